# Optimizing an MI355X kernel written in HIP

```python
import math
import jax, jax.numpy as jnp
from jax import lax
import numpy as np

D_MODEL = 1024
BATCH = 16
SEQ = 2048
DEPTH = 4

N_EVEN = (DEPTH + 1) // 2
N_ODD = DEPTH // 2
DN_ALPHA = (2.0 * DEPTH) ** 0.25
DN_BETA = (8.0 * DEPTH) ** -0.25
LN_EPS = 1e-5
RMS_EPS = 1e-6
Q_BLOCK = 128

A_HEADS = 8
A_HEAD_DIM = 64
A_KV_LATENT = 128
IDX_HEADS = 8
IDX_DIM = 64
TOPK_MAX = 256

B_HEADS = 4
B_DK = 64
B_DV = 128
B_GATE_RANK = 16
B_GATE_TEMP = 16.0
B_CHUNK = 64

EVEN_SPLITS = (A_HEADS * A_HEAD_DIM, A_KV_LATENT, IDX_HEADS * IDX_DIM, IDX_DIM, IDX_HEADS,
               B_HEADS * B_DK, B_HEADS * B_DK, B_HEADS * B_DV, B_GATE_RANK, B_HEADS * B_DV)
EVEN_IN = sum(EVEN_SPLITS)
EVEN_MIX = A_HEADS * A_HEAD_DIM + B_HEADS * B_DV

C_HEADS = 8
C_QK_DIM = 64
C_V_DIM = 2 * C_QK_DIM
C_MIX = C_HEADS * C_V_DIM

D_FF = 2816
N_EXPERTS = 8
TOP_K = 2
D_FF_EXPERT = 2816

kernel_name = 'hybrid_dsa_gla_diffattn_moe_deepnorm'


def layer_norm(x, g, b):
    xf = x.astype(jnp.float32)
    mu = jnp.mean(xf, axis=-1, keepdims=True)
    var = jnp.mean(jnp.square(xf - mu), axis=-1, keepdims=True)
    return ((xf - mu) * lax.rsqrt(var + LN_EPS) * g + b).astype(x.dtype)


def rms_norm(x, g):
    xf = x.astype(jnp.float32)
    return (xf * lax.rsqrt(jnp.mean(jnp.square(xf), axis=-1, keepdims=True) + RMS_EPS) * g).astype(x.dtype)


def split_cols(t, sizes):
    out, off = [], 0
    for s in sizes:
        out.append(t[..., off:off + s])
        off += s
    return out


def query_blocks(t):
    bsz, seq = t.shape[0], t.shape[1]
    return t.reshape((bsz, seq // Q_BLOCK, Q_BLOCK) + t.shape[2:]).swapaxes(0, 1)


def dsa_attention(q, c_kv, q_idx, k_idx, w_idx, kv_norm_g, w_uk, w_uv, kidx_ln_g, kidx_ln_b):
    bsz, seq = q.shape[0], q.shape[1]
    n_sel = min(TOPK_MAX, seq // 4)
    c = rms_norm(c_kv, kv_norm_g)
    k = c @ w_uk
    v = c @ w_uv
    k_i = layer_norm(k_idx, kidx_ln_g, kidx_ln_b).astype(jnp.float32)
    key_pos = jnp.arange(seq)
    gather = jax.vmap(lambda t, idx: t[idx])

    def block(args):
        qb, qib, wb, start = args
        qpos = start + jnp.arange(Q_BLOCK)
        rel = jax.nn.relu(jnp.einsum('bqhd,bsd->bqhs', qib.astype(jnp.float32), k_i) * IDX_DIM ** -0.5)
        score = jnp.einsum('bqh,bqhs->bqs', wb.astype(jnp.float32) * IDX_HEADS ** -0.5, rel)
        causal = key_pos[None, :] <= qpos[:, None]
        score = jnp.where(causal[None], score, -jnp.inf)
        _, idx = lax.top_k(score, n_sel)
        k_sel = gather(k, idx)
        v_sel = gather(v, idx)
        logits = jnp.einsum('bqhd,bqkd->bqhk', qb, k_sel).astype(jnp.float32) * A_HEAD_DIM ** -0.5
        valid = (idx <= qpos[None, :, None])[:, :, None, :]
        p = jax.nn.softmax(jnp.where(valid, logits, -jnp.inf), axis=-1).astype(v.dtype)
        return jnp.einsum('bqhk,bqkd->bqhd', p, v_sel)

    starts = jnp.arange(seq // Q_BLOCK) * Q_BLOCK
    out = lax.map(block, (query_blocks(q), query_blocks(q_idx), query_blocks(w_idx), starts))
    return out.swapaxes(0, 1).reshape(bsz, seq, A_HEADS * A_HEAD_DIM)


def gla_chunked(q, k, v, log_a):
    bsz, seq, nh, dk = q.shape
    dv = v.shape[-1]
    n = seq // B_CHUNK

    def chunks(t):
        return t.reshape(bsz, n, B_CHUNK, nh, t.shape[-1]).transpose(1, 0, 3, 2, 4).astype(jnp.float32)

    causal = jnp.tril(jnp.ones((B_CHUNK, B_CHUNK), dtype=bool))[None, None, :, :, None]

    def step(state, inp):
        qb, kb, vb, gb = inp
        b = jnp.cumsum(gb, axis=2)
        diff = b[:, :, :, None, :] - b[:, :, None, :, :]
        decay = jnp.exp(jnp.where(causal, diff, -jnp.inf))
        scores = jnp.einsum('bhid,bhjd,bhijd->bhij', qb, kb, decay)
        o = (jnp.einsum('bhij,bhje->bhie', scores, vb)
             + jnp.einsum('bhid,bhde->bhie', qb * jnp.exp(b), state))
        b_last = b[:, :, -1, :]
        state = (jnp.exp(b_last)[..., None] * state
                 + jnp.einsum('bhjd,bhje->bhde', kb * jnp.exp(b_last[:, :, None, :] - b), vb))
        return state, o

    state0 = jnp.zeros((bsz, nh, dk, dv), jnp.float32)
    _, o = lax.scan(step, state0, (chunks(q * dk ** -0.5), chunks(k), chunks(v), chunks(log_a)))
    return o.transpose(1, 0, 3, 2, 4).reshape(bsz, seq, nh, dv).astype(v.dtype)


def even_mixer(x, w_in, a_kv_norm_g, a_w_uk, a_w_uv, a_kidx_ln_g, a_kidx_ln_b, b_w_g2, b_b_g, b_norm_g, w_out):
    bsz, seq, _ = x.shape
    aq, ackv, aqi, aki, awi, bq, bk, bv, bg, br = split_cols(x @ w_in, EVEN_SPLITS)
    a_out = dsa_attention(aq.reshape(bsz, seq, A_HEADS, A_HEAD_DIM), ackv,
                          aqi.reshape(bsz, seq, IDX_HEADS, IDX_DIM), aki, awi,
                          a_kv_norm_g, a_w_uk, a_w_uv, a_kidx_ln_g, a_kidx_ln_b)
    log_a = jax.nn.log_sigmoid((bg @ b_w_g2 + b_b_g).astype(jnp.float32)) / B_GATE_TEMP
    heads = lambda t, d: t.reshape(bsz, seq, B_HEADS, d)
    o = gla_chunked(heads(bq, B_DK), heads(bk, B_DK), heads(bv, B_DV), heads(log_a, B_DK))
    b_out = (rms_norm(o, b_norm_g) * jax.nn.silu(heads(br, B_DV))).reshape(bsz, seq, B_HEADS * B_DV)
    return jnp.concatenate([a_out, b_out], axis=-1) @ w_out


def diff_attention(x, w_qkv, lam_q1, lam_k1, lam_q2, lam_k2, subln_g, w_out, lambda_init):
    bsz, seq, _ = x.shape
    f32 = jnp.float32
    q, k, v = split_cols(x @ w_qkv, (C_MIX, C_MIX, C_MIX))
    q = q.reshape(bsz, seq, C_HEADS, 2, C_QK_DIM)
    k = k.reshape(bsz, seq, C_HEADS, 2, C_QK_DIM)
    v = v.reshape(bsz, seq, C_HEADS, C_V_DIM)
    lam = (jnp.exp(jnp.sum(lam_q1.astype(f32) * lam_k1.astype(f32)))
           - jnp.exp(jnp.sum(lam_q2.astype(f32) * lam_k2.astype(f32))) + lambda_init)
    key_pos = jnp.arange(seq)

    def block(args):
        qb, start = args
        qpos = start + jnp.arange(Q_BLOCK)
        s = jnp.einsum('bqhmd,bshmd->bhmqs', qb, k).astype(f32) * C_QK_DIM ** -0.5
        s = jnp.where(key_pos[None, :] <= qpos[:, None], s, -jnp.inf)
        p = jax.nn.softmax(s, axis=-1)
        w = (p[:, :, 0] - lam * p[:, :, 1]).astype(v.dtype)
        return jnp.einsum('bhqs,bshe->bqhe', w, v)

    starts = jnp.arange(seq // Q_BLOCK) * Q_BLOCK
    o = lax.map(block, (query_blocks(q), starts)).swapaxes(0, 1).reshape(bsz, seq, C_HEADS, C_V_DIM)
    o = rms_norm(o, subln_g) * (1.0 - lambda_init)
    return o.reshape(bsz, seq, C_MIX) @ w_out


def swiglu(x, w_gate, w_up, w_down):
    return (jax.nn.silu(x @ w_gate) * (x @ w_up)) @ w_down


def moe_swiglu(x, w_router, b_router, w_gate, w_up, w_down):
    logits = (x @ w_router).astype(jnp.float32) + b_router
    top_vals, top_idx = lax.top_k(logits, TOP_K)
    gates = jax.nn.softmax(top_vals, axis=-1)
    combine = jnp.sum(jax.nn.one_hot(top_idx, N_EXPERTS, dtype=jnp.float32) * gates[..., None], axis=-2)
    y = jnp.zeros_like(x)
    for e in range(N_EXPERTS):
        y = y + combine[..., e:e + 1].astype(x.dtype) * swiglu(x, w_gate[e], w_up[e], w_down[e])
    return y


def setup_inputs(seed: int = 0) -> dict:
    key = jax.random.key(seed)
    keys = list(jax.random.split(key, 48))
    D = D_MODEL

    def nrm(shape, scale):
        return scale * jax.random.normal(keys.pop(), shape, jnp.float32)

    def gain(shape):
        return 1.0 + nrm(shape, 0.02)

    return {
        'x': nrm((BATCH, SEQ, D), 1.0),
        'ev_w_in': nrm((N_EVEN, D, EVEN_IN), D ** -0.5),
        'ev_a_kv_norm_g': gain((N_EVEN, A_KV_LATENT)),
        'ev_a_w_uk': nrm((N_EVEN, A_KV_LATENT, A_HEAD_DIM), A_KV_LATENT ** -0.5),
        'ev_a_w_uv': nrm((N_EVEN, A_KV_LATENT, A_HEAD_DIM), A_KV_LATENT ** -0.5),
        'ev_a_kidx_ln_g': gain((N_EVEN, IDX_DIM)),
        'ev_a_kidx_ln_b': nrm((N_EVEN, IDX_DIM), 0.02),
        'ev_b_w_g2': nrm((N_EVEN, B_GATE_RANK, B_HEADS * B_DK), B_GATE_RANK ** -0.5),
        'ev_b_b_g': nrm((N_EVEN, B_HEADS * B_DK), 0.1),
        'ev_b_norm_g': gain((N_EVEN, B_HEADS, B_DV)),
        'ev_w_out': nrm((N_EVEN, EVEN_MIX, D), DN_BETA * EVEN_MIX ** -0.5),
        'ev_ln1_g': gain((N_EVEN, D)),
        'ev_ln1_b': nrm((N_EVEN, D), 0.02),
        'ev_ffn_w_gate': nrm((N_EVEN, D, D_FF), D ** -0.5),
        'ev_ffn_w_up': nrm((N_EVEN, D, D_FF), D ** -0.5),
        'ev_ffn_w_down': nrm((N_EVEN, D_FF, D), DN_BETA * D_FF ** -0.5),
        'ev_ln2_g': gain((N_EVEN, D)),
        'ev_ln2_b': nrm((N_EVEN, D), 0.02),
        'od_w_qkv': nrm((N_ODD, D, 3 * C_MIX), D ** -0.5),
        'od_lam_q1': nrm((N_ODD, C_QK_DIM), 0.1),
        'od_lam_k1': nrm((N_ODD, C_QK_DIM), 0.1),
        'od_lam_q2': nrm((N_ODD, C_QK_DIM), 0.1),
        'od_lam_k2': nrm((N_ODD, C_QK_DIM), 0.1),
        'od_subln_g': gain((N_ODD, C_V_DIM)),
        'od_w_out': nrm((N_ODD, C_MIX, D), DN_BETA * C_MIX ** -0.5),
        'od_ln1_g': gain((N_ODD, D)),
        'od_ln1_b': nrm((N_ODD, D), 0.02),
        'od_router_w': nrm((N_ODD, D, N_EXPERTS), D ** -0.5),
        'od_router_b': nrm((N_ODD, N_EXPERTS), 0.01),
        'od_moe_w_gate': nrm((N_ODD, N_EXPERTS, D, D_FF_EXPERT), D ** -0.5),
        'od_moe_w_up': nrm((N_ODD, N_EXPERTS, D, D_FF_EXPERT), D ** -0.5),
        'od_moe_w_down': nrm((N_ODD, N_EXPERTS, D_FF_EXPERT, D), DN_BETA * D_FF_EXPERT ** -0.5),
        'od_ln2_g': gain((N_ODD, D)),
        'od_ln2_b': nrm((N_ODD, D), 0.02),
    }


def reference(x, ev_w_in, ev_a_kv_norm_g, ev_a_w_uk, ev_a_w_uv, ev_a_kidx_ln_g, ev_a_kidx_ln_b,
              ev_b_w_g2, ev_b_b_g, ev_b_norm_g, ev_w_out, ev_ln1_g, ev_ln1_b,
              ev_ffn_w_gate, ev_ffn_w_up, ev_ffn_w_down, ev_ln2_g, ev_ln2_b,
              od_w_qkv, od_lam_q1, od_lam_k1, od_lam_q2, od_lam_k2, od_subln_g, od_w_out,
              od_ln1_g, od_ln1_b, od_router_w, od_router_b,
              od_moe_w_gate, od_moe_w_up, od_moe_w_down, od_ln2_g, od_ln2_b):
    for i in range(DEPTH):
        j = i // 2
        if i % 2 == 0:
            h = even_mixer(x, ev_w_in[j], ev_a_kv_norm_g[j], ev_a_w_uk[j], ev_a_w_uv[j],
                           ev_a_kidx_ln_g[j], ev_a_kidx_ln_b[j], ev_b_w_g2[j], ev_b_b_g[j],
                           ev_b_norm_g[j], ev_w_out[j])
            x = layer_norm(DN_ALPHA * x + h, ev_ln1_g[j], ev_ln1_b[j])
            h = swiglu(x, ev_ffn_w_gate[j], ev_ffn_w_up[j], ev_ffn_w_down[j])
            x = layer_norm(DN_ALPHA * x + h, ev_ln2_g[j], ev_ln2_b[j])
        else:
            lambda_init = 0.8 - 0.6 * math.exp(-0.3 * i)
            h = diff_attention(x, od_w_qkv[j], od_lam_q1[j], od_lam_k1[j], od_lam_q2[j], od_lam_k2[j],
                               od_subln_g[j], od_w_out[j], lambda_init)
            x = layer_norm(DN_ALPHA * x + h, od_ln1_g[j], od_ln1_b[j])
            h = moe_swiglu(x, od_router_w[j], od_router_b[j], od_moe_w_gate[j], od_moe_w_up[j], od_moe_w_down[j])
            x = layer_norm(DN_ALPHA * x + h, od_ln2_g[j], od_ln2_b[j])
    return x
```

```cpp
#include <hip/hip_runtime.h>
#include <cstdio>
#include <cstdint>
#include <cmath>
namespace pg8 {
#define PG8_LAS __attribute__((address_space(3)))
typedef unsigned short bf16_t;
typedef short bf16x8 __attribute__((ext_vector_type(8)));
typedef float f32x4 __attribute__((ext_vector_type(4)));
typedef unsigned u32x4 __attribute__((ext_vector_type(4)));
constexpr int BM = 256, BK = 64, HALF = 128, HTB = HALF * BK * 2  , STAGE_BYTES = 8 * HTB, NXCD = 8, WGM = 8;

__host__ __device__ __forceinline__ int lds_byte(int r, int c) { const int st = (r >> 4) * 2 + (c >> 5), rr = r & 15, cc = c & 31, ob = rr * 64 + cc * 2; return st * 1024 + (ob ^ (((ob >> 9) & 1) << 5)); }
__host__ __device__ __forceinline__ void stage_rc(int b, int& R, int& C) { const int st = b / 1024, sb = b % 1024, swz = sb ^ (((sb >> 9) & 1) << 5); R = (st >> 1) * 16 + swz / 64; C = (st & 1) * 32 + (swz % 64) / 2; }
__host__ __device__ __forceinline__ int perm32(int rho) { const int n = rho >> 4, i = rho & 15; return 8 * (i >> 2) + 4 * n + (i & 3); }

struct Unit { int pm, pn, pb; };
struct Gemm { const bf16_t* A; const bf16_t* Bt; int M, N, K; };

struct StaticOrder {
    int nM, nN, nwg, G, c;
    __host__ __device__ void init(int M, int N, int G_, int c_) { nM = M / BM; nN = N / BM; nwg = nM * nN; G = G_; c = c_; }
    __host__ __device__ bool next(int i, Unit& u) const {
        const long L = (long)i * G + c; if (L >= nwg) return false;
        int wgid = (int)L; { const int q = nwg / NXCD, r = nwg % NXCD, xcd = wgid % NXCD, off = wgid / NXCD; wgid = (xcd < r ? xcd * (q + 1) : r * (q + 1) + (xcd - r) * q) + off; }
        const int nig = WGM * nN, gid = wgid / nig, fm = gid * WGM, gsz = (nM - fm) < WGM ? (nM - fm) : WGM;
        u.pm = fm + ((wgid % nig) % gsz); u.pn = (wgid % nig) / gsz; u.pb = u.pn; return true;
    }
    __device__ __forceinline__ void a_ready(const Unit&) const {}
    __device__ __forceinline__ void done(const Unit&) const {}
};

__device__ __forceinline__ unsigned cvt_pk_bf16(float lo, float hi) { unsigned r; asm volatile("v_cvt_pk_bf16_f32 %0, %1, %2" : "=v"(r) : "v"(lo), "v"(hi)); return r; }
typedef float f32x2 __attribute__((ext_vector_type(2)));
__device__ __forceinline__ f32x2 gelu_pk(f32x2 v) {
    const f32x2 av = __builtin_elementwise_abs(v), d = av * 0.2316418882f + 1.0f;
    f32x2 t; t.x = __builtin_amdgcn_rcpf(d.x); t.y = __builtin_amdgcn_rcpf(d.y);
    f32x2 q = t * 0.5307027145f + (-0.7265760135f); q = q * t + 0.7107068705f; q = q * t + (-0.142248368f); q = q * t + 0.127414796f; q = q * t;
    const f32x2 s = (v * v) * (-0.72134752044f);
    f32x2 e; e.x = __builtin_amdgcn_exp2f(s.x); e.y = __builtin_amdgcn_exp2f(s.y);
    const f32x2 m = v * (q * e), r = v - m;
    f32x2 o; o.x = v.x < 0.f ? m.x : r.x; o.y = v.y < 0.f ? m.y : r.y; return o;
}

template <int ACT  > struct EpiBf16 {
    static constexpr bool PERM = true, AFTER_DRAIN = false; static_assert(ACT == 0 || ACT == 1, "EpiBf16: ACT is 0 (none) or 1 (gelu_pk)");
    bf16_t* O; int ldc; const float* bias; int split_cols; size_t split_stride; float scale0;
    __device__ __forceinline__ void operator()(const f32x4 (&acc)[2][2][4][2], const Unit& u, int wr, int wc, int fr, int fq) const {
        const int row0 = u.pm * BM + wr * 64 + fr; int colt = u.pn * BM; bf16_t* base = O;
        float sc = 1.f; if (split_cols) { const int t = colt / split_cols; base += (size_t)t * split_stride; colt -= t * split_cols; if (t == 0) sc = scale0; }
        const int col0 = colt + wc * 32 + 8 * fq, bcol0 = u.pn * BM + wc * 32 + 8 * fq;
        f32x4 bv[2][2];
#pragma unroll
        for (int bj = 0; bj < 2; ++bj)
#pragma unroll
            for (int n = 0; n < 2; ++n) bv[bj][n] = bias ? *(const f32x4*)(bias + bcol0 + bj * HALF + 4 * n) : (f32x4){0.f, 0.f, 0.f, 0.f};
#pragma unroll
        for (int ai = 0; ai < 2; ++ai)
#pragma unroll
            for (int m = 0; m < 4; ++m) { bf16_t* rowp = base + (size_t)(row0 + ai * HALF + m * 16) * ldc + col0;
#pragma unroll
                for (int bj = 0; bj < 2; ++bj) { f32x4 v0 = acc[ai][bj][m][0] + bv[bj][0], v1 = acc[ai][bj][m][1] + bv[bj][1];
                    if (ACT == 1) { f32x2 a = gelu_pk((f32x2){v0[0], v0[1]}), b = gelu_pk((f32x2){v0[2], v0[3]}), c = gelu_pk((f32x2){v1[0], v1[1]}), d = gelu_pk((f32x2){v1[2], v1[3]});
                        v0 = (f32x4){a.x, a.y, b.x, b.y}; v1 = (f32x4){c.x, c.y, d.x, d.y}; }
                    v0 = v0 * sc; v1 = v1 * sc; u32x4 w; w.x = cvt_pk_bf16(v0[0], v0[1]); w.y = cvt_pk_bf16(v0[2], v0[3]); w.z = cvt_pk_bf16(v1[0], v1[1]); w.w = cvt_pk_bf16(v1[2], v1[3]);
                    *(u32x4*)(rowp + bj * HALF) = w; } }
    }
};
template <class Epi, class Sched, bool ALIGN_EPI = false, bool SP2 = false>
__device__ __forceinline__ void gemm_phase(PG8_LAS unsigned char* lds, const Gemm g, const Sched& S, const Epi& E, const int tid) {
    const int wid = __builtin_amdgcn_readfirstlane(tid >> 6), lane = tid & 63, wr = wid >> 2, wc = wid & 3, fr = lane & 15, fq = lane >> 4;
    const int K = g.K, nt = K / BK;
    unsigned voffA[2], voffB[2];
#pragma unroll
    for (int i = 0; i < 2; ++i) { int R, C; stage_rc(tid * 16 + i * 8192, R, C); const int Rb = Epi::PERM ? ((R & ~31) + perm32(R & 31)) : R;
        voffA[i] = (unsigned)(R * K + C) * 2u; voffB[i] = (unsigned)(Rb * K + C) * 2u; }
    const size_t kstep = (size_t)(BK * 2);
    const size_t hstep = (size_t)HALF * K * 2;
    const size_t tstep = 2 * hstep;
    const unsigned ldsw = (unsigned)wid * 1024u;
    const int aoff = lds_byte(wr * 64 + fr, fq * 8), boff = lds_byte(wc * 32 + fr, fq * 8);
#define PG8_SA(b, h) (((b) * 2 + (h)) * HTB)
#define PG8_SB(b, h) ((4 + (b) * 2 + (h)) * HTB)
#define PG8_STAGE(bufoff, gbase, voff) do { _Pragma("unroll") for (int _i = 0; _i < 2; ++_i) \
        __builtin_amdgcn_global_load_lds((const unsigned*)((const char*)(gbase) + (voff)[_i]), (PG8_LAS unsigned*)(lds + (bufoff) + ldsw + _i * 8192), 16, 0, 0); } while (0)
#define PG8_LDA(dst, b, h) do { _Pragma("unroll") for (int m = 0; m < 4; ++m) _Pragma("unroll") for (int k = 0; k < 2; ++k) dst[m][k] = *(const PG8_LAS bf16x8*)(lds + PG8_SA(b, h) + aoff + m * 2048 + k * 1024); } while (0)
#define PG8_LDB(dst, b, h) do { _Pragma("unroll") for (int n = 0; n < 2; ++n) _Pragma("unroll") for (int k = 0; k < 2; ++k) dst[n][k] = *(const PG8_LAS bf16x8*)(lds + PG8_SB(b, h) + boff + n * 2048 + k * 1024); } while (0)
#define PG8_MMA(ai, bj, At, Bt) do { __builtin_amdgcn_s_setprio(1); _Pragma("unroll") for (int m = 0; m < 4; ++m) _Pragma("unroll") for (int n = 0; n < 2; ++n) _Pragma("unroll") for (int k = 0; k < 2; ++k) \
        acc[ai][bj][m][n] = __builtin_amdgcn_mfma_f32_16x16x32_bf16(Bt[n][k], At[m][k], acc[ai][bj][m][n], 0, 0, 0); __builtin_amdgcn_s_setprio(0); } while (0)
#define PG8_WAIT_V(n) asm volatile("s_waitcnt vmcnt(" #n ")" ::: "memory")
#define PG8_WAIT_L(n) asm volatile("s_waitcnt lgkmcnt(" #n ")" ::: "memory")
#define PG8_BAR __builtin_amdgcn_s_barrier()
#define PG8_SCHED __builtin_amdgcn_sched_barrier(0)
    Unit cur, nxt; int ui = 0;
    if (!S.next(0, cur)) return;
    f32x4 acc[2][2][4][2];
#pragma unroll
    for (int a = 0; a < 2; ++a)
#pragma unroll
        for (int b = 0; b < 2; ++b)
#pragma unroll
            for (int m = 0; m < 4; ++m)
#pragma unroll
                for (int n = 0; n < 2; ++n) acc[a][b][m][n] = (f32x4){0.f, 0.f, 0.f, 0.f};
    bf16x8 At[4][2], B0[2][2], B1[2][2];
    const char* cA = (const char*)g.A + (size_t)cur.pm * tstep; const char* cB = (const char*)g.Bt + (size_t)cur.pb * tstep;
    S.a_ready(cur);
    if constexpr (SP2) {
        PG8_STAGE(PG8_SB(0, 0), cB, voffB); PG8_STAGE(PG8_SB(0, 1), cB + hstep, voffB); PG8_STAGE(PG8_SA(0, 0), cA, voffA); PG8_STAGE(PG8_SA(0, 1), cA + hstep, voffA);
        if (wr == 1) PG8_BAR;
        PG8_WAIT_V(2); PG8_BAR;
        PG8_STAGE(PG8_SB(1, 0), cB + kstep, voffB); PG8_STAGE(PG8_SA(1, 0), cA + kstep, voffA); PG8_STAGE(PG8_SB(1, 1), cB + hstep + kstep, voffB);
        PG8_WAIT_V(6); PG8_BAR;
    } else {
        PG8_STAGE(PG8_SB(0, 0), cB, voffB); PG8_STAGE(PG8_SA(0, 0), cA, voffA); PG8_STAGE(PG8_SB(0, 1), cB + hstep, voffB); PG8_STAGE(PG8_SA(0, 1), cA + hstep, voffA);
        if (wr == 1) PG8_BAR;
        PG8_WAIT_V(4); PG8_BAR;
        PG8_STAGE(PG8_SB(1, 0), cB + kstep, voffB); PG8_STAGE(PG8_SA(1, 0), cA + kstep, voffA); PG8_STAGE(PG8_SB(1, 1), cB + hstep + kstep, voffB);
        PG8_WAIT_V(6); PG8_BAR;
    }
    for (;;) {
        const bool has_next = S.next(ui + 1, nxt);
        const char* nA = has_next ? (const char*)g.A + (size_t)nxt.pm * tstep : cA; const char* nB = has_next ? (const char*)g.Bt + (size_t)nxt.pb * tstep : cB;
        for (int t = 0; t < nt; t += 2) {
            const bool last = (t == nt - 2);
            const char* a1 = cA + (size_t)(t + 1) * kstep;
            const char* a2 = last ? nA : cA + (size_t)(t + 2) * kstep; const char* b2 = last ? nB : cB + (size_t)(t + 2) * kstep;
            const char* a3 = a2 + kstep; const char* b3 = b2 + kstep;
            if (last && has_next) S.a_ready(nxt);
            if constexpr (SP2) {
            PG8_LDB(B0, 0, 0); PG8_LDB(B1, 0, 1); PG8_SCHED; PG8_LDA(At, 0, 0); PG8_STAGE(PG8_SA(1, 1), a1 + hstep, voffA);
            PG8_WAIT_V(8); PG8_WAIT_L(0); PG8_BAR; PG8_MMA(0, 0, At, B0); PG8_MMA(0, 1, At, B1); PG8_BAR; PG8_SCHED;
            PG8_LDA(At, 0, 1); PG8_STAGE(PG8_SB(0, 0), b2, voffB); PG8_STAGE(PG8_SB(0, 1), b2 + hstep, voffB); PG8_STAGE(PG8_SA(0, 0), a2, voffA);
            PG8_WAIT_V(8); PG8_WAIT_L(0); PG8_BAR; PG8_MMA(1, 0, At, B0); PG8_MMA(1, 1, At, B1); PG8_BAR; PG8_SCHED;
            PG8_LDB(B0, 1, 0); PG8_LDB(B1, 1, 1); PG8_SCHED; PG8_LDA(At, 1, 0); PG8_STAGE(PG8_SA(0, 1), a2 + hstep, voffA);
            PG8_WAIT_V(8); PG8_WAIT_L(0); PG8_BAR; PG8_MMA(0, 0, At, B0); PG8_MMA(0, 1, At, B1); PG8_BAR; PG8_SCHED;
            PG8_LDA(At, 1, 1); PG8_STAGE(PG8_SB(1, 0), b3, voffB); PG8_STAGE(PG8_SB(1, 1), b3 + hstep, voffB); PG8_STAGE(PG8_SA(1, 0), a3, voffA);
            PG8_WAIT_V(8); PG8_WAIT_L(0); PG8_BAR; PG8_MMA(1, 0, At, B0); PG8_MMA(1, 1, At, B1); PG8_BAR; PG8_SCHED;
            } else {
            PG8_LDB(B0, 0, 0); PG8_SCHED; PG8_LDA(At, 0, 0); PG8_STAGE(PG8_SA(1, 1), a1 + hstep, voffA);
            PG8_WAIT_L(8); PG8_BAR; PG8_WAIT_L(0); PG8_MMA(0, 0, At, B0); PG8_BAR; PG8_SCHED;
            PG8_LDB(B1, 0, 1); PG8_STAGE(PG8_SB(0, 0), b2, voffB);
            PG8_BAR; PG8_WAIT_L(0); PG8_MMA(0, 1, At, B1); PG8_BAR;
            PG8_LDA(At, 0, 1); PG8_STAGE(PG8_SA(0, 0), a2, voffA);
            PG8_BAR; PG8_WAIT_L(0); PG8_MMA(1, 0, At, B0); PG8_BAR; PG8_SCHED;
            PG8_STAGE(PG8_SB(0, 1), b2 + hstep, voffB);
            PG8_WAIT_V(6); PG8_BAR; PG8_MMA(1, 1, At, B1); PG8_BAR;
            PG8_LDB(B0, 1, 0); PG8_SCHED; PG8_LDA(At, 1, 0); PG8_STAGE(PG8_SA(0, 1), a2 + hstep, voffA);
            PG8_WAIT_L(8); PG8_BAR; PG8_WAIT_L(0); PG8_MMA(0, 0, At, B0); PG8_BAR; PG8_SCHED;
            PG8_LDB(B1, 1, 1); PG8_STAGE(PG8_SB(1, 0), b3, voffB);
            PG8_BAR; PG8_WAIT_L(0); PG8_MMA(0, 1, At, B1); PG8_BAR;
            PG8_LDA(At, 1, 1); PG8_STAGE(PG8_SA(1, 0), a3, voffA);
            PG8_BAR; PG8_WAIT_L(0); PG8_MMA(1, 0, At, B0); PG8_BAR; PG8_SCHED;
            PG8_STAGE(PG8_SB(1, 1), b3 + hstep, voffB);
            PG8_WAIT_V(6); PG8_BAR; PG8_MMA(1, 1, At, B1); PG8_BAR;
            }
        }
        if constexpr (ALIGN_EPI) { if (wr == 0) PG8_BAR; }
        if constexpr (!Epi::AFTER_DRAIN) { E(acc, cur, wr, wc, fr, fq); S.done(cur); }
        if (!has_next) break;
#pragma unroll
        for (int a = 0; a < 2; ++a)
#pragma unroll
            for (int b = 0; b < 2; ++b)
#pragma unroll
                for (int m = 0; m < 4; ++m)
#pragma unroll
                    for (int n = 0; n < 2; ++n) acc[a][b][m][n] = (f32x4){0.f, 0.f, 0.f, 0.f};
        cur = nxt; cA = nA; cB = nB; ++ui;
        if constexpr (ALIGN_EPI) { if (wr == 1) PG8_BAR; }
    }
    PG8_WAIT_V(0);
    if constexpr (!ALIGN_EPI) { if (wr == 0) PG8_BAR; }
    PG8_BAR;
    if constexpr (Epi::AFTER_DRAIN) { E.fused(acc, cur, wr, wc, fr, fq, lds, wid, lane); S.done(cur); }
#undef PG8_SA
#undef PG8_SB
#undef PG8_STAGE
#undef PG8_LDA
#undef PG8_LDB
#undef PG8_MMA
#undef PG8_WAIT_V
#undef PG8_WAIT_L
#undef PG8_BAR
#undef PG8_SCHED
}
}
#define GAS __attribute__((address_space(1)))
#define LAS __attribute__((address_space(3)))
typedef unsigned short bf16;
typedef unsigned v4u __attribute__((ext_vector_type(4)));
typedef float f32x4 __attribute__((ext_vector_type(4)));
typedef short bf16x8 __attribute__((ext_vector_type(8)));
typedef GAS unsigned gu32;
typedef GAS unsigned long long gu64;
#define RLX_AGENT __ATOMIC_RELAXED, __HIP_MEMORY_SCOPE_AGENT
#define LDS_WAIT() asm volatile("s_waitcnt lgkmcnt(0)" ::: "memory")
#define VM_WAIT() asm volatile("s_waitcnt vmcnt(0)" ::: "memory")
__device__ __forceinline__ unsigned long long rt() { return __builtin_amdgcn_s_memrealtime(); }
__device__ __forceinline__ unsigned f2bf(float f) { unsigned u = __builtin_bit_cast(unsigned, f); return (u + 0x7fffu + ((u >> 16) & 1u)) >> 16; }
__device__ __forceinline__ unsigned pk2(float lo, float hi) { return f2bf(lo) | (f2bf(hi) << 16); }

#define XB_TMO      128
#define XB_XCNT(j)  (256  + 64 * (j))
#define XB_XSUB(j)  (1280 + 64 * (j))
#define XB_XGEN(j)  (2304 + 64 * (j))
#define XB_TOP      3328
#define XB_TOPGEN   3392
#define XCD_BAR_WORDS 3456
#define XB_SPIN_CAP (1u << 18)

__device__ __forceinline__ unsigned xb_ld(unsigned* p)              { return __hip_atomic_load(p, __ATOMIC_RELAXED, __HIP_MEMORY_SCOPE_AGENT); }
__device__ __forceinline__ unsigned xb_add(unsigned* p, unsigned v) { return __hip_atomic_fetch_add(p, v, __ATOMIC_RELAXED, __HIP_MEMORY_SCOPE_AGENT); }
__device__ __forceinline__ unsigned xb_xcc_id() { return (unsigned)__builtin_amdgcn_s_getreg((3 << 11) | 20) & 0xFu; }
#define XB_SPIN(cond, bar) do { unsigned _sp = 0; while (cond) { __builtin_amdgcn_s_sleep(1); \
    if ((++_sp & 255u) == 0u) { if (xb_ld(&(bar)[XB_TMO])) break; if (_sp > XB_SPIN_CAP) { atomicAdd(&(bar)[XB_TMO], 1u); break; } } } } while (0)

struct XcdBarrier {
    unsigned* bar; unsigned x;
    volatile LAS unsigned* st;
};

__device__ __forceinline__ XcdBarrier xcd_barrier_post(unsigned* bar, volatile LAS unsigned* st) {
    XcdBarrier b; b.bar = bar; b.x = xb_xcc_id(); b.st = st;
    if (threadIdx.x == 0) (void)xb_add(&bar[XB_XCNT(b.x)], 1u);
    return b;
}
__device__ __forceinline__ void xcd_barrier_complete(unsigned* bar, unsigned x, unsigned& nloc, unsigned& nx) {
    const unsigned G = gridDim.x * gridDim.y * gridDim.z;
    unsigned sum, cnt, mine, sp = 0u;
    for (;;) {
        sum = 0u; cnt = 0u; mine = 0u;
#pragma unroll
        for (unsigned j = 0; j < 16; ++j) { const unsigned c = xb_ld(&bar[XB_XCNT(j)]); sum += c; cnt += (c > 0u) ? 1u : 0u; mine = (j == x) ? c : mine; }
        if (sum == G) break;
        __builtin_amdgcn_s_sleep(1);
        if ((++sp & 255u) == 0u) { if (xb_ld(&bar[XB_TMO])) break; if (sp > XB_SPIN_CAP) { atomicAdd(&bar[XB_TMO], 1u); break; } }
    }
    nloc = mine > 0u ? mine : 1u; nx = cnt > 0u ? cnt : 1u;
}

__device__ __forceinline__ void xcd_barrier(const XcdBarrier& b) {
    asm volatile("s_waitcnt vmcnt(0)" ::: "memory");
    __syncthreads();
    if (threadIdx.x == 0) {
        unsigned* bar = b.bar;
        __builtin_amdgcn_s_waitcnt(0);
        unsigned nloc = b.st[0], nx = b.st[1];
        if (nloc == 0u) { xcd_barrier_complete(bar, b.x, nloc, nx); b.st[0] = nloc; b.st[1] = nx; }
        const unsigned old = xb_add(&bar[XB_XSUB(b.x)], 1u);
        const unsigned gen = old / nloc;
        if (old + 1u == (gen + 1u) * nloc) {
            __builtin_amdgcn_fence(__ATOMIC_RELEASE, "agent");
            asm volatile("s_waitcnt vmcnt(0)" ::: "memory");
            const unsigned og = xb_add(&bar[XB_TOP], 1u);
            const unsigned tg = og / nx;
            if (og + 1u == (tg + 1u) * nx) xb_add(&bar[XB_TOPGEN], 1u);
            else XB_SPIN(xb_ld(&bar[XB_TOPGEN]) == tg, bar);
            __builtin_amdgcn_fence(__ATOMIC_ACQUIRE, "agent");
            xb_add(&bar[XB_XGEN(b.x)], 1u);
            asm volatile("s_waitcnt vmcnt(0)" ::: "memory");
        } else {
            XB_SPIN(xb_ld(&bar[XB_XGEN(b.x)]) == gen, bar);
            __builtin_amdgcn_fence(__ATOMIC_ACQUIRE, "agent");
            asm volatile("s_waitcnt vmcnt(0)" ::: "memory");
        }
    }
    __syncthreads();
}

constexpr int NWAVES = 8, NTHR = 512;
constexpr int BATCH = 16, SEQ = 2048, D = 1024, M = BATCH * SEQ;
constexpr int EIN = 2776, EINP = 2816, FF = 2816, NEXP = 8;
constexpr int PC_AQ = 0, PC_CKV = 512, PC_QI = 640, PC_KI = 1152, PC_WI = 1216, PC_BQ = 1224, PC_BK = 1480, PC_BV = 1736, PC_BG = 2248, PC_BR = 2264;
constexpr float ALPHA = 1.6817928305074290f;
constexpr float LN_EPS = 1e-5f, RMS_EPS = 1e-6f;
constexpr float C2 = 0.125f * 1.4426950408889634f;
constexpr int MOE_ROWS = 2 * M + NEXP * 256;
constexpr int TOPK = 256;

constexpr size_t MiB = 1u << 20;
constexpr size_t WS_CTL = 0, CTL_ZERO_BYTES = 64 * 1024;
constexpr size_t WS_WB = 2 * MiB;
constexpr size_t WB_WIN = 0, WB_WOUT = 6 * MiB, WB_WGU = 8 * MiB, WB_WDN = 20 * MiB;
constexpr size_t WB_WQKV = 0, WB_MGU = 8 * MiB, WB_MDN = 96 * MiB;
constexpr size_t WS_XB = 146 * MiB;
constexpr size_t WS_P = 210 * MiB, WS_HID = 210 * MiB, WS_MIX = 386 * MiB;
constexpr size_t WS_KD = 450 * MiB, WS_VD = 454 * MiB, WS_KI = 458 * MiB, WS_MASK = 462 * MiB;
constexpr size_t WS_GST = 470 * MiB, WS_H_EVEN = 470 * MiB;
constexpr size_t WS_QT = 534 * MiB, WS_KT = 550 * MiB, WS_EBL = 582 * MiB;
constexpr size_t WS_QKV = 210 * MiB, WS_MIXO = 402 * MiB, WS_H_ODD = 594 * MiB;
constexpr size_t WS_XPERM = 210 * MiB, WS_HIDP = 342 * MiB;
constexpr size_t WS_ROUTE = 706 * MiB, WS_END = 708 * MiB;
constexpr int CW_TMO = 0, CW_CNT = 64  , CW_BAR = 4096;

constexpr int RING_BYTES = 131072, LDSCTL_OFF = RING_BYTES, MISC_OFF = LDSCTL_OFF + 320, LDS_BYTES = 147456;
constexpr int XTRA_OFF = MISC_OFF + 128;

__device__ __forceinline__ float bf2f(unsigned short u) { return __uint_as_float((unsigned)u << 16); }
__device__ __forceinline__ float bflo(unsigned w) { return __uint_as_float(w << 16); }
__device__ __forceinline__ float bfhi(unsigned w) { return __uint_as_float(w & 0xffff0000u); }
__device__ __forceinline__ float wave_sum(float v) {
#pragma unroll
    for (int o = 1; o < 64; o <<= 1) v += __shfl_xor(v, o);
    return v;
}
__device__ __forceinline__ float wave_max(float v) {
#pragma unroll
    for (int o = 1; o < 64; o <<= 1) v = fmaxf(v, __shfl_xor(v, o));
    return v;
}
__device__ __forceinline__ int wave_sum_i(int v) {
#pragma unroll
    for (int o = 1; o < 64; o <<= 1) v += __shfl_xor(v, o);
    return v;
}
__device__ __forceinline__ int wave_incl_scan_i(int v, int lane) {
#pragma unroll
    for (int o = 1; o < 64; o <<= 1) { const int t = __shfl_up(v, o); if (lane >= o) v += t; }
    return v;
}
__device__ __forceinline__ void ld8bf(const bf16* p, float* f) {
    const v4u w = *(const v4u*)p;
    f[0] = bflo(w.x); f[1] = bfhi(w.x); f[2] = bflo(w.y); f[3] = bfhi(w.y); f[4] = bflo(w.z); f[5] = bfhi(w.z); f[6] = bflo(w.w); f[7] = bfhi(w.w);
}
__device__ __forceinline__ float silu_f(float x) { return x * __builtin_amdgcn_rcpf(1.0f + __builtin_amdgcn_exp2f(-1.4426950408889634f * x)); }

struct Frame {
    LAS unsigned char* lds;
    volatile LAS unsigned* MISC;
    gu32* ctl;
    int tid, lane, wave, G, gw, NGW, bx;
    unsigned char* ws;
    const __attribute__((address_space(4))) unsigned char* kp;
    __device__ __forceinline__ const float* inp(int i) const { typedef const float* cfp; return *(const __attribute__((address_space(4))) cfp*)(kp + 8 * i); }
    __device__ __forceinline__ float* outp() const { typedef float* fp; return *(const __attribute__((address_space(4))) fp*)(kp + 272); }
};

namespace pg8 {
struct EpiSwiGLU {
    static constexpr bool PERM = true, AFTER_DRAIN = false;
    bf16_t* O; int ldc;
    __device__ __forceinline__ void operator()(const f32x4 (&acc)[2][2][4][2], const Unit& u, int wr, int wc, int fr, int fq) const {
        const int row0 = u.pm * BM + wr * 64 + fr, col0 = u.pn * HALF + wc * 32 + 8 * fq;
#pragma unroll
        for (int ai = 0; ai < 2; ++ai)
#pragma unroll
            for (int m = 0; m < 4; ++m) {
                bf16_t* rowp = O + (size_t)(row0 + ai * HALF + m * 16) * ldc + col0;
                const f32x4 g0 = acc[ai][0][m][0], g1 = acc[ai][0][m][1], u0 = acc[ai][1][m][0], u1 = acc[ai][1][m][1];
                u32x4 w;
                w.x = cvt_pk_bf16(silu_f(g0[0]) * u0[0], silu_f(g0[1]) * u0[1]); w.y = cvt_pk_bf16(silu_f(g0[2]) * u0[2], silu_f(g0[3]) * u0[3]);
                w.z = cvt_pk_bf16(silu_f(g1[0]) * u1[0], silu_f(g1[1]) * u1[1]); w.w = cvt_pk_bf16(silu_f(g1[2]) * u1[2], silu_f(g1[3]) * u1[3]);
                *(u32x4*)rowp = w;
            }
    }
};
struct MoeOrder {
    StaticOrder so; int tb[NEXP + 1]; int nN;
    __device__ __forceinline__ void init(const unsigned* cnt, int nN_, int G, int c) {
        tb[0] = 0;
#pragma unroll
        for (int e = 0; e < NEXP; ++e) tb[e + 1] = tb[e] + (int)((__builtin_amdgcn_readfirstlane(cnt[e]) + 255u) >> 8);
        nN = nN_; so.nM = tb[NEXP]; so.nN = nN_; so.nwg = so.nM * nN_; so.G = G; so.c = c;
    }
    __device__ __forceinline__ bool next(int i, Unit& u) const {
        if (!so.next(i, u)) return false;
        int e = 0;
#pragma unroll
        for (int k = 1; k < NEXP; ++k) e += (u.pm >= tb[k]) ? 1 : 0;
        u.pb = e * nN + u.pn; return true;
    }
    __device__ __forceinline__ void a_ready(const Unit&) const {}
    __device__ __forceinline__ void done(const Unit&) const {}
};
}

__device__ __forceinline__ void cvt_item(const float* W, int K, int N, bf16* WT, int mode, int rowbase, LAS float* scr, int item, int nblk, int lane) {
    const int kb = item / nblk, nb = item - kb * nblk, k0 = 64 * kb, n0 = 32 * nb;
    const int nn = n0 + (lane & 31); const bool ok = nn < N;
    const float* src = W + (size_t)(k0 + (lane >> 5)) * N + nn;
#pragma unroll 8
    for (int i = 0; i < 32; ++i) { scr[(2 * i + (lane >> 5)) * 33 + (lane & 31)] = ok ? src[(size_t)(2 * i) * N] : 0.f; }
    LDS_WAIT(); asm volatile("" ::: "memory");
    const int c = lane & 7;
#pragma unroll
    for (int j = 0; j < 4; ++j) {
        const int n = (lane >> 3) + 8 * j, ncol = n0 + n;
        const int row = (mode == 0) ? ncol : ((ncol >> 7) * 256 + (ncol & 127) + (mode == 2 ? 128 : 0));
        const LAS float* s = scr + (8 * c) * 33 + n;
        v4u o; o.x = pk2(s[0 * 33], s[1 * 33]); o.y = pk2(s[2 * 33], s[3 * 33]); o.z = pk2(s[4 * 33], s[5 * 33]); o.w = pk2(s[6 * 33], s[7 * 33]);
        *(GAS v4u*)(WT + (size_t)(rowbase + row) * K + k0 + 8 * c) = o;
    }
    LDS_WAIT(); asm volatile("" ::: "memory");
}
__device__ __forceinline__ void cvt_even(Frame& F, int j) {
    LAS float* scr = (LAS float*)(F.lds + F.wave * 16384);
    bf16* wb = (bf16*)(F.ws + WS_WB);
    const float* w_in = F.inp(1) + (size_t)j * D * EIN; const float* w_out = F.inp(10) + (size_t)j * D * D;
    const float* w_g = F.inp(13) + (size_t)j * D * FF; const float* w_u = F.inp(14) + (size_t)j * D * FF; const float* w_d = F.inp(15) + (size_t)j * FF * D;
    constexpr int I_IN = 16 * 88, I_OUT = 16 * 32, I_G = 16 * 88, I_D = 44 * 32, TOT = I_IN + I_OUT + 2 * I_G + I_D;
    for (int it = F.gw; it < TOT; it += F.NGW) {
        int r = it;
        if (r < I_IN) { cvt_item(w_in, D, EIN, wb + WB_WIN / 2, 0, 0, scr, r, 88, F.lane); continue; } r -= I_IN;
        if (r < I_OUT) { cvt_item(w_out, D, D, wb + WB_WOUT / 2, 0, 0, scr, r, 32, F.lane); continue; } r -= I_OUT;
        if (r < I_G) { cvt_item(w_g, D, FF, wb + WB_WGU / 2, 1, 0, scr, r, 88, F.lane); continue; } r -= I_G;
        if (r < I_G) { cvt_item(w_u, D, FF, wb + WB_WGU / 2, 2, 0, scr, r, 88, F.lane); continue; } r -= I_G;
        cvt_item(w_d, FF, D, wb + WB_WDN / 2, 0, 0, scr, r, 32, F.lane);
    }
}
__device__ __forceinline__ void cvt_odd(Frame& F, int j) {
    LAS float* scr = (LAS float*)(F.lds + F.wave * 16384);
    bf16* wb = (bf16*)(F.ws + WS_WB);
    const float* w_qkv = F.inp(18) + (size_t)j * D * 3072; const float* w_out = F.inp(24) + (size_t)j * D * D;
    const float* w_g = F.inp(29) + (size_t)j * NEXP * D * FF; const float* w_u = F.inp(30) + (size_t)j * NEXP * D * FF; const float* w_d = F.inp(31) + (size_t)j * NEXP * FF * D;
    constexpr int I_QKV = 16 * 96, I_OUT = 16 * 32, I_E = 1408, TOT = I_QKV + I_OUT + 24 * I_E;
    for (int it = F.gw; it < TOT; it += F.NGW) {
        int r = it;
        if (r < I_QKV) { cvt_item(w_qkv, D, 3072, wb + WB_WQKV / 2, 0, 0, scr, r, 96, F.lane); continue; } r -= I_QKV;
        if (r < I_OUT) { cvt_item(w_out, D, D, wb + WB_WOUT / 2, 0, 0, scr, r, 32, F.lane); continue; } r -= I_OUT;
        const int mat = r / I_E, item = r - mat * I_E, kind = mat >> 3, e = mat & 7;
        if (kind == 0) cvt_item(w_g + (size_t)e * D * FF, D, FF, wb + WB_MGU / 2, 1, e * 5632, scr, item, 88, F.lane);
        else if (kind == 1) cvt_item(w_u + (size_t)e * D * FF, D, FF, wb + WB_MGU / 2, 2, e * 5632, scr, item, 88, F.lane);
        else cvt_item(w_d + (size_t)e * FF * D, FF, D, wb + WB_MDN / 2, 0, e * 1024, scr, item, 32, F.lane);
    }
}
__device__ __forceinline__ void xb_from_x(Frame& F) {
    const float* x = F.inp(0); bf16* xb = (bf16*)(F.ws + WS_XB);
    for (int m = F.gw; m < M; m += F.NGW) {
        const GAS f32x4* xr = (const GAS f32x4*)(x + (size_t)m * D) + F.lane;
        GAS unsigned long long* o8 = (GAS unsigned long long*)(xb + (size_t)m * D) + F.lane;
#pragma unroll
        for (int j = 0; j < 4; ++j) { const f32x4 v = xr[64 * j]; o8[64 * j] = (unsigned long long)pk2(v.x, v.y) | ((unsigned long long)pk2(v.z, v.w) << 32); }
    }
}

template <int MODE, bool ROUTER, bool WRITE_XB>
__device__ __forceinline__ void ln_phase(Frame& F, const float* xin, const bf16* Hb, const float* g, const float* b, float* xout, bf16* xb,
                                         const float* rw, const float* rb, int lslot) {
    int* r_e = (int*)(F.ws + WS_ROUTE); float* r_g = (float*)(F.ws + WS_ROUTE + 256 * 1024); int* r_i = (int*)(F.ws + WS_ROUTE + 512 * 1024); int* r_p = (int*)(F.ws + WS_ROUTE + 768 * 1024);
    LAS float* wr = (LAS float*)F.lds;
    LAS int* lcnt = (LAS int*)(F.lds + 32768);
    LAS int* lrk = (LAS int*)(F.lds + 32768 + 64);
    LAS int* lex = (LAS int*)(F.lds + 32768 + 64 + 4096);
    LAS int* wbase = (LAS int*)(F.lds + 32768 + 32);
    const int r0 = (int)((long)F.bx * M / F.G), r1 = (int)((long)(F.bx + 1) * M / F.G);
    if (ROUTER) {
        for (int i = F.tid; i < D * NEXP; i += NTHR) wr[i] = rw[i];
        if (F.tid < 8) lcnt[F.tid] = 0;
        __syncthreads();
    }
    for (int m = r0 + F.wave; m < r1; m += NWAVES) {
        const GAS f32x4* xr = (const GAS f32x4*)(xin + (size_t)m * D) + F.lane;
        f32x4 v[4]; float s = 0.f;
        if (MODE == 0) {
            const GAS unsigned long long* hr = (const GAS unsigned long long*)(Hb + (size_t)m * D) + F.lane;
#pragma unroll
            for (int j = 0; j < 4; ++j) { const f32x4 xv = xr[64 * j]; const unsigned long long hw = hr[64 * j]; const unsigned lo = (unsigned)hw, hi = (unsigned)(hw >> 32);
                v[j].x = ALPHA * xv.x + bflo(lo); v[j].y = ALPHA * xv.y + bfhi(lo); v[j].z = ALPHA * xv.z + bflo(hi); v[j].w = ALPHA * xv.w + bfhi(hi); }
        } else {
            const int p0 = r_p[2 * m], p1 = r_p[2 * m + 1]; const float g0 = r_g[2 * m], g1 = r_g[2 * m + 1];
            const GAS unsigned long long* h0 = (const GAS unsigned long long*)(Hb + (size_t)p0 * D) + F.lane;
            const GAS unsigned long long* h1 = (const GAS unsigned long long*)(Hb + (size_t)p1 * D) + F.lane;
#pragma unroll
            for (int j = 0; j < 4; ++j) { const f32x4 xv = xr[64 * j]; const unsigned long long a = h0[64 * j], c = h1[64 * j];
                const unsigned al = (unsigned)a, ah = (unsigned)(a >> 32), cl = (unsigned)c, ch = (unsigned)(c >> 32);
                v[j].x = ALPHA * xv.x + (g0 * bflo(al) + g1 * bflo(cl)); v[j].y = ALPHA * xv.y + (g0 * bfhi(al) + g1 * bfhi(cl));
                v[j].z = ALPHA * xv.z + (g0 * bflo(ah) + g1 * bflo(ch)); v[j].w = ALPHA * xv.w + (g0 * bfhi(ah) + g1 * bfhi(ch)); }
        }
#pragma unroll
        for (int j = 0; j < 4; ++j) s += (v[j].x + v[j].y) + (v[j].z + v[j].w);
        const float mean = wave_sum(s) * (1.f / D); float s2 = 0.f;
#pragma unroll
        for (int j = 0; j < 4; ++j) { v[j] = v[j] - mean; s2 += (v[j].x * v[j].x + v[j].y * v[j].y) + (v[j].z * v[j].z + v[j].w * v[j].w); }
        const float rstd = 1.f / sqrtf(wave_sum(s2) * (1.f / D) + LN_EPS);
        GAS f32x4* xo = (GAS f32x4*)(xout + (size_t)m * D) + F.lane;
        GAS unsigned long long* o8 = (GAS unsigned long long*)(xb + (size_t)m * D) + F.lane;
#pragma unroll
        for (int j = 0; j < 4; ++j) {
            const f32x4 gg = *((const GAS f32x4*)g + F.lane + 64 * j), bb = *((const GAS f32x4*)b + F.lane + 64 * j);
            v[j] = v[j] * rstd * gg + bb; xo[64 * j] = v[j];
            if (WRITE_XB) o8[64 * j] = (unsigned long long)pk2(v[j].x, v[j].y) | ((unsigned long long)pk2(v[j].z, v[j].w) << 32);
        }
        if (ROUTER) {
            float pl[NEXP];
#pragma unroll
            for (int e = 0; e < NEXP; ++e) pl[e] = 0.f;
#pragma unroll
            for (int j = 0; j < 4; ++j)
#pragma unroll
                for (int c = 0; c < 4; ++c) { const float xv = v[j][c]; const LAS f32x4* w4 = (const LAS f32x4*)(wr + (size_t)(4 * F.lane + 256 * j + c) * NEXP); const f32x4 wa = w4[0], wb = w4[1];
                    pl[0] += xv * wa.x; pl[1] += xv * wa.y; pl[2] += xv * wa.z; pl[3] += xv * wa.w; pl[4] += xv * wb.x; pl[5] += xv * wb.y; pl[6] += xv * wb.z; pl[7] += xv * wb.w; }
            float best0 = -INFINITY, best1 = -INFINITY; int e0 = 0, e1 = 0;
#pragma unroll
            for (int e = 0; e < NEXP; ++e) { const float l = wave_sum(pl[e]) + rb[e];
                if (l > best0) { best1 = best0; e1 = e0; best0 = l; e0 = e; } else if (l > best1) { best1 = l; e1 = e; } }
            const float ex = __expf(best1 - best0), g0 = 1.f / (1.f + ex), g1 = ex / (1.f + ex);
            if (F.lane == 0) {
                const int k0 = atomicAdd((int*)&lcnt[e0], 1), k1 = atomicAdd((int*)&lcnt[e1], 1);
                lrk[2 * (m - r0)] = k0; lrk[2 * (m - r0) + 1] = k1; lex[2 * (m - r0)] = e0; lex[2 * (m - r0) + 1] = e1;
                r_g[2 * m] = g0; r_g[2 * m + 1] = g1;
            }
        }
    }
    if (ROUTER) {
        __syncthreads();
        if (F.tid < 8) wbase[F.tid] = (int)__hip_atomic_fetch_add((unsigned*)(F.ctl + CW_CNT + 16 * lslot + F.tid), (unsigned)lcnt[F.tid], __ATOMIC_RELAXED, __HIP_MEMORY_SCOPE_AGENT);
        __syncthreads();
        for (int i = F.tid; i < 2 * (r1 - r0); i += NTHR) { const int e = lex[i]; r_e[2 * r0 + i] = e; r_i[2 * r0 + i] = wbase[e] + lrk[i]; }
        __syncthreads();
    }
}

__device__ __forceinline__ void moe_scatter(Frame& F, int lslot) {
    const int* r_e = (const int*)(F.ws + WS_ROUTE); const int* r_i = (const int*)(F.ws + WS_ROUTE + 512 * 1024); int* r_p = (int*)(F.ws + WS_ROUTE + 768 * 1024);
    const bf16* xb = (const bf16*)(F.ws + WS_XB); bf16* xp = (bf16*)(F.ws + WS_XPERM);
    int sb[NEXP]; { int a = 0;
#pragma unroll
        for (int e = 0; e < NEXP; ++e) { sb[e] = a; a += (int)((F.ctl[CW_CNT + 16 * lslot + e] + 255u) & ~255u); } }
    for (int ent = F.gw; ent < 2 * M; ent += F.NGW) {
        const int e = r_e[ent], idx = r_i[ent]; int base = 0;
#pragma unroll
        for (int k = 0; k < NEXP; ++k) base = (e == k) ? sb[k] : base;
        const int pos = base + idx; const int tok = ent >> 1;
        const GAS v4u* s = (const GAS v4u*)(xb + (size_t)tok * D); GAS v4u* d = (GAS v4u*)(xp + (size_t)pos * D);
        const v4u a = s[F.lane], c = s[F.lane + 64]; d[F.lane] = a; d[F.lane + 64] = c;
        if (F.lane == 0) r_p[ent] = pos;
    }
}

__device__ __forceinline__ void dsa_prep(Frame& F, int j) {
    const bf16* P = (const bf16*)(F.ws + WS_P); bf16* KD = (bf16*)(F.ws + WS_KD); bf16* VD = (bf16*)(F.ws + WS_VD); bf16* KI = (bf16*)(F.ws + WS_KI);
    const float* kvg = F.inp(2) + j * 128; const float* wuk = F.inp(3) + (size_t)j * 128 * 64; const float* wuv = F.inp(4) + (size_t)j * 128 * 64;
    const float* kg = F.inp(5) + j * 64; const float* kb = F.inp(6) + j * 64;
    LAS float* s_uk = (LAS float*)F.lds; LAS float* s_uv = s_uk + 8192; LAS float* s_c = s_uv + 8192 + F.wave * 128;
    for (int i = F.tid; i < 8192; i += NTHR) { s_uk[i] = wuk[i]; s_uv[i] = wuv[i]; }
    __syncthreads();
    const float g0 = kvg[2 * F.lane], g1 = kvg[2 * F.lane + 1], kgl = kg[F.lane], kbl = kb[F.lane];
    for (int m = F.gw; m < M; m += F.NGW) {
        const bf16* pr = P + (size_t)m * EINP;
        const unsigned cw = *(const unsigned*)(pr + PC_CKV + 2 * F.lane);
        float c0 = bflo(cw), c1 = bfhi(cw);
        const float rs = 1.f / sqrtf(wave_sum(c0 * c0 + c1 * c1) * (1.f / 128.f) + RMS_EPS);
        s_c[2 * F.lane] = c0 * rs * g0; s_c[2 * F.lane + 1] = c1 * rs * g1;
        LDS_WAIT(); asm volatile("" ::: "memory");
        float ak = 0.f, av = 0.f;
#pragma unroll 8
        for (int c = 0; c < 128; ++c) { const float cv = s_c[c]; ak += cv * s_uk[c * 64 + F.lane]; av += cv * s_uv[c * 64 + F.lane]; }
        KD[(size_t)m * 64 + F.lane] = (bf16)f2bf(ak * C2); VD[(size_t)m * 64 + F.lane] = (bf16)f2bf(av);
        const float kv = bf2f(pr[PC_KI + F.lane]);
        const float mean = wave_sum(kv) * (1.f / 64.f); const float dv = kv - mean;
        const float var = wave_sum(dv * dv) * (1.f / 64.f);
        KI[(size_t)m * 64 + F.lane] = (bf16)f2bf(dv * (1.f / sqrtf(var + LN_EPS)) * kgl + kbl);
        LDS_WAIT(); asm volatile("" ::: "memory");
    }
    __syncthreads();
}
__device__ __forceinline__ void gla_prep(Frame& F, int j) {
    const bf16* P = (const bf16*)(F.ws + WS_P); bf16* QT = (bf16*)(F.ws + WS_QT); bf16* KT = (bf16*)(F.ws + WS_KT);
    float* EBL = (float*)(F.ws + WS_EBL); float* GST = (float*)(F.ws + WS_GST);
    const float* wg2 = F.inp(7) + (size_t)j * 16 * 256; const float* bgb = F.inp(8) + j * 256;
    LAS float* sG = (LAS float*)F.lds;
    LAS float* sKH = sG + 64 * 65;
    LAS float* sV = sKH + 64 * 65;
    LAS float* sBG = sV + 64 * 128;
    LAS float* sW = sBG + 64 * 16;
    for (int unit = F.bx; unit < BATCH * 32 * 4; unit += F.G) {
        const int h = unit & 3, bc = unit >> 2, tok0 = bc * 64;
        for (int i = F.tid; i < 64 * 16; i += NTHR) { const int t = i >> 4, r = i & 15; sBG[i] = bf2f(P[(size_t)(tok0 + t) * EINP + PC_BG + r]); sW[i] = wg2[(i >> 6) * 256 + h * 64 + (i & 63)]; }
        for (int i = F.tid; i < 64 * 128; i += NTHR) { const int t = i >> 7, e = i & 127; sV[i] = bf2f(P[(size_t)(tok0 + t) * EINP + PC_BV + h * 128 + e]); }
        __syncthreads();
        for (int i = F.tid; i < 4096; i += NTHR) { const int t = i >> 6, d = i & 63; float z = bgb[h * 64 + d];
#pragma unroll
            for (int r = 0; r < 16; ++r) z += sBG[t * 16 + r] * sW[r * 64 + d];
            const float ls = fminf(z, 0.f) - log1pf(__expf(-fabsf(z)));
            sG[t * 65 + d] = ls * (1.f / 16.f); }
        __syncthreads();
        if (F.tid < 64) { float run = 0.f; for (int t = 0; t < 64; ++t) { run += sG[t * 65 + F.tid]; sG[t * 65 + F.tid] = run; } }
        __syncthreads();
        for (int i = F.tid; i < 4096; i += NTHR) { const int t = i >> 6, d = i & 63; const float bb = sG[t * 65 + d], bl = sG[63 * 65 + d];
            const size_t po = (size_t)(tok0 + t) * EINP; const float q = bf2f(P[po + PC_BQ + h * 64 + d]) * 0.125f, k = bf2f(P[po + PC_BK + h * 64 + d]);
            QT[(size_t)(tok0 + t) * 256 + h * 64 + d] = (bf16)f2bf(q * __expf(bb)); KT[(size_t)(tok0 + t) * 256 + h * 64 + d] = (bf16)f2bf(k * __expf(-bb));
            sKH[t * 65 + d] = k * __expf(bl - bb);
            if (t == 63) EBL[(size_t)bc * 256 + h * 64 + d] = __expf(bl); }
        __syncthreads();
        { const int e = F.tid & 127, dq = F.tid >> 7; float acc[16];
#pragma unroll
            for (int i = 0; i < 16; ++i) acc[i] = 0.f;
            for (int t = 0; t < 64; ++t) { const float vv = sV[t * 128 + e];
#pragma unroll
                for (int i = 0; i < 16; ++i) acc[i] += sKH[t * 65 + dq + 4 * i] * vv; }
#pragma unroll
            for (int i = 0; i < 16; ++i) GST[(size_t)unit * 8192 + (dq + 4 * i) * 128 + e] = acc[i]; }
        __syncthreads();
    }
}
__device__ __forceinline__ void gla_scan(Frame& F) {
    float* GST = (float*)(F.ws + WS_GST); const float* EBL = (const float*)(F.ws + WS_EBL);
    const int gt = F.bx * NTHR + F.tid, NG = F.G * NTHR;
    for (int idx = gt; idx < BATCH * 4 * 8192; idx += NG) {
        const int de = idx & 8191, h = (idx >> 13) & 3, b = idx >> 15, d = de >> 7;
        float S = 0.f;
#pragma unroll 8
        for (int c = 0; c < 32; ++c) { const size_t off = (size_t)(((b * 32 + c) << 2) + h) * 8192 + de; const float a = GST[off]; GST[off] = S; S = EBL[(size_t)(b * 32 + c) * 256 + h * 64 + d] * S + a; }
    }
}
__device__ __forceinline__ void gla_out(Frame& F, int j) {
    const bf16* P = (const bf16*)(F.ws + WS_P); const bf16* QT = (const bf16*)(F.ws + WS_QT); const bf16* KT = (const bf16*)(F.ws + WS_KT);
    const float* GST = (const float*)(F.ws + WS_GST); bf16* MIX = (bf16*)(F.ws + WS_MIX); const float* ng = F.inp(9) + j * 512;
    LAS float* sQ = (LAS float*)F.lds;
    LAS float* sK = sQ + 64 * 65;
    LAS float* sSC = sK + 64 * 65;
    LAS float* sV = sSC + 64 * 65;
    LAS float* sS = sV + 64 * 128;
    for (int unit = F.bx; unit < BATCH * 32 * 4; unit += F.G) {
        const int h = unit & 3, bc = unit >> 2, tok0 = bc * 64;
        for (int i = F.tid; i < 4096; i += NTHR) { const int t = i >> 6, d = i & 63; sQ[t * 65 + d] = bf2f(QT[(size_t)(tok0 + t) * 256 + h * 64 + d]); sK[t * 65 + d] = bf2f(KT[(size_t)(tok0 + t) * 256 + h * 64 + d]); }
        for (int i = F.tid; i < 8192; i += NTHR) { const int t = i >> 7, e = i & 127; sV[i] = bf2f(P[(size_t)(tok0 + t) * EINP + PC_BV + h * 128 + e]); sS[i] = GST[(size_t)unit * 8192 + i]; }
        __syncthreads();
        for (int i = F.tid; i < 4096; i += NTHR) { const int ti = i >> 6, tj = i & 63; float s = 0.f;
            if (tj <= ti) {
#pragma unroll 16
                for (int d = 0; d < 64; ++d) s += sQ[ti * 65 + d] * sK[tj * 65 + d]; }
            sSC[ti * 65 + tj] = s; }
        __syncthreads();
        float acc[16];
        { const int e = F.tid & 127, iq = F.tid >> 7;
#pragma unroll
            for (int i = 0; i < 16; ++i) acc[i] = 0.f;
            for (int t = 0; t < 64; ++t) { const float vv = sV[t * 128 + e], sv = sS[t * 128 + e];
#pragma unroll
                for (int i = 0; i < 16; ++i) acc[i] += sSC[(iq + 4 * i) * 65 + t] * vv + sQ[(iq + 4 * i) * 65 + t] * sv; }
            __syncthreads();
#pragma unroll
            for (int i = 0; i < 16; ++i) sS[(iq + 4 * i) * 128 + e] = acc[i]; }
        __syncthreads();
        for (int i = F.wave; i < 64; i += NWAVES) {
            const float o0 = sS[i * 128 + 2 * F.lane], o1 = sS[i * 128 + 2 * F.lane + 1];
            const float rs = 1.f / sqrtf(wave_sum(o0 * o0 + o1 * o1) * (1.f / 128.f) + RMS_EPS);
            const size_t tok = tok0 + i; const unsigned rw = *(const unsigned*)(P + tok * EINP + PC_BR + h * 128 + 2 * F.lane);
            const float v0 = o0 * rs * ng[h * 128 + 2 * F.lane] * silu_f(bflo(rw)), v1 = o1 * rs * ng[h * 128 + 2 * F.lane + 1] * silu_f(bfhi(rw));
            *(unsigned*)(MIX + tok * D + 512 + h * 128 + 2 * F.lane) = pk2(v0, v1);
        }
        __syncthreads();
    }
}

__device__ __forceinline__ unsigned mono_key(float f) { const unsigned u = __float_as_uint(f); return (u & 0x80000000u) ? ~u : (u | 0x80000000u); }
__device__ __forceinline__ void dsa_simple(Frame& F) {
    const bf16* P = (const bf16*)(F.ws + WS_P); const bf16* KD = (const bf16*)(F.ws + WS_KD); const bf16* VD = (const bf16*)(F.ws + WS_VD); const bf16* KI = (const bf16*)(F.ws + WS_KI);
    bf16* MIX = (bf16*)(F.ws + WS_MIX);
    LAS unsigned* sKey = (LAS unsigned*)(F.lds + F.wave * 11264);
    LAS float* sP = (LAS float*)sKey;
    LAS float* sQ = (LAS float*)(F.lds + F.wave * 11264 + 8192);
    LAS int* sSel = (LAS int*)(F.lds + F.wave * 11264 + 10240);
    const int lane = F.lane;
    for (int qi = F.gw; qi < M; qi += F.NGW) {
        const int b = qi >> 11, i = qi & 2047; const bf16* pr = P + (size_t)qi * EINP;
        { float f[8]; ld8bf(pr + PC_QI + 8 * lane, f);
#pragma unroll
            for (int c = 0; c < 8; ++c) sQ[8 * lane + c] = f[c]; }
        float w[8]; { float f[8]; ld8bf(pr + PC_WI, f);
#pragma unroll
            for (int c = 0; c < 8; ++c) w[c] = f[c]; }
        LDS_WAIT(); asm volatile("" ::: "memory");
#pragma unroll 1
        for (int jj = 0; jj < 32; ++jj) {
            const int jk = jj * 64 + lane; unsigned key = 0u;
            if (jj * 64 <= i) {
                if (jk <= i) {
                    float kk[64]; const bf16* kr = KI + (size_t)(b * SEQ + jk) * 64;
#pragma unroll
                    for (int c = 0; c < 8; ++c) ld8bf(kr + 8 * c, kk + 8 * c);
                    float sc = 0.f;
#pragma unroll
                    for (int h = 0; h < 8; ++h) { float dt = 0.f;
#pragma unroll
                        for (int d4 = 0; d4 < 16; ++d4) { const f32x4 q4 = *(const LAS f32x4*)(sQ + h * 64 + 4 * d4); dt += q4.x * kk[4 * d4] + q4.y * kk[4 * d4 + 1] + q4.z * kk[4 * d4 + 2] + q4.w * kk[4 * d4 + 3]; }
                        sc += w[h] * fmaxf(dt, 0.f); }
                    key = mono_key(sc);
                }
            }
            sKey[jk] = key;
        }
        LDS_WAIT(); asm volatile("" ::: "memory");
        unsigned u[32];
#pragma unroll
        for (int r = 0; r < 8; ++r) { const v4u t = *(const LAS v4u*)(sKey + 32 * lane + 4 * r); u[4 * r] = t.x; u[4 * r + 1] = t.y; u[4 * r + 2] = t.z; u[4 * r + 3] = t.w; }
        unsigned mask = 0u;
        if (i + 1 <= TOPK) {
#pragma unroll
            for (int r = 0; r < 32; ++r) mask |= (u[r] != 0u) ? (1u << r) : 0u;
        } else {
            unsigned T = 0u;
#pragma unroll 1
            for (int bit = 31; bit >= 0; --bit) { const unsigned cand = T | (1u << bit); int c = 0;
#pragma unroll
                for (int r = 0; r < 32; ++r) c += (u[r] >= cand) ? 1 : 0;
                if (wave_sum_i(c) >= TOPK) T = cand; }
            int cg = 0, ce = 0;
#pragma unroll
            for (int r = 0; r < 32; ++r) { cg += (u[r] > T) ? 1 : 0; ce += (u[r] == T) ? 1 : 0; }
            const int need = TOPK - wave_sum_i(cg); int pe = wave_incl_scan_i(ce, lane) - ce;
#pragma unroll
            for (int r = 0; r < 32; ++r) { if (u[r] > T) mask |= (1u << r); else if (u[r] == T) { if (pe < need) mask |= (1u << r); ++pe; } }
        }
        const int pc = __popc(mask); int px = wave_incl_scan_i(pc, lane) - pc; const int nsel = wave_sum_i(pc);
        { unsigned mm = mask; while (mm) { const int r = __ffs(mm) - 1; mm &= mm - 1; sSel[px++] = 32 * lane + r; } }
        { float f[8]; ld8bf(pr + PC_AQ + 8 * lane, f);
#pragma unroll
            for (int c = 0; c < 8; ++c) sQ[8 * lane + c] = f[c]; }
        LDS_WAIT(); asm volatile("" ::: "memory");
        float mx[8];
#pragma unroll
        for (int h = 0; h < 8; ++h) mx[h] = -INFINITY;
#pragma unroll 1
        for (int s4 = 0; s4 < 4; ++s4) { const int s = s4 * 64 + lane;
            if (s < nsel) { const int jk = sSel[s]; float kk[64]; const bf16* kr = KD + (size_t)(b * SEQ + jk) * 64;
#pragma unroll
                for (int c = 0; c < 8; ++c) ld8bf(kr + 8 * c, kk + 8 * c);
#pragma unroll
                for (int h = 0; h < 8; ++h) { float dt = 0.f;
#pragma unroll
                    for (int d4 = 0; d4 < 16; ++d4) { const f32x4 q4 = *(const LAS f32x4*)(sQ + h * 64 + 4 * d4); dt += q4.x * kk[4 * d4] + q4.y * kk[4 * d4 + 1] + q4.z * kk[4 * d4 + 2] + q4.w * kk[4 * d4 + 3]; }
                    sP[h * 256 + s] = dt; mx[h] = fmaxf(mx[h], dt); } } }
        float li[8];
#pragma unroll
        for (int h = 0; h < 8; ++h) { mx[h] = wave_max(mx[h]); float l = 0.f;
            for (int s4 = 0; s4 < 4; ++s4) { const int s = s4 * 64 + lane; if (s < nsel) { const float p = __builtin_amdgcn_exp2f(sP[h * 256 + s] - mx[h]); sP[h * 256 + s] = p; l += p; } }
            li[h] = 1.f / wave_sum(l); }
        LDS_WAIT(); asm volatile("" ::: "memory");
        float acc[8];
#pragma unroll
        for (int h = 0; h < 8; ++h) acc[h] = 0.f;
        for (int s = 0; s < nsel; ++s) { const int jk = sSel[s]; const float vv = bf2f(VD[(size_t)(b * SEQ + jk) * 64 + lane]);
#pragma unroll
            for (int h = 0; h < 8; ++h) acc[h] += sP[h * 256 + s] * vv; }
#pragma unroll
        for (int h = 0; h < 8; ++h) MIX[(size_t)qi * D + h * 64 + lane] = (bf16)f2bf(acc[h] * li[h]);
        LDS_WAIT(); asm volatile("" ::: "memory");
    }
}

__device__ __forceinline__ void diffattn_simple(Frame& F, int j, float lam_init) {
    const bf16* QKV = (const bf16*)(F.ws + WS_QKV); bf16* MIXO = (bf16*)(F.ws + WS_MIXO);
    const float* sg = F.inp(23) + j * 128;
    LAS float* s0 = (LAS float*)(F.lds + F.wave * 16384);
    LAS float* s1 = s0 + 2048;
    LAS float* sq = (LAS float*)(F.lds + XTRA_OFF + F.wave * 512);
    const int lane = F.lane;
    float lam; { const float a = wave_sum(F.inp(19)[j * 64 + lane] * F.inp(20)[j * 64 + lane]), c = wave_sum(F.inp(21)[j * 64 + lane] * F.inp(22)[j * 64 + lane]); lam = __expf(a) - __expf(c) + lam_init; }
    const float g0 = sg[2 * lane], g1 = sg[2 * lane + 1];
    for (int un = F.gw; un < M * 8; un += F.NGW) {
        const int h = un & 7, qi = un >> 3, b = qi >> 11, i = qi & 2047;
        { const unsigned qw = *(const unsigned*)(QKV + (size_t)qi * 3072 + h * 128 + 2 * lane); sq[2 * lane] = bflo(qw) * C2; sq[2 * lane + 1] = bfhi(qw) * C2; }
        LDS_WAIT(); asm volatile("" ::: "memory");
        float m0 = -INFINITY, m1 = -INFINITY;
        for (int jj = 0; jj * 64 <= i; ++jj) { const int jk = jj * 64 + lane;
            if (jk <= i) { const bf16* kr = QKV + (size_t)(b * SEQ + jk) * 3072 + 1024 + h * 128; float kk[64]; float d0 = 0.f, d1 = 0.f;
#pragma unroll
                for (int c = 0; c < 8; ++c) ld8bf(kr + 8 * c, kk + 8 * c);
#pragma unroll
                for (int d4 = 0; d4 < 16; ++d4) { const f32x4 q4 = *(const LAS f32x4*)(sq + 4 * d4); d0 += q4.x * kk[4 * d4] + q4.y * kk[4 * d4 + 1] + q4.z * kk[4 * d4 + 2] + q4.w * kk[4 * d4 + 3]; }
#pragma unroll
                for (int c = 0; c < 8; ++c) ld8bf(kr + 64 + 8 * c, kk + 8 * c);
#pragma unroll
                for (int d4 = 0; d4 < 16; ++d4) { const f32x4 q4 = *(const LAS f32x4*)(sq + 64 + 4 * d4); d1 += q4.x * kk[4 * d4] + q4.y * kk[4 * d4 + 1] + q4.z * kk[4 * d4 + 2] + q4.w * kk[4 * d4 + 3]; }
                s0[jk] = d0; s1[jk] = d1; m0 = fmaxf(m0, d0); m1 = fmaxf(m1, d1); } }
        m0 = wave_max(m0); m1 = wave_max(m1);
        float l0 = 0.f, l1 = 0.f;
        for (int jj = 0; jj * 64 <= i; ++jj) { const int jk = jj * 64 + lane; if (jk <= i) { const float e0 = __builtin_amdgcn_exp2f(s0[jk] - m0), e1 = __builtin_amdgcn_exp2f(s1[jk] - m1); s0[jk] = e0; s1[jk] = e1; l0 += e0; l1 += e1; } }
        l0 = 1.f / wave_sum(l0); l1 = lam / wave_sum(l1);
        for (int jj = 0; jj * 64 <= i; ++jj) { const int jk = jj * 64 + lane; if (jk <= i) s0[jk] = s0[jk] * l0 - s1[jk] * l1; }
        LDS_WAIT(); asm volatile("" ::: "memory");
        float a0 = 0.f, a1 = 0.f; const bf16* vb = QKV + (size_t)(b * SEQ) * 3072 + 2048 + h * 128 + 2 * lane;
        int jk = 0;
        for (; jk + 4 <= i + 1; jk += 4) {
            const unsigned v0 = *(const unsigned*)(vb + (size_t)jk * 3072), v1 = *(const unsigned*)(vb + (size_t)(jk + 1) * 3072), v2 = *(const unsigned*)(vb + (size_t)(jk + 2) * 3072), v3 = *(const unsigned*)(vb + (size_t)(jk + 3) * 3072);
            const f32x4 w4 = *(const LAS f32x4*)(s0 + jk);
            a0 += w4.x * bflo(v0) + w4.y * bflo(v1) + w4.z * bflo(v2) + w4.w * bflo(v3); a1 += w4.x * bfhi(v0) + w4.y * bfhi(v1) + w4.z * bfhi(v2) + w4.w * bfhi(v3); }
        for (; jk <= i; ++jk) { const unsigned v0 = *(const unsigned*)(vb + (size_t)jk * 3072); const float wv = s0[jk]; a0 += wv * bflo(v0); a1 += wv * bfhi(v0); }
        const float rs = 1.f / sqrtf(wave_sum(a0 * a0 + a1 * a1) * (1.f / 128.f) + RMS_EPS) * (1.f - lam_init);
        *(unsigned*)(MIXO + (size_t)qi * D + h * 128 + 2 * lane) = pk2(a0 * rs * g0, a1 * rs * g1);
        LDS_WAIT(); asm volatile("" ::: "memory");
    }
}

struct Args { const float* in[34]; float* out; unsigned char* ws; int lo, hi; };
constexpr int PH_PER_PAIR = 17, NPHASE = 1 + 2 * PH_PER_PAIR;
#ifndef PHMASK
#define PHMASK 0x3F7E3u
#endif
#define PHON(k) (((PHMASK) >> (k)) & 1u)

__device__ __forceinline__ void frame_refresh(Frame& F) {
    int t = threadIdx.x; asm volatile("" : "+v"(t));
    int bx = blockIdx.x; asm volatile("" : "+s"(bx));
    const __attribute__((address_space(4))) unsigned char* kp = (const __attribute__((address_space(4))) unsigned char*)__builtin_amdgcn_kernarg_segment_ptr(); asm volatile("" : "+s"(kp));
    typedef unsigned char* ucp; unsigned char* w = *(const __attribute__((address_space(4))) ucp*)(kp + 280);
    F.kp = kp; F.tid = t; F.lane = t & 63; F.wave = __builtin_amdgcn_readfirstlane(t >> 6);
    F.bx = bx; F.gw = bx * NWAVES + F.wave; F.ws = w; F.ctl = (gu32*)(w + WS_CTL);
}

__global__ void __launch_bounds__(NTHR, 2) mega_fwd(Args args) {
    extern __shared__ __attribute__((aligned(16))) unsigned char lds[];
    Frame F;
    F.lds = (LAS unsigned char*)lds; F.MISC = (volatile LAS unsigned*)(F.lds + MISC_OFF);
    F.G = gridDim.x; F.NGW = F.G * NWAVES;
    frame_refresh(F);
    for (int u = F.tid; u < (LDS_BYTES - LDSCTL_OFF) / 4; u += NTHR) ((LAS unsigned*)(F.lds + LDSCTL_OFF))[u] = 0u;
    __syncthreads();
    const int lo = args.lo, hi = args.hi;
    const bool use_bar = (hi - lo) > 1;
    XcdBarrier bar; bar.bar = (unsigned*)(F.ctl + CW_BAR); bar.x = 0; bar.st = nullptr;
    if (use_bar) bar = xcd_barrier_post((unsigned*)(F.ctl + CW_BAR), F.MISC + 8);
#define IN(k) (lo <= (k) && (k) < hi)
#define SEAM(k) do { if (IN((k) + 1)) xcd_barrier(bar); } while (0)
#define WSB(off) ((bf16*)(F.ws + (off)))

    if (PHON(0) && IN(0)) { frame_refresh(F); cvt_even(F, 0); xb_from_x(F); SEAM(0); }

    for (int lp = 0; lp < 2; ++lp) {
        const int pb = 1 + PH_PER_PAIR * lp;
        if (PHON(1) && IN(pb + 0)) {
            frame_refresh(F);
            pg8::Gemm g{WSB(WS_XB), WSB(WS_WB + WB_WIN), M, EINP, D}; pg8::StaticOrder S; S.init(M, EINP, F.G, F.bx);
            pg8::EpiBf16<0> E{WSB(WS_P), EINP, nullptr, 0, 0, 1.f};
            pg8::gemm_phase<pg8::EpiBf16<0>, pg8::StaticOrder, true, true>(F.lds, g, S, E, F.tid);
            SEAM(pb + 0);
        }
        if (PHON(2) && IN(pb + 1)) { frame_refresh(F); dsa_prep(F, lp); gla_prep(F, lp); SEAM(pb + 1); }
        if (PHON(3) && IN(pb + 2)) { frame_refresh(F); gla_scan(F); SEAM(pb + 2); }
        if (PHON(4) && IN(pb + 3)) { frame_refresh(F); dsa_simple(F); __syncthreads(); gla_out(F, lp); SEAM(pb + 3); }
        if (PHON(5) && IN(pb + 4)) {
            frame_refresh(F);
            pg8::Gemm g{WSB(WS_MIX), WSB(WS_WB + WB_WOUT), M, D, D}; pg8::StaticOrder S; S.init(M, D, F.G, F.bx);
            pg8::EpiBf16<0> E{WSB(WS_H_EVEN), D, nullptr, 0, 0, 1.f};
            pg8::gemm_phase<pg8::EpiBf16<0>, pg8::StaticOrder, true, true>(F.lds, g, S, E, F.tid);
            SEAM(pb + 4);
        }
        if (PHON(6) && IN(pb + 5)) { frame_refresh(F); const float* xin_even = (lp == 0) ? F.inp(0) : (const float*)F.outp();
            ln_phase<0, false, true>(F, xin_even, WSB(WS_H_EVEN), F.inp(11) + lp * D, F.inp(12) + lp * D, F.outp(), WSB(WS_XB), nullptr, nullptr, 0); SEAM(pb + 5); }
        if (PHON(7) && IN(pb + 6)) {
            frame_refresh(F);
            pg8::Gemm g{WSB(WS_XB), WSB(WS_WB + WB_WGU), M, 2 * FF, D}; pg8::StaticOrder S; S.init(M, 2 * FF, F.G, F.bx);
            pg8::EpiSwiGLU E{WSB(WS_HID), FF};
            pg8::gemm_phase<pg8::EpiSwiGLU, pg8::StaticOrder, true, true>(F.lds, g, S, E, F.tid);
            SEAM(pb + 6);
        }
        if (PHON(8) && IN(pb + 7)) {
            frame_refresh(F);
            pg8::Gemm g{WSB(WS_HID), WSB(WS_WB + WB_WDN), M, D, FF}; pg8::StaticOrder S; S.init(M, D, F.G, F.bx);
            pg8::EpiBf16<0> E{WSB(WS_H_EVEN), D, nullptr, 0, 0, 1.f};
            pg8::gemm_phase<pg8::EpiBf16<0>, pg8::StaticOrder, true, true>(F.lds, g, S, E, F.tid);
            SEAM(pb + 7);
        }
        if (PHON(9) && IN(pb + 8)) {
            frame_refresh(F);
            ln_phase<0, false, true>(F, (const float*)F.outp(), WSB(WS_H_EVEN), F.inp(16) + lp * D, F.inp(17) + lp * D, F.outp(), WSB(WS_XB), nullptr, nullptr, 0);
            __syncthreads(); cvt_odd(F, lp); SEAM(pb + 8);
        }
        if (PHON(10) && IN(pb + 9)) {
            frame_refresh(F);
            pg8::Gemm g{WSB(WS_XB), WSB(WS_WB + WB_WQKV), M, 3072, D}; pg8::StaticOrder S; S.init(M, 3072, F.G, F.bx);
            pg8::EpiBf16<0> E{WSB(WS_QKV), 3072, nullptr, 0, 0, 1.f};
            pg8::gemm_phase<pg8::EpiBf16<0>, pg8::StaticOrder, true, true>(F.lds, g, S, E, F.tid);
            SEAM(pb + 9);
        }
        if (PHON(11) && IN(pb + 10)) { frame_refresh(F); const float lam_init = 0.8f - 0.6f * __expf(-0.3f * (float)(2 * lp + 1)); diffattn_simple(F, lp, lam_init); SEAM(pb + 10); }
        if (PHON(12) && IN(pb + 11)) {
            frame_refresh(F);
            pg8::Gemm g{WSB(WS_MIXO), WSB(WS_WB + WB_WOUT), M, D, D}; pg8::StaticOrder S; S.init(M, D, F.G, F.bx);
            pg8::EpiBf16<0> E{WSB(WS_H_ODD), D, nullptr, 0, 0, 1.f};
            pg8::gemm_phase<pg8::EpiBf16<0>, pg8::StaticOrder, true, true>(F.lds, g, S, E, F.tid);
            SEAM(pb + 11);
        }
        if (PHON(13) && IN(pb + 12)) { frame_refresh(F);
            ln_phase<0, true, true>(F, (const float*)F.outp(), WSB(WS_H_ODD), F.inp(25) + lp * D, F.inp(26) + lp * D, F.outp(), WSB(WS_XB), F.inp(27) + (size_t)lp * D * NEXP, F.inp(28) + lp * NEXP, lp); SEAM(pb + 12); }
        if (PHON(14) && IN(pb + 13)) { frame_refresh(F); moe_scatter(F, lp); SEAM(pb + 13); }
        if (PHON(15) && IN(pb + 14)) {
            frame_refresh(F);
            pg8::MoeOrder S; S.init((const unsigned*)(F.ctl + CW_CNT + 16 * lp), 22, F.G, F.bx);
            pg8::Gemm g{WSB(WS_XPERM), WSB(WS_WB + WB_MGU), S.so.nM * 256, 2 * FF, D};
            pg8::EpiSwiGLU E{WSB(WS_HIDP), FF};
            pg8::gemm_phase<pg8::EpiSwiGLU, pg8::MoeOrder, true, true>(F.lds, g, S, E, F.tid);
            SEAM(pb + 14);
        }
        if (PHON(16) && IN(pb + 15)) {
            frame_refresh(F);
            pg8::MoeOrder S; S.init((const unsigned*)(F.ctl + CW_CNT + 16 * lp), 4, F.G, F.bx);
            pg8::Gemm g{WSB(WS_HIDP), WSB(WS_WB + WB_MDN), S.so.nM * 256, D, FF};
            pg8::EpiBf16<0> E{WSB(WS_XPERM), D, nullptr, 0, 0, 1.f};
            pg8::gemm_phase<pg8::EpiBf16<0>, pg8::MoeOrder, true, true>(F.lds, g, S, E, F.tid);
            SEAM(pb + 15);
        }
        if (PHON(17) && IN(pb + 16)) {
            frame_refresh(F);
            ln_phase<1, false, true>(F, (const float*)F.outp(), WSB(WS_XPERM), F.inp(32) + lp * D, F.inp(33) + lp * D, F.outp(), WSB(WS_XB), nullptr, nullptr, 0);
            if (lp == 0) { __syncthreads(); cvt_even(F, 1); SEAM(pb + 16); }
        }
    }
#undef IN
#undef SEAM
}

template <int W> __global__ void __launch_bounds__(NTHR, 2) k_simple(Args args, int lp) {
    extern __shared__ __attribute__((aligned(16))) unsigned char lds[];
    Frame F;
    F.lds = (LAS unsigned char*)lds; F.MISC = (volatile LAS unsigned*)(F.lds + MISC_OFF);
    F.G = gridDim.x; F.NGW = F.G * NWAVES;
    frame_refresh(F);
    if (W == 0) { dsa_prep(F, lp); gla_prep(F, lp); }
    if (W == 1) { gla_scan(F); }
    if (W == 2) { dsa_simple(F); }
    if (W == 3) { gla_out(F, lp); }
    if (W == 4) { const float lam_init = 0.8f - 0.6f * __expf(-0.3f * (float)(2 * lp + 1)); diffattn_simple(F, lp, lam_init); }
}

#ifndef MK_SINGLE
#define MK_SINGLE 0
#endif
extern "C" void kernel_launch(void* const* d_in, const int* in_sizes, int n_in, void* d_out, int out_size, void* d_ws, size_t ws_size, hipStream_t stream) {
    static int grid = 0;
    if (grid == 0) {
        if (n_in != 34 || in_sizes[0] != M * D || out_size != M * D || ws_size < WS_END) { fprintf(stderr, "kernel_launch: unexpected shapes or workspace (n_in %d, ws %zu)\n", n_in, ws_size); grid = -1; return; }
        int dev = 0, cus = 0, per_cu = 0;
        if (hipGetDevice(&dev) != hipSuccess || hipDeviceGetAttribute(&cus, hipDeviceAttributeMultiprocessorCount, dev) != hipSuccess) { grid = -1; return; }
        if (hipFuncSetAttribute((const void*)mega_fwd, hipFuncAttributeMaxDynamicSharedMemorySize, LDS_BYTES) != hipSuccess) { grid = -1; return; }
        (void)hipFuncSetAttribute((const void*)k_simple<0>, hipFuncAttributeMaxDynamicSharedMemorySize, LDS_BYTES); (void)hipFuncSetAttribute((const void*)k_simple<1>, hipFuncAttributeMaxDynamicSharedMemorySize, LDS_BYTES);
        (void)hipFuncSetAttribute((const void*)k_simple<2>, hipFuncAttributeMaxDynamicSharedMemorySize, LDS_BYTES); (void)hipFuncSetAttribute((const void*)k_simple<3>, hipFuncAttributeMaxDynamicSharedMemorySize, LDS_BYTES);
        (void)hipFuncSetAttribute((const void*)k_simple<4>, hipFuncAttributeMaxDynamicSharedMemorySize, LDS_BYTES);
        if (hipOccupancyMaxActiveBlocksPerMultiprocessor(&per_cu, (const void*)mega_fwd, NTHR, LDS_BYTES) != hipSuccess || per_cu < 1) fprintf(stderr, "kernel_launch: occupancy query says %d\n", per_cu);
        (void)hipGetLastError();
        grid = cus;
    }
    if (grid < 0) return;
    (void)hipMemsetAsync((char*)d_ws + WS_CTL, 0, CTL_ZERO_BYTES, stream);
    Args a{};
    for (int i = 0; i < 34; ++i) a.in[i] = (const float*)d_in[i];
    a.out = (float*)d_out; a.ws = (unsigned char*)d_ws;
#if MK_SINGLE
    a.lo = 0; a.hi = NPHASE;
    hipLaunchKernelGGL(mega_fwd, dim3(grid), dim3(NTHR), LDS_BYTES, stream, a);
#else
    for (int p = 0; p < NPHASE; ++p) {
        a.lo = p; a.hi = p + 1;
        const int loc = p >= 1 ? (p - 1) % PH_PER_PAIR : -1, lp = p >= 1 ? (p - 1) / PH_PER_PAIR : 0;
        if (loc == 1) hipLaunchKernelGGL(k_simple<0>, dim3(grid), dim3(NTHR), LDS_BYTES, stream, a, lp);
        else if (loc == 2) hipLaunchKernelGGL(k_simple<1>, dim3(grid), dim3(NTHR), LDS_BYTES, stream, a, lp);
        else if (loc == 3) { hipLaunchKernelGGL(k_simple<2>, dim3(grid), dim3(NTHR), LDS_BYTES, stream, a, lp); hipLaunchKernelGGL(k_simple<3>, dim3(grid), dim3(NTHR), LDS_BYTES, stream, a, lp); }
        else if (loc == 10) hipLaunchKernelGGL(k_simple<4>, dim3(grid), dim3(NTHR), LDS_BYTES, stream, a, lp);
        else hipLaunchKernelGGL(mega_fwd, dim3(grid), dim3(NTHR), LDS_BYTES, stream, a);
    }
#endif
}
```

```cpp
#include <hip/hip_runtime.h>
#include <cstdio>
#include <cstdint>
#include <cmath>
namespace pg8 {
#define PG8_LAS __attribute__((address_space(3)))
typedef unsigned short bf16_t;
typedef short bf16x8 __attribute__((ext_vector_type(8)));
typedef float f32x4 __attribute__((ext_vector_type(4)));
typedef unsigned u32x4 __attribute__((ext_vector_type(4)));
constexpr int BM = 256, BK = 64, HALF = 128, HTB = HALF * BK * 2  , STAGE_BYTES = 8 * HTB, NXCD = 8, WGM = 5;

__host__ __device__ __forceinline__ int lds_byte(int r, int c) { const int st = (r >> 4) * 2 + (c >> 5), rr = r & 15, cc = c & 31, ob = rr * 64 + cc * 2; return st * 1024 + (ob ^ (((ob >> 9) & 1) << 5)); }
__host__ __device__ __forceinline__ void stage_rc(int b, int& R, int& C) { const int st = b / 1024, sb = b % 1024, swz = sb ^ (((sb >> 9) & 1) << 5); R = (st >> 1) * 16 + swz / 64; C = (st & 1) * 32 + (swz % 64) / 2; }
__host__ __device__ __forceinline__ int perm32(int rho) { const int n = rho >> 4, i = rho & 15; return 8 * (i >> 2) + 4 * n + (i & 3); }

struct Unit { int pm, pn, pb; };
struct Gemm { const bf16_t* A; const bf16_t* Bt; int M, N, K; const int* inv = nullptr; };

struct StaticOrder {
    int nM, nN, nwg, G, c, lim;
    __host__ __device__ void init(int M, int N, int G_, int c_) { nM = M / BM; nN = N / BM; nwg = nM * nN; G = G_; c = c_; lim = nwg; }
    __host__ __device__ bool next(int i, Unit& u) const { const long L = (long)i * G + c; if (L >= lim) return false; return at(L, u); }
    __host__ __device__ bool at(long L, Unit& u) const {
        if (L >= nwg) return false;
        int wgid = (int)L; { const int q = nwg / NXCD, r = nwg % NXCD, xcd = wgid % NXCD, off = wgid / NXCD; wgid = (xcd < r ? xcd * (q + 1) : r * (q + 1) + (xcd - r) * q) + off; }
        const int nig = WGM * nN, gid = wgid / nig, fm = gid * WGM, gsz = (nM - fm) < WGM ? (nM - fm) : WGM;
        u.pm = fm + ((wgid % nig) % gsz); u.pn = (wgid % nig) / gsz; u.pb = u.pn; return true;
    }
    __device__ __forceinline__ void a_ready(const Unit&) const {}
    __device__ __forceinline__ void done(const Unit&) const {}
};

__device__ __forceinline__ unsigned cvt_pk_bf16(float lo, float hi) { unsigned r; asm volatile("v_cvt_pk_bf16_f32 %0, %1, %2" : "=v"(r) : "v"(lo), "v"(hi)); return r; }
typedef float f32x2 __attribute__((ext_vector_type(2)));
__device__ __forceinline__ f32x2 gelu_pk(f32x2 v) {
    const f32x2 av = __builtin_elementwise_abs(v), d = av * 0.2316418882f + 1.0f;
    f32x2 t; t.x = __builtin_amdgcn_rcpf(d.x); t.y = __builtin_amdgcn_rcpf(d.y);
    f32x2 q = t * 0.5307027145f + (-0.7265760135f); q = q * t + 0.7107068705f; q = q * t + (-0.142248368f); q = q * t + 0.127414796f; q = q * t;
    const f32x2 s = (v * v) * (-0.72134752044f);
    f32x2 e; e.x = __builtin_amdgcn_exp2f(s.x); e.y = __builtin_amdgcn_exp2f(s.y);
    const f32x2 m = v * (q * e), r = v - m;
    f32x2 o; o.x = v.x < 0.f ? m.x : r.x; o.y = v.y < 0.f ? m.y : r.y; return o;
}

template <int ACT  > struct EpiBf16 {
    static constexpr bool PERM = true, AFTER_DRAIN = false; static_assert(ACT == 0 || ACT == 1, "EpiBf16: ACT is 0 (none) or 1 (gelu_pk)");
    bf16_t* O; int ldc; const float* bias; int split_cols; size_t split_stride; float scale0;
    __device__ __forceinline__ void operator()(const f32x4 (&acc)[2][2][4][2], const Unit& u, int wr, int wc, int fr, int fq) const {
        const int row0 = u.pm * BM + wr * 64 + fr; int colt = u.pn * BM; bf16_t* base = O;
        float sc = 1.f; if (split_cols) { const int t = colt / split_cols; base += (size_t)t * split_stride; colt -= t * split_cols; if (t == 0) sc = scale0; }
        const int col0 = colt + wc * 32 + 8 * fq, bcol0 = u.pn * BM + wc * 32 + 8 * fq;
        f32x4 bv[2][2];
#pragma unroll
        for (int bj = 0; bj < 2; ++bj)
#pragma unroll
            for (int n = 0; n < 2; ++n) bv[bj][n] = bias ? *(const f32x4*)(bias + bcol0 + bj * HALF + 4 * n) : (f32x4){0.f, 0.f, 0.f, 0.f};
#pragma unroll
        for (int ai = 0; ai < 2; ++ai)
#pragma unroll
            for (int m = 0; m < 4; ++m) { bf16_t* rowp = base + (size_t)(row0 + ai * HALF + m * 16) * ldc + col0;
#pragma unroll
                for (int bj = 0; bj < 2; ++bj) { f32x4 v0 = acc[ai][bj][m][0] + bv[bj][0], v1 = acc[ai][bj][m][1] + bv[bj][1];
                    if (ACT == 1) { f32x2 a = gelu_pk((f32x2){v0[0], v0[1]}), b = gelu_pk((f32x2){v0[2], v0[3]}), c = gelu_pk((f32x2){v1[0], v1[1]}), d = gelu_pk((f32x2){v1[2], v1[3]});
                        v0 = (f32x4){a.x, a.y, b.x, b.y}; v1 = (f32x4){c.x, c.y, d.x, d.y}; }
                    v0 = v0 * sc; v1 = v1 * sc; u32x4 w; w.x = cvt_pk_bf16(v0[0], v0[1]); w.y = cvt_pk_bf16(v0[2], v0[3]); w.z = cvt_pk_bf16(v1[0], v1[1]); w.w = cvt_pk_bf16(v1[2], v1[3]);
                    *(u32x4*)(rowp + bj * HALF) = w; } }
    }
};
template <class Epi, class Sched, bool ALIGN_EPI = false, bool SP2 = false, bool GATHER = false>
__device__ __forceinline__ void gemm_phase(PG8_LAS unsigned char* lds, const Gemm g, const Sched& S, const Epi& E, const int tid) {
    const int wid = __builtin_amdgcn_readfirstlane(tid >> 6), lane = tid & 63, wr = wid >> 2, wc = wid & 3, fr = lane & 15, fq = lane >> 4;
    const int K = g.K, nt = K / BK;
    unsigned voffA[2], voffB[2];
#pragma unroll
    for (int i = 0; i < 2; ++i) { int R, C; stage_rc(tid * 16 + i * 8192, R, C); const int Rb = Epi::PERM ? ((R & ~31) + perm32(R & 31)) : R;
        voffA[i] = (unsigned)(R * K + C) * 2u; voffB[i] = (unsigned)(Rb * K + C) * 2u; }
    unsigned vA[2][2], vN[2][2]; int rawN[2][2]; int gR[2], gC[2];
#pragma unroll
    for (int i = 0; i < 2; ++i) { stage_rc(tid * 16 + i * 8192, gR[i], gC[i]); vA[0][i] = vA[1][i] = vN[0][i] = vN[1][i] = voffA[i]; rawN[0][i] = rawN[1][i] = 0; }
    const size_t kstep = (size_t)(BK * 2);
    const size_t hstep = (size_t)HALF * K * 2;
    const size_t hsA = GATHER ? (size_t)0 : hstep;
    const size_t tstep = 2 * hstep;
    const unsigned ldsw = (unsigned)wid * 1024u;
    const int aoff = lds_byte(wr * 64 + fr, fq * 8), boff = lds_byte(wc * 32 + fr, fq * 8);
#define PG8_SA(b, h) (((b) * 2 + (h)) * HTB)
#define PG8_SB(b, h) ((4 + (b) * 2 + (h)) * HTB)
#define PG8_STAGE(bufoff, gbase, voff) do { _Pragma("unroll") for (int _i = 0; _i < 2; ++_i) \
        __builtin_amdgcn_global_load_lds((const unsigned*)((const char*)(gbase) + (voff)[_i]), (PG8_LAS unsigned*)(lds + (bufoff) + ldsw + _i * 8192), 16, 0, 0); } while (0)
#define PG8_LDA(dst, b, h) do { _Pragma("unroll") for (int m = 0; m < 4; ++m) _Pragma("unroll") for (int k = 0; k < 2; ++k) dst[m][k] = *(const PG8_LAS bf16x8*)(lds + PG8_SA(b, h) + aoff + m * 2048 + k * 1024); } while (0)
#define PG8_LDB(dst, b, h) do { _Pragma("unroll") for (int n = 0; n < 2; ++n) _Pragma("unroll") for (int k = 0; k < 2; ++k) dst[n][k] = *(const PG8_LAS bf16x8*)(lds + PG8_SB(b, h) + boff + n * 2048 + k * 1024); } while (0)
#define PG8_MMA(ai, bj, At, Bt) do { __builtin_amdgcn_s_setprio(1); _Pragma("unroll") for (int m = 0; m < 4; ++m) _Pragma("unroll") for (int n = 0; n < 2; ++n) _Pragma("unroll") for (int k = 0; k < 2; ++k) \
        acc[ai][bj][m][n] = __builtin_amdgcn_mfma_f32_16x16x32_bf16(Bt[n][k], At[m][k], acc[ai][bj][m][n], 0, 0, 0); __builtin_amdgcn_s_setprio(0); } while (0)
#define PG8_WAIT_V(n) asm volatile("s_waitcnt vmcnt(" #n ")" ::: "memory")
#define PG8_WAIT_L(n) asm volatile("s_waitcnt lgkmcnt(" #n ")" ::: "memory")
#define PG8_BAR __builtin_amdgcn_s_barrier()
#define PG8_SCHED __builtin_amdgcn_sched_barrier(0)
    Unit cur, nxt; int ui = 0;
    if (!S.next(0, cur)) return;
    f32x4 acc[2][2][4][2];
#pragma unroll
    for (int a = 0; a < 2; ++a)
#pragma unroll
        for (int b = 0; b < 2; ++b)
#pragma unroll
            for (int m = 0; m < 4; ++m)
#pragma unroll
                for (int n = 0; n < 2; ++n) acc[a][b][m][n] = (f32x4){0.f, 0.f, 0.f, 0.f};
    bf16x8 At[4][2], B0[2][2], B1[2][2];
    const char* cA = GATHER ? (const char*)g.A : (const char*)g.A + (size_t)cur.pm * tstep; const char* cB = (const char*)g.Bt + (size_t)cur.pb * tstep;
    if constexpr (GATHER) {
#pragma unroll
        for (int h = 0; h < 2; ++h)
#pragma unroll
            for (int i = 0; i < 2; ++i) vA[h][i] = vN[h][i] = (unsigned)g.inv[cur.pm * BM + HALF * h + gR[i]] * (unsigned)(K * 2) + (unsigned)(gC[i] * 2);
    }
    S.a_ready(cur);
    if constexpr (SP2) {
        PG8_STAGE(PG8_SB(0, 0), cB, voffB); PG8_STAGE(PG8_SB(0, 1), cB + hstep, voffB); PG8_STAGE(PG8_SA(0, 0), cA, vA[0]); PG8_STAGE(PG8_SA(0, 1), cA + hsA, vA[1]);
        if (wr == 1) PG8_BAR;
        PG8_WAIT_V(2); PG8_BAR;
        PG8_STAGE(PG8_SB(1, 0), cB + kstep, voffB); PG8_STAGE(PG8_SA(1, 0), cA + kstep, vA[0]); PG8_STAGE(PG8_SB(1, 1), cB + hstep + kstep, voffB);
        PG8_WAIT_V(6); PG8_BAR;
    } else {
        PG8_STAGE(PG8_SB(0, 0), cB, voffB); PG8_STAGE(PG8_SA(0, 0), cA, vA[0]); PG8_STAGE(PG8_SB(0, 1), cB + hstep, voffB); PG8_STAGE(PG8_SA(0, 1), cA + hsA, vA[1]);
        if (wr == 1) PG8_BAR;
        PG8_WAIT_V(4); PG8_BAR;
        PG8_STAGE(PG8_SB(1, 0), cB + kstep, voffB); PG8_STAGE(PG8_SA(1, 0), cA + kstep, vA[0]); PG8_STAGE(PG8_SB(1, 1), cB + hstep + kstep, voffB);
        PG8_WAIT_V(6); PG8_BAR;
    }
    for (;;) {
        const bool has_next = S.next(ui + 1, nxt);
        if constexpr (GATHER) {
            if (has_next) {
#pragma unroll
                for (int h = 0; h < 2; ++h)
#pragma unroll
                    for (int i = 0; i < 2; ++i) asm volatile("global_load_dword %0, %1, off" : "=&v"(rawN[h][i]) : "v"(g.inv + nxt.pm * BM + HALF * h + gR[i]) : "memory");
            }
        }
        const char* nA = GATHER ? cA : (has_next ? (const char*)g.A + (size_t)nxt.pm * tstep : cA); const char* nB = has_next ? (const char*)g.Bt + (size_t)nxt.pb * tstep : cB;
        for (int t = 0; t < nt; t += 2) {
            const bool last = (t == nt - 2);
            const char* a1 = cA + (size_t)(t + 1) * kstep;
            const char* a2 = last ? nA : cA + (size_t)(t + 2) * kstep; const char* b2 = last ? nB : cB + (size_t)(t + 2) * kstep;
            const char* a3 = a2 + kstep; const char* b3 = b2 + kstep;
            if (last && has_next) S.a_ready(nxt);
            if constexpr (GATHER) {
                if (last) {
                    if (has_next) {
#pragma unroll
                        for (int h = 0; h < 2; ++h)
#pragma unroll
                            for (int i = 0; i < 2; ++i) { int tkn; asm volatile("v_mov_b32 %0, %1" : "=v"(tkn) : "v"(rawN[h][i])); vN[h][i] = (unsigned)tkn * (unsigned)(K * 2) + (unsigned)(gC[i] * 2); }
                    } else {
#pragma unroll
                        for (int h = 0; h < 2; ++h)
#pragma unroll
                            for (int i = 0; i < 2; ++i) vN[h][i] = vA[h][i];
                    }
                }
            }
            unsigned v2[2][2];
#pragma unroll
            for (int h = 0; h < 2; ++h)
#pragma unroll
                for (int i = 0; i < 2; ++i) v2[h][i] = last ? vN[h][i] : vA[h][i];
            if constexpr (SP2) {
            PG8_LDB(B0, 0, 0); PG8_LDB(B1, 0, 1); PG8_SCHED; PG8_LDA(At, 0, 0); PG8_STAGE(PG8_SA(1, 1), a1 + hsA, vA[1]);
            PG8_WAIT_V(8); PG8_WAIT_L(0); PG8_BAR; PG8_MMA(0, 0, At, B0); PG8_MMA(0, 1, At, B1); PG8_BAR; PG8_SCHED;
            PG8_LDA(At, 0, 1); PG8_STAGE(PG8_SB(0, 0), b2, voffB); PG8_STAGE(PG8_SB(0, 1), b2 + hstep, voffB); PG8_STAGE(PG8_SA(0, 0), a2, v2[0]);
            PG8_WAIT_V(8); PG8_WAIT_L(0); PG8_BAR; PG8_MMA(1, 0, At, B0); PG8_MMA(1, 1, At, B1); PG8_BAR; PG8_SCHED;
            PG8_LDB(B0, 1, 0); PG8_LDB(B1, 1, 1); PG8_SCHED; PG8_LDA(At, 1, 0); PG8_STAGE(PG8_SA(0, 1), a2 + hsA, v2[1]);
            PG8_WAIT_V(8); PG8_WAIT_L(0); PG8_BAR; PG8_MMA(0, 0, At, B0); PG8_MMA(0, 1, At, B1); PG8_BAR; PG8_SCHED;
            PG8_LDA(At, 1, 1); PG8_STAGE(PG8_SB(1, 0), b3, voffB); PG8_STAGE(PG8_SB(1, 1), b3 + hstep, voffB); PG8_STAGE(PG8_SA(1, 0), a3, v2[0]);
            PG8_WAIT_V(8); PG8_WAIT_L(0); PG8_BAR; PG8_MMA(1, 0, At, B0); PG8_MMA(1, 1, At, B1); PG8_BAR; PG8_SCHED;
            } else {
            PG8_LDB(B0, 0, 0); PG8_SCHED; PG8_LDA(At, 0, 0); PG8_STAGE(PG8_SA(1, 1), a1 + hsA, vA[1]);
            PG8_WAIT_L(8); PG8_BAR; PG8_WAIT_L(0); PG8_MMA(0, 0, At, B0); PG8_BAR; PG8_SCHED;
            PG8_LDB(B1, 0, 1); PG8_STAGE(PG8_SB(0, 0), b2, voffB);
            PG8_BAR; PG8_WAIT_L(0); PG8_MMA(0, 1, At, B1); PG8_BAR;
            PG8_LDA(At, 0, 1); PG8_STAGE(PG8_SA(0, 0), a2, v2[0]);
            PG8_BAR; PG8_WAIT_L(0); PG8_MMA(1, 0, At, B0); PG8_BAR; PG8_SCHED;
            PG8_STAGE(PG8_SB(0, 1), b2 + hstep, voffB);
            PG8_WAIT_V(6); PG8_BAR; PG8_MMA(1, 1, At, B1); PG8_BAR;
            PG8_LDB(B0, 1, 0); PG8_SCHED; PG8_LDA(At, 1, 0); PG8_STAGE(PG8_SA(0, 1), a2 + hsA, v2[1]);
            PG8_WAIT_L(8); PG8_BAR; PG8_WAIT_L(0); PG8_MMA(0, 0, At, B0); PG8_BAR; PG8_SCHED;
            PG8_LDB(B1, 1, 1); PG8_STAGE(PG8_SB(1, 0), b3, voffB);
            PG8_BAR; PG8_WAIT_L(0); PG8_MMA(0, 1, At, B1); PG8_BAR;
            PG8_LDA(At, 1, 1); PG8_STAGE(PG8_SA(1, 0), a3, v2[0]);
            PG8_BAR; PG8_WAIT_L(0); PG8_MMA(1, 0, At, B0); PG8_BAR; PG8_SCHED;
            PG8_STAGE(PG8_SB(1, 1), b3 + hstep, voffB);
            PG8_WAIT_V(6); PG8_BAR; PG8_MMA(1, 1, At, B1); PG8_BAR;
            }
        }
        if constexpr (ALIGN_EPI) { if (wr == 0) PG8_BAR; }
        if constexpr (!Epi::AFTER_DRAIN) { E(acc, cur, wr, wc, fr, fq); S.done(cur); }
        if (!has_next) break;
#pragma unroll
        for (int a = 0; a < 2; ++a)
#pragma unroll
            for (int b = 0; b < 2; ++b)
#pragma unroll
                for (int m = 0; m < 4; ++m)
#pragma unroll
                    for (int n = 0; n < 2; ++n) acc[a][b][m][n] = (f32x4){0.f, 0.f, 0.f, 0.f};
        cur = nxt; cA = nA; cB = nB; ++ui;
#pragma unroll
        for (int h = 0; h < 2; ++h)
#pragma unroll
            for (int i = 0; i < 2; ++i) vA[h][i] = vN[h][i];
        if constexpr (ALIGN_EPI) { if (wr == 1) PG8_BAR; }
    }
    PG8_WAIT_V(0);
    if constexpr (!ALIGN_EPI) { if (wr == 0) PG8_BAR; }
    PG8_BAR;
    if constexpr (Epi::AFTER_DRAIN) { E.fused(acc, cur, wr, wc, fr, fq, lds, wid, lane); S.done(cur); }
#undef PG8_SA
#undef PG8_SB
#undef PG8_STAGE
#undef PG8_LDA
#undef PG8_LDB
#undef PG8_MMA
#undef PG8_WAIT_V
#undef PG8_WAIT_L
#undef PG8_BAR
#undef PG8_SCHED
}
}
#define GAS __attribute__((address_space(1)))
#define LAS __attribute__((address_space(3)))
typedef unsigned short bf16;
typedef unsigned v4u __attribute__((ext_vector_type(4)));
typedef float f32x4 __attribute__((ext_vector_type(4)));
typedef short bf16x8 __attribute__((ext_vector_type(8)));
typedef GAS unsigned gu32;
typedef GAS unsigned long long gu64;
#define RLX_AGENT __ATOMIC_RELAXED, __HIP_MEMORY_SCOPE_AGENT
#define LDS_WAIT() asm volatile("s_waitcnt lgkmcnt(0)" ::: "memory")
#define VM_WAIT() asm volatile("s_waitcnt vmcnt(0)" ::: "memory")
__device__ __forceinline__ unsigned long long rt() { return __builtin_amdgcn_s_memrealtime(); }
__device__ __forceinline__ unsigned f2bf(float f) { unsigned u = __builtin_bit_cast(unsigned, f); return (u + 0x7fffu + ((u >> 16) & 1u)) >> 16; }
__device__ __forceinline__ unsigned pk2(float lo, float hi) { typedef float f2_t __attribute__((ext_vector_type(2))); typedef __bf16 b2_t __attribute__((ext_vector_type(2))); f2_t v = {lo, hi}; b2_t b = __builtin_convertvector(v, b2_t); return __builtin_bit_cast(unsigned, b); }

#define XB_TMO      128
#define XB_XCNT(j)  (256  + 64 * (j))
#define XB_XSUB(j)  (1280 + 64 * (j))
#define XB_XGEN(j)  (2304 + 64 * (j))
#define XB_TOP      3328
#define XB_TOPGEN   3392
#define XCD_BAR_WORDS 3456
#define XB_SPIN_CAP (1u << 18)

__device__ __forceinline__ unsigned xb_ld(unsigned* p)              { return __hip_atomic_load(p, __ATOMIC_RELAXED, __HIP_MEMORY_SCOPE_AGENT); }
__device__ __forceinline__ unsigned xb_add(unsigned* p, unsigned v) { return __hip_atomic_fetch_add(p, v, __ATOMIC_RELAXED, __HIP_MEMORY_SCOPE_AGENT); }
__device__ __forceinline__ unsigned xb_xcc_id() { return (unsigned)__builtin_amdgcn_s_getreg((3 << 11) | 20) & 0xFu; }
#define XB_SPIN(cond, bar) do { unsigned _sp = 0; while (cond) { __builtin_amdgcn_s_sleep(1); \
    if ((++_sp & 255u) == 0u) { if (xb_ld(&(bar)[XB_TMO])) break; if (_sp > XB_SPIN_CAP) { atomicAdd(&(bar)[XB_TMO], 1u); break; } } } } while (0)

struct XcdBarrier {
    unsigned* bar; unsigned x;
    volatile LAS unsigned* st;
};

__device__ __forceinline__ XcdBarrier xcd_barrier_post(unsigned* bar, volatile LAS unsigned* st, const int tid) {
    XcdBarrier b; b.bar = bar; b.x = xb_xcc_id(); b.st = st;
    if (tid == 0) (void)xb_add(&bar[XB_XCNT(b.x)], 1u);
    return b;
}
__device__ __forceinline__ void xcd_barrier_complete(unsigned* bar, unsigned x, unsigned& nloc, unsigned& nx) {
    const unsigned G = gridDim.x * gridDim.y * gridDim.z;
    unsigned sum, cnt, mine, sp = 0u;
    for (;;) {
        sum = 0u; cnt = 0u; mine = 0u;
#pragma unroll 1
        for (unsigned j = 0; j < 16; ++j) { const unsigned c = xb_ld(&bar[XB_XCNT(j)]); sum += c; cnt += (c > 0u) ? 1u : 0u; mine = (j == x) ? c : mine; }
        if (sum == G) break;
        __builtin_amdgcn_s_sleep(1);
        if ((++sp & 255u) == 0u) { if (xb_ld(&bar[XB_TMO])) break; if (sp > XB_SPIN_CAP) { atomicAdd(&bar[XB_TMO], 1u); break; } }
    }
    nloc = mine > 0u ? mine : 1u; nx = cnt > 0u ? cnt : 1u;
}

__device__ __forceinline__ void xcd_barrier(const XcdBarrier& b, const int tid) {
    asm volatile("s_waitcnt vmcnt(0)" ::: "memory");
    __syncthreads();
    if (tid == 0) {
        unsigned* bar = b.bar;
        __builtin_amdgcn_s_waitcnt(0);
        unsigned nloc = b.st[0], nx = b.st[1];
        if (nloc == 0u) { xcd_barrier_complete(bar, b.x, nloc, nx); b.st[0] = nloc; b.st[1] = nx; }
        const unsigned old = xb_add(&bar[XB_XSUB(b.x)], 1u);
        const unsigned gen = old / nloc;
        if (old + 1u == (gen + 1u) * nloc) {
            __builtin_amdgcn_fence(__ATOMIC_RELEASE, "agent");
            asm volatile("s_waitcnt vmcnt(0)" ::: "memory");
            const unsigned og = xb_add(&bar[XB_TOP], 1u);
            const unsigned tg = og / nx;
            if (og + 1u == (tg + 1u) * nx) xb_add(&bar[XB_TOPGEN], 1u);
            else XB_SPIN(xb_ld(&bar[XB_TOPGEN]) == tg, bar);
            __builtin_amdgcn_fence(__ATOMIC_ACQUIRE, "agent");
            xb_add(&bar[XB_XGEN(b.x)], 1u);
            asm volatile("s_waitcnt vmcnt(0)" ::: "memory");
        } else {
            XB_SPIN(xb_ld(&bar[XB_XGEN(b.x)]) == gen, bar);
            __builtin_amdgcn_fence(__ATOMIC_ACQUIRE, "agent");
            asm volatile("s_waitcnt vmcnt(0)" ::: "memory");
        }
    }
    __syncthreads();
}

#include <hip/hip_bf16.h>
#include <cmath>
namespace dsa_body {
using bf16=__hip_bfloat16;
using bf16x8=__attribute__((ext_vector_type(8)))short;
using s16x4=__attribute__((ext_vector_type(4)))short;
using f32x16=__attribute__((ext_vector_type(16)))float;
using u32x4=__attribute__((ext_vector_type(4)))unsigned;
constexpr int SEQ=2048,D=64,DM=64,DMQ=2816,DMO=1024;
constexpr int NW=8,QBLK=32,QB=QBLK*NW,KVBLK=64,NQB=SEQ/QB;
__device__ __forceinline__ int crow(int r,int hi){return (r&3)+8*(r>>2)+4*hi;}
#define SBAR() __builtin_amdgcn_sched_barrier(0)
typedef unsigned u32x2 __attribute__((ext_vector_type(2)));
__device__ __forceinline__ void smask(f32x16&p0,f32x16&p1,u32x2 mk,int hi){
  const int m0=(int)(mk.x>>(4*hi)), m1=(int)(mk.y>>(4*hi));
  #pragma unroll
  for(int r=0;r<16;++r){ const int cb=(r&3)+8*(r>>2);
    const unsigned n0=(unsigned)__builtin_amdgcn_sbfe(m0,cb,1), n1=(unsigned)__builtin_amdgcn_sbfe(m1,cb,1);
    p0[r]=__uint_as_float((__float_as_uint(p0[r])&n0)|(~n0&0xff800000u)); p1[r]=__uint_as_float((__float_as_uint(p1[r])&n1)|(~n1&0xff800000u)); }
}
constexpr int NSLOT=3, SLOTB=8192;
constexpr int LDS_K=0, LDS_V=NSLOT*SLOTB, LDS_WS=2*NSLOT*SLOTB, LDS_OST=LDS_WS+NW*64*4, LDS_BYTES=LDS_OST+NW*4096;
constexpr float C2=0.125f*1.4426950408889634f;
__device__ __forceinline__ void glds16(const void*gsrc,unsigned lds_dst){unsigned keep;
  asm volatile("s_mov_b32 %0, m0\n\ts_mov_b32 m0, %2\n\ts_nop 0\n\tglobal_load_lds_dwordx4 %1, off\n\ts_mov_b32 m0, %0":"=&s"(keep):"v"(gsrc),"s"(lds_dst):"memory");}
__device__ __forceinline__ float max3f(float a,float b,float c){float r;asm("v_max3_f32 %0, %1, %2, %3":"=v"(r):"v"(a),"v"(b),"v"(c));return r;}
__device__ __forceinline__ float max2f(float a,float b){float r;asm("v_max_f32_e32 %0, %1, %2":"=v"(r):"v"(a),"v"(b));return r;}
__device__ __forceinline__ float fadd_s(float a,float b){float r;asm("v_add_f32_e32 %0, %1, %2":"=v"(r):"v"(a),"v"(b));return r;}
__device__ __forceinline__ float fsub_s(float a,float b){float r;asm("v_sub_f32_e32 %0, %1, %2":"=v"(r):"v"(a),"v"(b));return r;}
typedef float f32x2_t __attribute__((ext_vector_type(2))); typedef __bf16 bf16x2_t __attribute__((ext_vector_type(2)));
__device__ __forceinline__ unsigned cvtpk_s(float lo,float hi){f32x2_t v={lo,hi};bf16x2_t b=__builtin_convertvector(v,bf16x2_t);return __builtin_bit_cast(unsigned,b);}
#define WAIT_BAR(N) asm volatile("s_waitcnt vmcnt(" #N ") lgkmcnt(0)\n\ts_barrier":::"memory")

__device__ __forceinline__ void qkt(f32x16&p0,f32x16&p1,const char*Kslot,const bf16x8*qr,const f32x16&negm,int r32,int hi){
  const char*kb=Kslot+hi*1024+r32*16;
  #pragma unroll
  for(int d0=0;d0<4;++d0){
    const bf16x8 b0=*reinterpret_cast<const bf16x8*>(kb+d0*2048);
    const bf16x8 b1=*reinterpret_cast<const bf16x8*>(kb+d0*2048+512);
    if(d0==0){p0=__builtin_amdgcn_mfma_f32_32x32x16_bf16(b0,qr[0],negm,0,0,0);p1=__builtin_amdgcn_mfma_f32_32x32x16_bf16(b1,qr[0],negm,0,0,0);}
    else{p0=__builtin_amdgcn_mfma_f32_32x32x16_bf16(b0,qr[d0],p0,0,0,0);p1=__builtin_amdgcn_mfma_f32_32x32x16_bf16(b1,qr[d0],p1,0,0,0);}}
}
typedef __attribute__((address_space(3))) const char* lds_cptr;
typedef short v4i16_t __attribute__((ext_vector_type(4)));
__device__ __forceinline__ void kload8(bf16x8*kf,lds_cptr kp){
  kf[0]=*(const __attribute__((address_space(3))) bf16x8*)(kp);      kf[1]=*(const __attribute__((address_space(3))) bf16x8*)(kp+512);
  kf[2]=*(const __attribute__((address_space(3))) bf16x8*)(kp+2048); kf[3]=*(const __attribute__((address_space(3))) bf16x8*)(kp+2560);
  kf[4]=*(const __attribute__((address_space(3))) bf16x8*)(kp+4096); kf[5]=*(const __attribute__((address_space(3))) bf16x8*)(kp+4608);
  kf[6]=*(const __attribute__((address_space(3))) bf16x8*)(kp+6144); kf[7]=*(const __attribute__((address_space(3))) bf16x8*)(kp+6656);
}
__device__ __forceinline__ void kload2(bf16x8*kf,lds_cptr kp,int j){ kf[2*j]=*(const __attribute__((address_space(3))) bf16x8*)(kp+j*2048); kf[2*j+1]=*(const __attribute__((address_space(3))) bf16x8*)(kp+j*2048+512); }
__device__ __forceinline__ s16x4 vtr(lds_cptr p){ return __builtin_bit_cast(s16x4,__builtin_amdgcn_ds_read_tr16_b64_v4i16((__attribute__((address_space(3))) v4i16_t*)p)); }
__device__ __forceinline__ float rowmax(const f32x16&p0,const f32x16&p1){
  float a=max3f(p0[0],p0[1],p1[0]),b=max3f(p0[2],p0[3],p1[1]);a=max3f(a,p1[2],p1[3]);
  #pragma unroll
  for(int r=4;r<16;r+=4){a=max3f(a,p0[r],p0[r+1]);b=max3f(b,p0[r+2],p0[r+3]);a=max3f(a,p1[r],p1[r+1]);b=max3f(b,p1[r+2],p1[r+3]);}
  const float m=max2f(a,b);
  auto rr=__builtin_amdgcn_permlane32_swap(__float_as_uint(m),__float_as_uint(m),false,false);
  return max2f(__uint_as_float(rr[0]),__uint_as_float(rr[1]));
}
__device__ __forceinline__ void pv(f32x16*o,int vb,bf16x8 pa0,bf16x8 pa1,bf16x8 pa2,bf16x8 pa3){
  #pragma unroll
  for(int d0=0;d0<2;++d0){s16x4 lo[4],hi[4];
    #pragma unroll
    for(int ks=0;ks<4;++ks){
      asm volatile("ds_read_b64_tr_b16 %0,%1 offset:%c2":"=&v"(lo[ks]):"v"(vb),"i"(d0*4096+ks*1024):"memory");
      asm volatile("ds_read_b64_tr_b16 %0,%1 offset:%c2":"=&v"(hi[ks]):"v"(vb),"i"(d0*4096+ks*1024+512):"memory");}
    asm volatile("s_waitcnt lgkmcnt(0)":::"memory");SBAR();
    #define PK(k) (bf16x8){lo[k][0],lo[k][1],lo[k][2],lo[k][3],hi[k][0],hi[k][1],hi[k][2],hi[k][3]}
    o[d0]=__builtin_amdgcn_mfma_f32_32x32x16_bf16(pa0,PK(0),o[d0],0,0,0);
    o[d0]=__builtin_amdgcn_mfma_f32_32x32x16_bf16(pa1,PK(1),o[d0],0,0,0);
    o[d0]=__builtin_amdgcn_mfma_f32_32x32x16_bf16(pa2,PK(2),o[d0],0,0,0);
    o[d0]=__builtin_amdgcn_mfma_f32_32x32x16_bf16(pa3,PK(3),o[d0],0,0,0);
    #undef PK
  }
}

#ifndef ATTN_STORE16
#define ATTN_STORE16(p,v) (*(u32x4*)(p)=(v))
#endif
template<int THRL> __device__ __forceinline__ void dsa_unit(int b,int u,const bf16*Q,const bf16*__restrict__ K,const bf16*__restrict__ V,bf16*O,const unsigned*MASKW,char*shm,const int tid){
  const int lane=tid&63,r32=lane&31,hi=lane>>5; const int wid=__builtin_amdgcn_readfirstlane(tid>>6);
  const long rowbase=(long)b*SEQ; const int q0=u*32;
  const bf16*Qw=Q+(rowbase+q0+wid*4+(r32>>3))*DMQ+(r32&7)*64;
  const bf16*Kh=K+rowbase*DM,*Vh=V+rowbase*DM;
  const unsigned*mrow=MASKW+(rowbase+q0+wid*4+(r32>>3))*64;
  const unsigned lds0=(unsigned)(uintptr_t)shm;
  float*wsf=(float*)(shm+LDS_WS)+wid*64;
  const bf16*ksrc=Kh+(long)lane*DM+wid*8;
  const bf16*vsrc=Vh+(long)(16*(wid&3)+(lane>>2))*DM+(wid>>2)*32+(lane&3)*8;
  const unsigned kdst=lds0+LDS_K+wid*1024, vdst=lds0+LDS_V+wid*1024;
  #define DMA_K(t,slot) glds16(ksrc+(long)(t)*KVBLK*DM,(unsigned)__builtin_amdgcn_readfirstlane(kdst+(slot)))
  #define DMA_V(t,slot) glds16(vsrc+(long)(t)*KVBLK*DM,(unsigned)__builtin_amdgcn_readfirstlane(vdst+(slot)))
  const int vb0=(int)(lds0+LDS_V)+((lane>>4)&1)*32+(lane&3)*8+(4*hi+((lane&15)>>2))*64;
  const char*Kbase=shm+LDS_K; bf16x8 kf[8];
  const lds_cptr shm3=(lds_cptr)shm; const lds_cptr kp0=shm3+LDS_K+hi*1024+r32*16; const lds_cptr vp0=shm3+LDS_V+((lane>>4)&1)*32+(lane&3)*8+(4*hi+((lane&15)>>2))*64;
  int NT_=(((u>>1)+1)+1)&~1; if(NT_<4)NT_=4; const int NT=NT_;
  u32x2 mraw0,mkn,mkc;
  #define MLOAD(dst,t) asm volatile("global_load_dwordx2 %0, %1, off":"=&v"(dst):"v"(mrow+2*(t)):"memory")
  #define MCOPY(dst,src) asm volatile("v_mov_b32 %0, %2\n\tv_mov_b32 %1, %3":"=&v"(dst.x),"=&v"(dst.y):"v"(src.x),"v"(src.y))
  MLOAD(mraw0,0); MLOAD(mkn,1);
  DMA_K(0,0);DMA_V(0,0);DMA_K(1,SLOTB);
  bf16x8 qr[4];
  #pragma unroll
  for(int d0=0;d0<4;++d0)qr[d0]=*reinterpret_cast<const bf16x8*>(&Qw[d0*16+hi*8]);
  float mhat=0.f,l_reg=0.f;f32x16 o[2];o[0]=f32x16{};o[1]=f32x16{};const f32x16 negm=f32x16{};
  #define CMASK(P0,P1,t) smask(P0,P1,mkc,hi)
  bool resc=false;
  #define START(P0,P1) do{ const float rm=rowmax(P0,P1); resc=false; \
    { const float dl=__any(rm>(float)THRL)?__builtin_fmaxf(rm,0.f):0.f; mhat=fadd_s(mhat,dl); \
      _Pragma("unroll") for(int r=0;r<16;++r){P0[r]=fsub_s(P0[r],dl);P1[r]=fsub_s(P1[r],dl);} \
      } \
    _Pragma("unroll") for(int r=0;r<16;++r)P0[r]=__builtin_amdgcn_exp2f(P0[r]); }while(0)
  #define RESC() do{ if(resc){ asm volatile("s_waitcnt lgkmcnt(0)":::"memory"); \
      _Pragma("unroll") for(int d_=0;d_<2;++d_) _Pragma("unroll") for(int r=0;r<16;++r)o[d_][r]*=wsf[crow(r,hi)]; } }while(0)
  f32x16 pA0,pA1,pB0,pB1;
  int sl_prev=0,sl_cur=0,sl_next=SLOTB;
  #define ROT() do{sl_prev=sl_cur;sl_cur=sl_next;sl_next=(sl_next==(NSLOT-1)*SLOTB)?0:sl_next+SLOTB;}while(0)
  DMA_K(2,2*SLOTB);
  WAIT_BAR(3);
  MCOPY(mkc,mraw0);
  qkt(pA0,pA1,Kbase,qr,negm,r32,hi);asm volatile("s_nop 15\n\ts_nop 7":"+v"(pA0),"+v"(pA1));CMASK(pA0,pA1,0);
  START(pA0,pA1);
  _Pragma("unroll") for(int r=0;r<16;++r)pA1[r]=__builtin_amdgcn_exp2f(pA1[r]);
  WAIT_BAR(0);
  DMA_K(3,0);DMA_V(1,SLOTB);
  ROT();
  kload8(kf,kp0+sl_cur);
  WAIT_BAR(2);
  s16x4 vlo[8],vhi[8]; u32x4 pw0,pw1,pw2,pw3;
  #define PKW(P,B) cvtpk_s(P[B],P[B+1])
  #define PAF(k) __builtin_bit_cast(bf16x8,pw##k)
  #define VFR(i) (bf16x8){vlo[i][0],vlo[i][1],vlo[i][2],vlo[i][3],vhi[i][0],vhi[i][1],vhi[i][2],vhi[i][3]}
  #define PIN(x) asm volatile("":"+v"(x))
  #define MX3(a,b,c) __builtin_fmaxf(__builtin_fmaxf((a),(b)),(c))
  #define GAPA(MF,A0,A1,A2,A3,W0,W1,PW) do{ MF; sacc+=A0; sacc+=A1; sacc+=A2; sacc+=A3; PIN(sacc); W0; W1; PIN(PW); SBAR(); }while(0)
  #define EX(v) __builtin_amdgcn_exp2f(v)
  #define GAPB(MF,X,B) do{ MF; X[B]=EX(X[B]); X[B+1]=EX(X[B+1]); X[B+2]=EX(X[B+2]); X[B+3]=EX(X[B+3]); PIN(X); SBAR(); }while(0)
  #define VRD(i) do{ vlo[i]=vtr(vp_+(((i)>>2)*4096+((i)&3)*1024)); vhi[i]=vtr(vp_+(((i)>>2)*4096+((i)&3)*1024+512)); }while(0)
  #define KRD(G,j) do{ if(G){ kload2(kf,kp0+sl_next,j); SBAR(); } }while(0)
  #define STEP(C0,C1,P0,P1,t,GK,GV,GL) do{ SBAR(); MCOPY(mkc,mkn); if(GV){MLOAD(mkn,(t)+1);} \
    const lds_cptr vp_=vp0+sl_prev; \
    VRD(0); SBAR(); float sacc=(P0[0]+P0[1]); \
    GAPA(C0=__builtin_amdgcn_mfma_f32_32x32x16_bf16(kf[0],qr[0],negm,0,0,0), P0[2],P0[3],P0[4],P0[5],     pw0[0]=PKW(P0,0), pw0[1]=PKW(P0,2), pw0); \
    VRD(4); SBAR(); GAPA(C1=__builtin_amdgcn_mfma_f32_32x32x16_bf16(kf[1],qr[0],negm,0,0,0), P0[6],P0[7],P0[8],P0[9],     pw0[2]=PKW(P0,4), pw0[3]=PKW(P0,6), pw0); \
    VRD(1); SBAR(); GAPA(C0=__builtin_amdgcn_mfma_f32_32x32x16_bf16(kf[2],qr[1],C0,0,0,0),   P0[10],P0[11],P0[12],P0[13], pw1[0]=PKW(P0,8), pw1[1]=PKW(P0,10), pw1); \
    VRD(5); SBAR(); GAPA(C1=__builtin_amdgcn_mfma_f32_32x32x16_bf16(kf[3],qr[1],C1,0,0,0),   P0[14],P0[15],P1[0],P1[1],   pw1[2]=PKW(P0,12),pw1[3]=PKW(P0,14), pw1); \
    VRD(2); SBAR(); GAPA(C0=__builtin_amdgcn_mfma_f32_32x32x16_bf16(kf[4],qr[2],C0,0,0,0),   P1[2],P1[3],P1[4],P1[5],     pw2[0]=PKW(P1,0), pw2[1]=PKW(P1,2), pw2); \
    VRD(6); SBAR(); GAPA(C1=__builtin_amdgcn_mfma_f32_32x32x16_bf16(kf[5],qr[2],C1,0,0,0),   P1[6],P1[7],P1[8],P1[9],     pw2[2]=PKW(P1,4), pw2[3]=PKW(P1,6), pw2); \
    VRD(3); SBAR(); GAPA(C0=__builtin_amdgcn_mfma_f32_32x32x16_bf16(kf[6],qr[3],C0,0,0,0),   P1[10],P1[11],P1[12],P1[13], pw3[0]=PKW(P1,8), pw3[1]=PKW(P1,10), pw3); \
    VRD(7); SBAR(); GAPA(C1=__builtin_amdgcn_mfma_f32_32x32x16_bf16(kf[7],qr[3],C1,0,0,0),   P1[14],P1[15],0.f,0.f,       pw3[2]=PKW(P1,12),pw3[3]=PKW(P1,14), pw3); \
    l_reg+=sacc; \
    if(GK){DMA_K((t)+3,sl_cur);} if(GV){DMA_V((t)+1,sl_next);} \
    CMASK(C0,C1,t); \
    _Pragma("unroll") for(int r=0;r<16;++r){C0[r]-=mhat;C1[r]-=mhat;} \
    { float a=MX3(C0[0],C0[1],C1[0]),b=MX3(C0[2],C0[3],C1[1]); a=MX3(a,C1[2],C1[3]); \
      _Pragma("unroll") for(int r=4;r<16;r+=4){a=MX3(a,C0[r],C0[r+1]);b=MX3(b,C0[r+2],C0[r+3]);a=MX3(a,C1[r],C1[r+1]);b=MX3(b,C1[r+2],C1[r+3]);} \
      float rm=__builtin_fmaxf(a,b); { auto rr=__builtin_amdgcn_permlane32_swap(__float_as_uint(rm),__float_as_uint(rm),false,false); rm=__builtin_fmaxf(__uint_as_float(rr[0]),__uint_as_float(rr[1])); } \
      resc=false; \
      if(__builtin_expect(__any(rm>(float)THRL),0)){ const float dl=__builtin_fmaxf(rm,0.f); mhat+=dl; \
        _Pragma("unroll") for(int r=0;r<16;++r){C0[r]-=dl;C1[r]-=dl;} \
        const float f=__builtin_amdgcn_exp2f(-dl); l_reg*=f; if(hi==0)wsf[r32]=f; resc=true; } } \
    SBAR(); \
    GAPB(o[0]=__builtin_amdgcn_mfma_f32_32x32x16_bf16(PAF(0),VFR(0),o[0],0,0,0), C0,0); \
    GAPB(o[1]=__builtin_amdgcn_mfma_f32_32x32x16_bf16(PAF(0),VFR(4),o[1],0,0,0), C0,4); \
    KRD(GL,0); GAPB(o[0]=__builtin_amdgcn_mfma_f32_32x32x16_bf16(PAF(1),VFR(1),o[0],0,0,0), C0,8); \
    KRD(GL,1); GAPB(o[1]=__builtin_amdgcn_mfma_f32_32x32x16_bf16(PAF(1),VFR(5),o[1],0,0,0), C0,12); \
    KRD(GL,2); GAPB(o[0]=__builtin_amdgcn_mfma_f32_32x32x16_bf16(PAF(2),VFR(2),o[0],0,0,0), C1,0); \
    KRD(GL,3); GAPB(o[1]=__builtin_amdgcn_mfma_f32_32x32x16_bf16(PAF(2),VFR(6),o[1],0,0,0), C1,4); \
    GAPB(o[0]=__builtin_amdgcn_mfma_f32_32x32x16_bf16(PAF(3),VFR(3),o[0],0,0,0), C1,8); \
    GAPB(o[1]=__builtin_amdgcn_mfma_f32_32x32x16_bf16(PAF(3),VFR(7),o[1],0,0,0), C1,12); \
    }while(0)
  int t=1;
  for(;t+5<NT;t+=2){
    STEP(pB0,pB1,pA0,pA1,t,true,true,true);     WAIT_BAR(2); RESC(); ROT();
    STEP(pA0,pA1,pB0,pB1,t+1,true,true,true);   WAIT_BAR(2); RESC(); ROT();
  }
  #define ENDW(tt) do{ if((tt)+3<NT){WAIT_BAR(2);} else if((tt)+2<NT){WAIT_BAR(1);} else {WAIT_BAR(0);} }while(0)
  for(;t+1<NT;t+=2){
    STEP(pB0,pB1,pA0,pA1,t,(t+3<NT),(t+1<NT),(t+1<NT));       ENDW(t);   RESC(); ROT();
    STEP(pA0,pA1,pB0,pB1,t+1,(t+4<NT),(t+2<NT),(t+2<NT));     ENDW(t+1); RESC(); ROT();
  }
  STEP(pB0,pB1,pA0,pA1,NT-1,false,false,false); RESC();
  { float sacc=pB0[0]+pB0[1]; _Pragma("unroll") for(int r=2;r<16;++r)sacc+=pB0[r]; _Pragma("unroll") for(int r=0;r<16;++r)sacc+=pB1[r]; l_reg+=sacc;
    pw0=(u32x4){PKW(pB0,0),PKW(pB0,2),PKW(pB0,4),PKW(pB0,6)};pw1=(u32x4){PKW(pB0,8),PKW(pB0,10),PKW(pB0,12),PKW(pB0,14)};pw2=(u32x4){PKW(pB1,0),PKW(pB1,2),PKW(pB1,4),PKW(pB1,6)};pw3=(u32x4){PKW(pB1,8),PKW(pB1,10),PKW(pB1,12),PKW(pB1,14)};
    SBAR(); pv(o,vb0+sl_cur,PAF(0),PAF(1),PAF(2),PAF(3)); }
  #undef PKW
  #undef PAF
  #undef VFR
  #undef PIN
  #undef MX3
  #undef GAPA
  #undef GAPB
  #undef EX
  #undef VRD
  #undef KRD
  #undef STEP
  #undef ENDW
  {auto rr=__builtin_amdgcn_permlane32_swap(__float_as_uint(l_reg),__float_as_uint(l_reg),false,false);l_reg=__uint_as_float(rr[0])+__uint_as_float(rr[1]);}
  if(hi==0)wsf[32+r32]=l_reg;asm volatile("s_waitcnt lgkmcnt(0)":::"memory");
  float rli[16];
  #pragma unroll
  for(int r=0;r<16;++r)rli[r]=__builtin_amdgcn_rcpf(wsf[32+crow(r,hi)]);
  bf16*Ow=O+(rowbase+q0+wid*4)*DMO;
  { bf16*stg=(bf16*)(shm+LDS_OST)+wid*2048;
    #pragma unroll
    for(int r=0;r<16;++r){const int orow=crow(r,hi);
      #pragma unroll
      for(int d0=0;d0<2;++d0)stg[orow*64+d0*32+r32]=__float2bfloat16(o[d0][r]*rli[r]);}
    asm volatile("s_waitcnt lgkmcnt(0)":::"memory");
    #pragma unroll
    for(int i=0;i<4;++i){const int row=i*8+(lane>>3),ch=lane&7; const u32x4 v=*(const u32x4*)(stg+row*64+ch*8); ATTN_STORE16(Ow+(long)(row>>3)*DMO+(row&7)*64+ch*8,v);} }
  asm volatile("s_waitcnt lgkmcnt(0)\n\ts_barrier":::"memory");
  #undef DMA_K
  #undef DMA_V
  #undef CMASK
  #undef MLOAD
  #undef MCOPY
  #undef START
  #undef RESC
  #undef ROT
}
constexpr int ATTN_LDS_BYTES=LDS_BYTES;
template<int THRL=8> __device__ __forceinline__ void dsa_attn_phase(char*lds,const bf16*Pq,const bf16*KD,const bf16*VD,bf16*MIXp,const unsigned*MASKW,int vcu,int ncu,int tid){
  for(int v=vcu;v<16*16;v+=ncu){
    const int b=v>>4, s=v&15;
    #pragma unroll 1
    for(int i=0;i<4;++i){ const int u=(i==0)?s:(i==1)?63-s:(i==2)?31-s:32+s;
      dsa_unit<THRL>(b,u,Pq,KD,VD,MIXp,MASKW,lds,tid); }
  }
}
#undef SBAR
#undef WAIT_BAR
}

constexpr int NWAVES = 8, NTHR = 512;
constexpr int BATCH = 16, SEQ = 2048, D = 1024, M = BATCH * SEQ;
constexpr int EIN = 2776, EINP = 2816, FF = 2816, NEXP = 8;
constexpr int PC_AQ = 0, PC_CKV = 512, PC_QI = 640, PC_KI = 1152, PC_WI = 1216, PC_BQ = 1224, PC_BK = 1480, PC_BV = 1736, PC_BG = 2248, PC_BR = 2264;
constexpr float ALPHA = 1.6817928305074290f;
constexpr float LN_EPS = 1e-5f, RMS_EPS = 1e-6f;
constexpr float C2 = 0.125f * 1.4426950408889634f;
constexpr int MOE_ROWS = 2 * M + NEXP * 256;
constexpr int TOPK = 256;

constexpr size_t MiB = 1u << 20;
constexpr size_t WS_CTL = 0, CTL_ZERO_BYTES = 256 * 1024;
constexpr size_t WS_XSTAT = 1u << 20;
constexpr int CW_PANEL = 16384;
constexpr size_t WS_WB = 2 * MiB;
constexpr size_t WB_WIN = 0, WB_WOUT = 6 * MiB, WB_WGU = 8 * MiB, WB_WDN = 20 * MiB;
constexpr size_t WB_WQKV = 0, WB_MGU = 8 * MiB, WB_MDN = 96 * MiB;
constexpr size_t WS_XB = 146 * MiB;
constexpr size_t WS_P = 210 * MiB, WS_HID = 210 * MiB, WS_MIX = 386 * MiB;
constexpr size_t WS_KD = 450 * MiB, WS_VD = 454 * MiB, WS_KI = 458 * MiB, WS_MASK = 462 * MiB;
constexpr size_t WS_GST = 470 * MiB, WS_H_EVEN = 470 * MiB;
constexpr size_t WS_QT = 534 * MiB, WS_KT = 550 * MiB, WS_EBL = 582 * MiB, WS_SC = 584 * MiB;
constexpr size_t WS_QKV = 210 * MiB, WS_AO = 402 * MiB, WS_MIXO = 530 * MiB, WS_H_ODD = 594 * MiB;
constexpr size_t WS_XPERM = 210 * MiB, WS_HIDP = 342 * MiB;
constexpr size_t WS_ROUTE = 722 * MiB, WS_INV = 723 * MiB, WS_CNTT = 723 * MiB + 512 * 1024  , WS_END = 724 * MiB;
constexpr int CW_TMO = 0, CW_CNT = 64  , CW_BAR = 4096;

constexpr int RING_BYTES = 131072, LDSCTL_OFF = RING_BYTES, MISC_OFF = LDSCTL_OFF + 320, LDS_BYTES = 147456;
constexpr int XTRA_OFF = MISC_OFF + 128;

__device__ __forceinline__ float bf2f(unsigned short u) { return __uint_as_float((unsigned)u << 16); }
__device__ __forceinline__ float bflo(unsigned w) { return __uint_as_float(w << 16); }
__device__ __forceinline__ float bfhi(unsigned w) { return __uint_as_float(w & 0xffff0000u); }
__device__ __forceinline__ float wave_sum_fd(float v);
__device__ __forceinline__ float wave_sum(float v) { return wave_sum_fd(v); }
__device__ __forceinline__ float wave_sum_l(float v, int lane) {
#pragma unroll
    for (int o = 1; o < 64; o <<= 1) v += __int_as_float(__builtin_amdgcn_ds_bpermute((lane ^ o) << 2, __float_as_int(v)));
    return v;
}
__device__ __forceinline__ int hw_lane() { int ln; asm volatile("v_mbcnt_lo_u32_b32 %0, -1, 0\n\tv_mbcnt_hi_u32_b32 %0, -1, %0" : "=v"(ln)); return ln & 63; }
__device__ __forceinline__ float wave_sum_fd(float v) {
    v += __int_as_float(__builtin_amdgcn_mov_dpp(__float_as_int(v), 0xB1, 0xF, 0xF, true));
    v += __int_as_float(__builtin_amdgcn_mov_dpp(__float_as_int(v), 0x4E, 0xF, 0xF, true));
    v += __int_as_float(__builtin_amdgcn_mov_dpp(__float_as_int(v), 0x141, 0xF, 0xF, true));
    v += __int_as_float(__builtin_amdgcn_mov_dpp(__float_as_int(v), 0x140, 0xF, 0xF, true));
    const int b = __float_as_int(v);
    return (__int_as_float(__builtin_amdgcn_readlane(b, 0)) + __int_as_float(__builtin_amdgcn_readlane(b, 16))) + (__int_as_float(__builtin_amdgcn_readlane(b, 32)) + __int_as_float(__builtin_amdgcn_readlane(b, 48)));
}
__device__ __forceinline__ float wave_max(float v) {
#pragma unroll
    for (int o = 1; o < 64; o <<= 1) v = fmaxf(v, __shfl_xor(v, o));
    return v;
}
__device__ __forceinline__ int wave_sum_i(int v) {
#pragma unroll
    for (int o = 1; o < 64; o <<= 1) v += __shfl_xor(v, o);
    return v;
}
__device__ __forceinline__ int wave_incl_scan_i(int v, int lane) {
#pragma unroll
    for (int o = 1; o < 64; o <<= 1) { const int t = __shfl_up(v, o); if (lane >= o) v += t; }
    return v;
}
__device__ __forceinline__ void ld8bf(const bf16* p, float* f) {
    const v4u w = *(const v4u*)p;
    f[0] = bflo(w.x); f[1] = bfhi(w.x); f[2] = bflo(w.y); f[3] = bfhi(w.y); f[4] = bflo(w.z); f[5] = bfhi(w.z); f[6] = bflo(w.w); f[7] = bfhi(w.w);
}
__device__ __forceinline__ float silu_f(float x) { return x * __builtin_amdgcn_rcpf(1.0f + __builtin_amdgcn_exp2f(-1.4426950408889634f * x)); }

struct Frame {
    LAS unsigned char* lds;
    volatile LAS unsigned* MISC;
    gu32* ctl;
    int tid, lane, wave, G, gw, NGW, bx, wave0;
    unsigned char* ws;
    const __attribute__((address_space(4))) unsigned char* kp;
    __device__ __forceinline__ const float* inp(int i) const { typedef const float* cfp; return *(const __attribute__((address_space(4))) cfp*)(kp + 8 * i); }
    __device__ __forceinline__ float* outp() const { typedef float* fp; return *(const __attribute__((address_space(4))) fp*)(kp + 272); }
};

namespace pg8 {
struct EpiSwiGLU {
    static constexpr bool PERM = true, AFTER_DRAIN = false;
    bf16_t* O; int ldc;
    __device__ __forceinline__ void operator()(const f32x4 (&acc)[2][2][4][2], const Unit& u, int wr, int wc, int fr, int fq) const {
        const int row0 = u.pm * BM + wr * 64 + fr, col0 = u.pn * HALF + wc * 32 + 8 * fq;
#pragma unroll
        for (int ai = 0; ai < 2; ++ai)
#pragma unroll
            for (int m = 0; m < 4; ++m) {
                bf16_t* rowp = O + (size_t)(row0 + ai * HALF + m * 16) * ldc + col0;
                const f32x4 g0 = acc[ai][0][m][0], g1 = acc[ai][0][m][1], u0 = acc[ai][1][m][0], u1 = acc[ai][1][m][1];
                u32x4 w;
                w.x = cvt_pk_bf16(silu_f(g0[0]) * u0[0], silu_f(g0[1]) * u0[1]); w.y = cvt_pk_bf16(silu_f(g0[2]) * u0[2], silu_f(g0[3]) * u0[3]);
                w.z = cvt_pk_bf16(silu_f(g1[0]) * u1[0], silu_f(g1[1]) * u1[1]); w.w = cvt_pk_bf16(silu_f(g1[2]) * u1[2], silu_f(g1[3]) * u1[3]);
                *(u32x4*)rowp = w;
            }
    }
};
struct MoeOrder {
    StaticOrder so; int tb[NEXP + 1]; int nN;
    __device__ __forceinline__ void init(const unsigned* cnt, int nN_, int G, int c) {
        tb[0] = 0;
#pragma unroll
        for (int e = 0; e < NEXP; ++e) tb[e + 1] = tb[e] + (int)((__builtin_amdgcn_readfirstlane(cnt[e]) + 255u) >> 8);
        nN = nN_; so.nM = tb[NEXP]; so.nN = nN_; so.nwg = so.nM * nN_; so.G = G; so.c = c; so.lim = so.nwg;
    }
    __device__ __forceinline__ void cut_tail() { const int tail = so.nwg % so.G; if (tail * 16 <= 2 * so.G) so.lim = so.nwg - tail; }
    __device__ __forceinline__ bool next(int i, Unit& u) const {
        if (!so.next(i, u)) return false;
        int e = 0;
#pragma unroll
        for (int k = 1; k < NEXP; ++k) e += (u.pm >= tb[k]) ? 1 : 0;
        u.pb = e * nN + u.pn; return true;
    }
    __device__ __forceinline__ bool at(long L, Unit& u) const {
        if (!so.at(L, u)) return false;
        int e = 0;
#pragma unroll
        for (int k = 1; k < NEXP; ++k) e += (u.pm >= tb[k]) ? 1 : 0;
        u.pb = e * nN + u.pn; return true;
    }
    __device__ __forceinline__ void a_ready(const Unit&) const {}
    __device__ __forceinline__ void done(const Unit&) const {}
};
struct PanelOrder {
    int nM, c;
    __device__ __forceinline__ void init(int M, int c_) { nM = M / BM; c = c_; }
    __device__ __forceinline__ bool next(int i, Unit& u) const { const int j = c >> 3, pm = i * 64 + (c & 7) * 8 + (j >> 2); if (pm >= nM) return false; u.pm = pm; u.pn = j & 3; u.pb = u.pn; return true; }
    __device__ __forceinline__ void a_ready(const Unit&) const {}
    __device__ __forceinline__ void done(const Unit&) const {}
};
struct EpiLnFused {
    static constexpr bool PERM = true, AFTER_DRAIN = false;
    bf16_t* X; const float* g; const float* b; unsigned long long* xbuf; unsigned* cnt; unsigned* tmo; PG8_LAS unsigned char* tl;
    __device__ __forceinline__ void operator()(f32x4 (&acc)[2][2][4][2], const Unit& u, int wr, int wc, int fr, int fq) const {
        typedef float f32x2v __attribute__((ext_vector_type(2)));
        const int wid = wr * 4 + wc, lane = fq * 16 + fr;
        PG8_LAS f32x2v* P = (PG8_LAS f32x2v*)tl;
        PG8_LAS f32x2v* S = (PG8_LAS f32x2v*)(tl + 8192);
        bf16_t* xb0 = X + (size_t)(u.pm * BM + wr * 64 + fr) * 1024 + u.pn * BM + wc * 32 + 8 * fq;
        {
            u32x4 xw[2][4][2];
#pragma unroll
            for (int ai = 0; ai < 2; ++ai)
#pragma unroll
                for (int m = 0; m < 4; ++m)
#pragma unroll
                    for (int bj = 0; bj < 2; ++bj) xw[ai][m][bj] = *(const u32x4*)(xb0 + (size_t)(ai * HALF + m * 16) * 1024 + bj * HALF);
#pragma unroll
            for (int ai = 0; ai < 2; ++ai)
#pragma unroll
                for (int m = 0; m < 4; ++m)
#pragma unroll
                    for (int bj = 0; bj < 2; ++bj) { const u32x4 w = xw[ai][m][bj];
                        acc[ai][bj][m][0] += (f32x4){bflo(w.x), bfhi(w.x), bflo(w.y), bfhi(w.y)} * ALPHA; acc[ai][bj][m][1] += (f32x4){bflo(w.z), bfhi(w.z), bflo(w.w), bfhi(w.w)} * ALPHA; }
            asm volatile("" ::: "memory");
        }
#pragma unroll
        for (int ai = 0; ai < 2; ++ai)
#pragma unroll
            for (int m = 0; m < 4; ++m) {
                float s = 0.f;
#pragma unroll
                for (int bj = 0; bj < 2; ++bj)
#pragma unroll
                    for (int n = 0; n < 2; ++n) { const f32x4 x = acc[ai][bj][m][n]; s += (x[0] + x[1]) + (x[2] + x[3]); }
                s += __int_as_float(__builtin_amdgcn_ds_bpermute((lane ^ 16) << 2, __float_as_int(s))); s += __int_as_float(__builtin_amdgcn_ds_bpermute((lane ^ 32) << 2, __float_as_int(s)));
                const float mw = s * (1.0f / 64.0f); float q = 0.f;
#pragma unroll
                for (int bj = 0; bj < 2; ++bj)
#pragma unroll
                    for (int n = 0; n < 2; ++n) { const f32x4 d = acc[ai][bj][m][n] - mw; q += (d[0] * d[0] + d[1] * d[1]) + (d[2] * d[2] + d[3] * d[3]); }
                q += __int_as_float(__builtin_amdgcn_ds_bpermute((lane ^ 16) << 2, __float_as_int(q))); q += __int_as_float(__builtin_amdgcn_ds_bpermute((lane ^ 32) << 2, __float_as_int(q)));
                if (fq == 0) P[(ai * HALF + wr * 64 + m * 16 + fr) * 4 + wc] = (f32x2v){mw, q};
            }
        asm volatile("s_waitcnt lgkmcnt(0)" ::: "memory"); __builtin_amdgcn_s_barrier(); asm volatile("" ::: "memory");
        const int row = wid * 32 + (lane & 31);
        if (lane < 32) {
            const f32x2v a = P[row * 4 + 0], b2 = P[row * 4 + 1], c2 = P[row * 4 + 2], d = P[row * 4 + 3];
            const float mt = (a.x + b2.x + c2.x + d.x) * 0.25f;
            const float da = a.x - mt, db = b2.x - mt, dc = c2.x - mt, dd = d.x - mt;
            const float m2 = (a.y + b2.y) + (c2.y + d.y) + 64.0f * ((da * da + db * db) + (dc * dc + dd * dd));
            unsigned long long* slot = xbuf + ((size_t)(u.pm * BM + row) * 4 + u.pn);
            __hip_atomic_store(slot, ((unsigned long long)__float_as_uint(m2) << 32) | __float_as_uint(mt), __ATOMIC_RELAXED, __HIP_MEMORY_SCOPE_AGENT);
        }
        asm volatile("s_waitcnt vmcnt(0)" ::: "memory");
        if (lane == 0) __hip_atomic_fetch_add(cnt + 64 * u.pm, 1u, __ATOMIC_RELAXED, __HIP_MEMORY_SCOPE_AGENT);
        if (wid == 0) {
            unsigned sp = 0u;
            while ((unsigned)__builtin_amdgcn_readfirstlane(__hip_atomic_load(cnt + 64 * u.pm, __ATOMIC_RELAXED, __HIP_MEMORY_SCOPE_AGENT)) < 32u) {
                __builtin_amdgcn_s_sleep(2);
                if (++sp > (1u << 17)) { if (lane == 0) __hip_atomic_store(tmo, 1u, __ATOMIC_RELAXED, __HIP_MEMORY_SCOPE_AGENT); break; }
            }
            __builtin_amdgcn_fence(__ATOMIC_ACQUIRE, "agent");
        }
        asm volatile("s_waitcnt vmcnt(0) lgkmcnt(0)" ::: "memory"); __builtin_amdgcn_s_barrier(); asm volatile("" ::: "memory");
        if (lane < 32) {
            const unsigned long long* slot = xbuf + (size_t)(u.pm * BM + row) * 4; float mt[4], m2[4]; float ms = 0.f;
#pragma unroll
            for (int t = 0; t < 4; ++t) { const unsigned long long w = __hip_atomic_load(slot + t, __ATOMIC_RELAXED, __HIP_MEMORY_SCOPE_AGENT); mt[t] = __uint_as_float((unsigned)w); m2[t] = __uint_as_float((unsigned)(w >> 32)); ms += mt[t]; }
            const float mean = ms * 0.25f; float q = 0.f;
#pragma unroll
            for (int t = 0; t < 4; ++t) { const float dm = mt[t] - mean; q += m2[t] + 256.0f * dm * dm; }
            S[row] = (f32x2v){mean, 1.0f / sqrtf(q * (1.0f / 1024.0f) + LN_EPS)};
        }
        asm volatile("s_waitcnt lgkmcnt(0)" ::: "memory"); __builtin_amdgcn_s_barrier(); asm volatile("" ::: "memory");
        const int colg = u.pn * BM + wc * 32 + 8 * fq;
        f32x4 gv[2][2], bv[2][2];
#pragma unroll
        for (int bj = 0; bj < 2; ++bj)
#pragma unroll
            for (int n = 0; n < 2; ++n) { gv[bj][n] = *(const f32x4*)(g + colg + bj * HALF + 4 * n); bv[bj][n] = *(const f32x4*)(b + colg + bj * HALF + 4 * n); }
#pragma unroll
        for (int ai = 0; ai < 2; ++ai)
#pragma unroll
            for (int m = 0; m < 4; ++m) { const f32x2v sr = S[ai * HALF + wr * 64 + m * 16 + fr];
#pragma unroll
                for (int bj = 0; bj < 2; ++bj) {
                    const f32x4 v0 = (acc[ai][bj][m][0] - sr.x) * sr.y * gv[bj][0] + bv[bj][0], v1 = (acc[ai][bj][m][1] - sr.x) * sr.y * gv[bj][1] + bv[bj][1];
                    u32x4 w; w.x = cvt_pk_bf16(v0[0], v0[1]); w.y = cvt_pk_bf16(v0[2], v0[3]); w.z = cvt_pk_bf16(v1[0], v1[1]); w.w = cvt_pk_bf16(v1[2], v1[3]);
                    *(u32x4*)(xb0 + (size_t)(ai * HALF + m * 16) * 1024 + bj * HALF) = w; } }
    }
};
}

__device__ __forceinline__ void cvt_item(const float* W, int K, int N, bf16* WT, int mode, int rowbase, int item, int nblk, int lane) {
    const int kb = item / nblk, nb = item - kb * nblk, k0 = 32 * kb, n = 64 * nb + lane;
    const bool ok = n < N;
    const float* src = W + (size_t)k0 * N + (ok ? n : 0);
    float v[32];
#pragma unroll
    for (int i = 0; i < 32; ++i) v[i] = __builtin_nontemporal_load(src + (size_t)i * N);
    const int row = (mode == 0) ? n : ((n >> 7) * 256 + (n & 127) + (mode == 2 ? 128 : 0));
    bf16* dst = WT + (size_t)(rowbase + row) * K + k0;
#pragma unroll
    for (int g = 0; g < 4; ++g) { v4u o;
        o.x = ok ? pk2(v[8 * g], v[8 * g + 1]) : 0u; o.y = ok ? pk2(v[8 * g + 2], v[8 * g + 3]) : 0u; o.z = ok ? pk2(v[8 * g + 4], v[8 * g + 5]) : 0u; o.w = ok ? pk2(v[8 * g + 6], v[8 * g + 7]) : 0u;
        *(GAS v4u*)(dst + 8 * g) = o; }
}
__device__ __forceinline__ void cvt_even(Frame& F, int j) {
    bf16* wb = (bf16*)(F.ws + WS_WB);
    const float* w_in = F.inp(1) + (size_t)j * D * EIN; const float* w_out = F.inp(10) + (size_t)j * D * D;
    const float* w_g = F.inp(13) + (size_t)j * D * FF; const float* w_u = F.inp(14) + (size_t)j * D * FF; const float* w_d = F.inp(15) + (size_t)j * FF * D;
    constexpr int I_IN = 32 * 44, I_OUT = 32 * 16, I_G = 32 * 44, I_D = 88 * 16, TOT = I_IN + I_OUT + 2 * I_G + I_D;
    for (int it = F.gw; it < TOT; it += F.NGW) {
        int r = it;
        if (r < I_IN) { cvt_item(w_in, D, EIN, wb + WB_WIN / 2, 0, 0, r, 44, F.lane); continue; } r -= I_IN;
        if (r < I_OUT) { cvt_item(w_out, D, D, wb + WB_WOUT / 2, 0, 0, r, 16, F.lane); continue; } r -= I_OUT;
        if (r < I_G) { cvt_item(w_g, D, FF, wb + WB_WGU / 2, 1, 0, r, 44, F.lane); continue; } r -= I_G;
        if (r < I_G) { cvt_item(w_u, D, FF, wb + WB_WGU / 2, 2, 0, r, 44, F.lane); continue; } r -= I_G;
        cvt_item(w_d, FF, D, wb + WB_WDN / 2, 0, 0, r, 16, F.lane);
    }
}
__device__ __forceinline__ void cvt_odd(Frame& F, int j) {
    bf16* wb = (bf16*)(F.ws + WS_WB);
    const float* w_qkv = F.inp(18) + (size_t)j * D * 3072; const float* w_out = F.inp(24) + (size_t)j * D * D;
    const float* w_g = F.inp(29) + (size_t)j * NEXP * D * FF; const float* w_u = F.inp(30) + (size_t)j * NEXP * D * FF; const float* w_d = F.inp(31) + (size_t)j * NEXP * FF * D;
    constexpr int I_QKV = 32 * 48, I_OUT = 32 * 16, I_E = 1408, TOT = I_QKV + I_OUT + 24 * I_E;
    for (int it = F.gw; it < TOT; it += F.NGW) {
        int r = it;
        if (r < I_QKV) { cvt_item(w_qkv, D, 3072, wb + WB_WQKV / 2, 0, 0, r, 48, F.lane); continue; } r -= I_QKV;
        if (r < I_OUT) { cvt_item(w_out, D, D, wb + WB_WOUT / 2, 0, 0, r, 16, F.lane); continue; } r -= I_OUT;
        const int mat = r / I_E, item = r - mat * I_E, kind = mat >> 3, e = mat & 7;
        if (kind == 0) cvt_item(w_g + (size_t)e * D * FF, D, FF, wb + WB_MGU / 2, 1, e * 5632, item, 44, F.lane);
        else if (kind == 1) cvt_item(w_u + (size_t)e * D * FF, D, FF, wb + WB_MGU / 2, 2, e * 5632, item, 44, F.lane);
        else cvt_item(w_d + (size_t)e * FF * D, FF, D, wb + WB_MDN / 2, 0, e * 1024, item, 16, F.lane);
    }
}
__device__ __forceinline__ void xb_from_x(Frame& F) {
    const float* x = F.inp(0); bf16* xb = (bf16*)(F.ws + WS_XB);
    for (int m = F.gw; m < M; m += F.NGW) {
        const GAS f32x4* xr = (const GAS f32x4*)(x + (size_t)m * D) + F.lane;
        GAS unsigned long long* o8 = (GAS unsigned long long*)(xb + (size_t)m * D) + F.lane;
#pragma unroll
        for (int j = 0; j < 4; ++j) { const f32x4 v = xr[64 * j]; o8[64 * j] = (unsigned long long)pk2(v.x, v.y) | ((unsigned long long)pk2(v.z, v.w) << 32); }
    }
}

template <int MODE, bool XBF>
__device__ __forceinline__ void ln_load(f32x4 (&v)[4], int m, int lane, const float* xin, const bf16* xb, const bf16* Hb, const int* r_p, const float* r_g) {
    f32x4 xv4[4];
    if (XBF) { const GAS unsigned long long* xr8 = (const GAS unsigned long long*)(xb + (size_t)m * D) + lane;
#pragma unroll
        for (int j = 0; j < 4; ++j) { const unsigned long long xw = xr8[64 * j]; const unsigned lo = (unsigned)xw, hi = (unsigned)(xw >> 32); xv4[j] = (f32x4){bflo(lo), bfhi(lo), bflo(hi), bfhi(hi)}; } }
    else { const GAS f32x4* xr = (const GAS f32x4*)(xin + (size_t)m * D) + lane;
#pragma unroll
        for (int j = 0; j < 4; ++j) xv4[j] = xr[64 * j]; }
    if (MODE == 0) {
        const GAS unsigned long long* hr = (const GAS unsigned long long*)(Hb + (size_t)m * D) + lane;
#pragma unroll
        for (int j = 0; j < 4; ++j) { const f32x4 xv = xv4[j]; const unsigned long long hw = hr[64 * j]; const unsigned lo = (unsigned)hw, hi = (unsigned)(hw >> 32);
            v[j].x = ALPHA * xv.x + bflo(lo); v[j].y = ALPHA * xv.y + bfhi(lo); v[j].z = ALPHA * xv.z + bflo(hi); v[j].w = ALPHA * xv.w + bfhi(hi); }
    } else {
        const int p0 = r_p[2 * m], p1 = r_p[2 * m + 1]; const float g0 = r_g[2 * m], g1 = r_g[2 * m + 1];
        const GAS unsigned long long* h0 = (const GAS unsigned long long*)(Hb + (size_t)p0 * D) + lane;
        const GAS unsigned long long* h1 = (const GAS unsigned long long*)(Hb + (size_t)p1 * D) + lane;
#pragma unroll
        for (int j = 0; j < 4; ++j) { const f32x4 xv = xv4[j]; const unsigned long long a = h0[64 * j], c = h1[64 * j];
            const unsigned al = (unsigned)a, ah = (unsigned)(a >> 32), cl = (unsigned)c, ch = (unsigned)(c >> 32);
            v[j].x = ALPHA * xv.x + (g0 * bflo(al) + g1 * bflo(cl)); v[j].y = ALPHA * xv.y + (g0 * bfhi(al) + g1 * bfhi(cl));
            v[j].z = ALPHA * xv.z + (g0 * bflo(ah) + g1 * bflo(ch)); v[j].w = ALPHA * xv.w + (g0 * bfhi(ah) + g1 * bfhi(ch)); }
    }
}
template <int MODE, bool ROUTER, bool XBF  , bool WRITE_F32>
__device__ __forceinline__ void ln_phase(Frame& F, const float* xin, const bf16* Hb, const float* g, const float* b, float* xout, bf16* xb,
                                         const float* rw, const float* rb, int lslot) {
    int* r_e = (int*)(F.ws + WS_ROUTE); float* r_g = (float*)(F.ws + WS_ROUTE + 256 * 1024); int* r_i = (int*)(F.ws + WS_ROUTE + 512 * 1024); int* r_p = (int*)(F.ws + WS_ROUTE + 768 * 1024);
    LAS float* wr = (LAS float*)F.lds;
    LAS int* lcnt = (LAS int*)(F.lds + 32768);
    LAS int* lrk = (LAS int*)(F.lds + 32768 + 64);
    LAS int* lex = (LAS int*)(F.lds + 32768 + 64 + 4096);
    LAS int* wbase = (LAS int*)(F.lds + 32768 + 32);
    const int r0 = (int)((long)F.bx * M / F.G), r1 = (int)((long)(F.bx + 1) * M / F.G);
    if (ROUTER) {
        for (int i = F.tid; i < D * NEXP; i += NTHR) wr[i] = rw[i];
        if (F.tid < 8) lcnt[F.tid] = 0;
        __syncthreads();
    }
    f32x4 gg[4], bb[4];
#pragma unroll
    for (int j = 0; j < 4; ++j) { gg[j] = *((const GAS f32x4*)g + F.lane + 64 * j); bb[j] = *((const GAS f32x4*)b + F.lane + 64 * j); }
    f32x4 v[4], vn[4];
    int m = r0 + F.wave;
    if (m < r1) ln_load<MODE, XBF>(v, m, F.lane, xin, xb, Hb, r_p, r_g);
    for (; m < r1; m += NWAVES) {
        const bool more = m + NWAVES < r1;
        if (more) ln_load<MODE, XBF>(vn, m + NWAVES, F.lane, xin, xb, Hb, r_p, r_g);
        float s = 0.f;
#pragma unroll
        for (int j = 0; j < 4; ++j) s += (v[j].x + v[j].y) + (v[j].z + v[j].w);
        const float mean = wave_sum_fd(s) * (1.f / D); float s2 = 0.f;
#pragma unroll
        for (int j = 0; j < 4; ++j) { v[j] = v[j] - mean; s2 += (v[j].x * v[j].x + v[j].y * v[j].y) + (v[j].z * v[j].z + v[j].w * v[j].w); }
        const float rstd = 1.f / sqrtf(wave_sum_fd(s2) * (1.f / D) + LN_EPS);
        GAS f32x4* xo = (GAS f32x4*)(xout + (size_t)m * D) + F.lane;
        GAS unsigned long long* o8 = (GAS unsigned long long*)(xb + (size_t)m * D) + F.lane;
#pragma unroll
        for (int j = 0; j < 4; ++j) {
            v[j] = v[j] * rstd * gg[j] + bb[j]; if (WRITE_F32) xo[64 * j] = v[j];
            else o8[64 * j] = (unsigned long long)pk2(v[j].x, v[j].y) | ((unsigned long long)pk2(v[j].z, v[j].w) << 32);
        }
        if (ROUTER) {
            float pl[NEXP];
#pragma unroll
            for (int e = 0; e < NEXP; ++e) pl[e] = 0.f;
#pragma unroll
            for (int j = 0; j < 4; ++j)
#pragma unroll
                for (int c = 0; c < 4; ++c) { const float xv = v[j][c]; const LAS f32x4* w4 = (const LAS f32x4*)(wr + (size_t)(4 * F.lane + 256 * j + c) * NEXP); const f32x4 wa = w4[0], wb = w4[1];
                    pl[0] += xv * wa.x; pl[1] += xv * wa.y; pl[2] += xv * wa.z; pl[3] += xv * wa.w; pl[4] += xv * wb.x; pl[5] += xv * wb.y; pl[6] += xv * wb.z; pl[7] += xv * wb.w; }
            float best0 = -INFINITY, best1 = -INFINITY; int e0 = 0, e1 = 0;
#pragma unroll
            for (int e = 0; e < NEXP; ++e) { const float l = wave_sum_fd(pl[e]) + rb[e];
                if (l > best0) { best1 = best0; e1 = e0; best0 = l; e0 = e; } else if (l > best1) { best1 = l; e1 = e; } }
            const float ex = __expf(best1 - best0), g0 = 1.f / (1.f + ex), g1 = ex / (1.f + ex);
            if (F.lane == 0) {
                lex[2 * (m - r0)] = e0; lex[2 * (m - r0) + 1] = e1;
                r_g[2 * m] = g0; r_g[2 * m + 1] = g1;
            }
        }
        if (more) {
#pragma unroll
            for (int j = 0; j < 4; ++j) v[j] = vn[j];
        }
    }
    if (ROUTER) {
        __syncthreads();
        const int nent = 2 * (r1 - r0);
        const int e = (F.tid < nent) ? lex[F.tid] : -1; int inr = 0;
#pragma unroll
        for (int k = 0; k < NEXP; ++k) {
            const unsigned long long mk = __ballot(e == k);
            const int below = (int)__builtin_amdgcn_mbcnt_hi((unsigned)(mk >> 32), __builtin_amdgcn_mbcnt_lo((unsigned)mk, 0u));
            inr = (e == k) ? below : inr;
            if (F.lane == 0) lrk[F.wave * NEXP + k] = (int)__builtin_popcountll(mk);
        }
        __syncthreads();
        if (F.tid < nent) { int base = 0;
#pragma unroll
            for (int w = 0; w < NWAVES; ++w) base += (w < F.wave) ? lrk[w * NEXP + e] : 0;
            r_e[2 * r0 + F.tid] = e; r_i[2 * r0 + F.tid] = base + inr; }
        if (F.tid < NEXP) { int t = 0;
#pragma unroll
            for (int w = 0; w < NWAVES; ++w) t += lrk[w * NEXP + F.tid];
            ((int*)(F.ws + WS_CNTT))[F.bx * NEXP + F.tid] = t; }
        __syncthreads();
    }
    (void)lcnt; (void)wbase; (void)lslot;
}

__device__ __forceinline__ void moe_map(Frame& F, int lslot) {
    const int* r_e = (const int*)(F.ws + WS_ROUTE); const int* r_i = (const int*)(F.ws + WS_ROUTE + 512 * 1024); int* r_p = (int*)(F.ws + WS_ROUTE + 768 * 1024);
    int* inv = (int*)(F.ws + WS_INV);
    LAS int* tab = (LAS int*)F.lds; LAS int* pre = (LAS int*)(F.lds + 8192); LAS int* tot = (LAS int*)(F.lds + 16384);
    { const int* cntt = (const int*)(F.ws + WS_CNTT); for (int i = F.tid; i < F.G * NEXP; i += NTHR) tab[i] = cntt[i]; }
    __syncthreads();
    { const int e = F.wave, l4 = 4 * F.lane;
        const int c0 = tab[(l4 + 0) * NEXP + e], c1 = tab[(l4 + 1) * NEXP + e], c2 = tab[(l4 + 2) * NEXP + e], c3 = tab[(l4 + 3) * NEXP + e];
        const int sm = (c0 + c1) + (c2 + c3), inc = wave_incl_scan_i(sm, F.lane), ex = inc - sm;
        pre[(l4 + 0) * NEXP + e] = ex; pre[(l4 + 1) * NEXP + e] = ex + c0; pre[(l4 + 2) * NEXP + e] = ex + c0 + c1; pre[(l4 + 3) * NEXP + e] = ex + c0 + c1 + c2;
        if (F.lane == 63) tot[e] = inc; }
    __syncthreads();
    int sb[NEXP + 1]; unsigned cn[NEXP]; { int a = 0;
#pragma unroll
        for (int e = 0; e < NEXP; ++e) { cn[e] = (unsigned)tot[e]; sb[e] = a; a += (int)((cn[e] + 255u) & ~255u); } sb[NEXP] = a; }
    if (F.bx == 0 && F.tid < NEXP) F.ctl[CW_CNT + 16 * lslot + F.tid] = (unsigned)tot[F.tid];
    const int gt = F.bx * NTHR + F.tid, NG = F.G * NTHR;
    for (int ent = gt; ent < 2 * M; ent += NG) {
        const int e = r_e[ent], idx = r_i[ent] + pre[(ent >> 8) * NEXP + e]; int base = 0;
#pragma unroll
        for (int k = 0; k < NEXP; ++k) base = (e == k) ? sb[k] : base;
        const int pos = base + idx; r_p[ent] = pos; inv[pos] = ent >> 1;
    }
    for (int p = gt; p < NEXP * 256; p += NG) { const int e = p >> 8, k = p & 255; int b0 = 0, b1 = 0; unsigned c = 0;
#pragma unroll
        for (int q = 0; q < NEXP; ++q) { if (e == q) { b0 = sb[q]; b1 = sb[q + 1]; c = cn[q]; } }
        const int pos = b0 + (int)c + k; if (pos < b1) inv[pos] = 0; }
    __syncthreads();
}

typedef float f32x4_t __attribute__((ext_vector_type(4)));
typedef short bf16x8_t __attribute__((ext_vector_type(8)));
typedef unsigned u32x4_t __attribute__((ext_vector_type(4)));
typedef float f32x16_t __attribute__((ext_vector_type(16)));
typedef unsigned u32x2_t __attribute__((ext_vector_type(2)));
constexpr int GLA_RT = 72;
__device__ __forceinline__ void gla_put_vt(LAS bf16* sVt, int tid, v4u w0, v4u w1) {
    const int t = tid & 63, ec = tid >> 6;
#pragma unroll
    for (int it = 0; it < 2; ++it) { const v4u w = it ? w1 : w0; LAS bf16* d = sVt + 8 * (ec + 8 * it) * GLA_RT + t;
        d[0 * GLA_RT] = (bf16)(w.x & 0xffffu); d[1 * GLA_RT] = (bf16)(w.x >> 16); d[2 * GLA_RT] = (bf16)(w.y & 0xffffu); d[3 * GLA_RT] = (bf16)(w.y >> 16);
        d[4 * GLA_RT] = (bf16)(w.z & 0xffffu); d[5 * GLA_RT] = (bf16)(w.z >> 16); d[6 * GLA_RT] = (bf16)(w.w & 0xffffu); d[7 * GLA_RT] = (bf16)(w.w >> 16); }
}
__device__ __forceinline__ void unpk8(v4u w, float* f) { f[0] = bflo(w.x); f[1] = bfhi(w.x); f[2] = bflo(w.y); f[3] = bfhi(w.y); f[4] = bflo(w.z); f[5] = bfhi(w.z); f[6] = bflo(w.w); f[7] = bfhi(w.w); }
__device__ __forceinline__ void dsa_prep(Frame& F, int j) {
    const bf16* P = (const bf16*)(F.ws + WS_P); bf16* KD = (bf16*)(F.ws + WS_KD); bf16* VD = (bf16*)(F.ws + WS_VD); bf16* KI = (bf16*)(F.ws + WS_KI);
    const float* kvg = F.inp(2) + j * 128; const float* wuk = F.inp(3) + (size_t)j * 128 * 64; const float* wuv = F.inp(4) + (size_t)j * 128 * 64;
    const float* kg = F.inp(5) + j * 64; const float* kb = F.inp(6) + j * 64;
    constexpr int WT_RS = 136;
    LAS bf16* sWt = (LAS bf16*)F.lds;
    for (int i = F.tid; i < 128 * 128; i += NTHR) {
        const int c = i >> 7, f = i & 127; const float w = (f < 64) ? wuk[c * 64 + f] * C2 : wuv[c * 64 + (f - 64)];
        sWt[f * WT_RS + c] = (bf16)f2bf(w * kvg[c]); }
    __syncthreads();
    const int lane = F.lane, t16 = lane & 15, quad = lane >> 4;
    bf16x8_t af[8][4];
#pragma unroll
    for (int ft = 0; ft < 8; ++ft)
#pragma unroll
        for (int ks = 0; ks < 4; ++ks) af[ft][ks] = *(const LAS bf16x8_t*)(sWt + (16 * ft + t16) * WT_RS + 32 * ks + 8 * quad);
    float kgl[16], kbl[16];
#pragma unroll
    for (int k = 0; k < 16; ++k) { kgl[k] = kg[16 * quad + k]; kbl[k] = kb[16 * quad + k]; }
    for (int m0 = F.gw * 16; m0 < M; m0 += F.NGW * 16) {
        const bf16* pr = P + (size_t)(m0 + t16) * EINP;
        bf16x8_t cf[4]; float ss = 0.f;
#pragma unroll
        for (int ks = 0; ks < 4; ++ks) { const v4u w = *(const v4u*)(pr + PC_CKV + 32 * ks + 8 * quad); cf[ks] = __builtin_bit_cast(bf16x8_t, w);
            float f8[8]; unpk8(w, f8);
#pragma unroll
            for (int k = 0; k < 8; ++k) ss += f8[k] * f8[k]; }
        ss += __int_as_float(__builtin_amdgcn_ds_bpermute((lane ^ 16) << 2, __float_as_int(ss))); ss += __int_as_float(__builtin_amdgcn_ds_bpermute((lane ^ 32) << 2, __float_as_int(ss)));
        const float rs = 1.f / sqrtf(ss * (1.f / 128.f) + RMS_EPS);
#pragma unroll
        for (int ft = 0; ft < 8; ++ft) {
            f32x4_t c = {0.f, 0.f, 0.f, 0.f};
#pragma unroll
            for (int ks = 0; ks < 4; ++ks) c = __builtin_amdgcn_mfma_f32_16x16x32_bf16(af[ft][ks], cf[ks], c, 0, 0, 0);
            u32x2_t o; o.x = pk2(c[0] * rs, c[1] * rs); o.y = pk2(c[2] * rs, c[3] * rs);
            bf16* dst = (ft < 4 ? KD : VD) + (size_t)(m0 + t16) * 64 + 16 * (ft & 3) + 4 * quad;
            *(u32x2_t*)dst = o;
        }
        {
            float x[16]; const v4u w0 = *(const v4u*)(pr + PC_KI + 16 * quad), w1 = *(const v4u*)(pr + PC_KI + 16 * quad + 8); unpk8(w0, x); unpk8(w1, x + 8);
            float s = 0.f;
#pragma unroll
            for (int k = 0; k < 16; ++k) s += x[k];
            s += __int_as_float(__builtin_amdgcn_ds_bpermute((lane ^ 16) << 2, __float_as_int(s))); s += __int_as_float(__builtin_amdgcn_ds_bpermute((lane ^ 32) << 2, __float_as_int(s)));
            const float mean = s * (1.f / 64.f); float q = 0.f;
#pragma unroll
            for (int k = 0; k < 16; ++k) { x[k] -= mean; q += x[k] * x[k]; }
            q += __int_as_float(__builtin_amdgcn_ds_bpermute((lane ^ 16) << 2, __float_as_int(q))); q += __int_as_float(__builtin_amdgcn_ds_bpermute((lane ^ 32) << 2, __float_as_int(q)));
            const float rstd = 1.f / sqrtf(q * (1.f / 64.f) + LN_EPS);
            v4u o0, o1;
            o0.x = pk2(x[0] * rstd * kgl[0] + kbl[0], x[1] * rstd * kgl[1] + kbl[1]); o0.y = pk2(x[2] * rstd * kgl[2] + kbl[2], x[3] * rstd * kgl[3] + kbl[3]);
            o0.z = pk2(x[4] * rstd * kgl[4] + kbl[4], x[5] * rstd * kgl[5] + kbl[5]); o0.w = pk2(x[6] * rstd * kgl[6] + kbl[6], x[7] * rstd * kgl[7] + kbl[7]);
            o1.x = pk2(x[8] * rstd * kgl[8] + kbl[8], x[9] * rstd * kgl[9] + kbl[9]); o1.y = pk2(x[10] * rstd * kgl[10] + kbl[10], x[11] * rstd * kgl[11] + kbl[11]);
            o1.z = pk2(x[12] * rstd * kgl[12] + kbl[12], x[13] * rstd * kgl[13] + kbl[13]); o1.w = pk2(x[14] * rstd * kgl[14] + kbl[14], x[15] * rstd * kgl[15] + kbl[15]);
            bf16* kd = KI + (size_t)(m0 + t16) * 64 + 16 * quad; *(v4u*)kd = o0; *(v4u*)(kd + 8) = o1;
        }
    }
    __syncthreads();
}

struct GlaPrepIn { v4u v0, v1, g0, g1, q, k; };
__device__ __forceinline__ GlaPrepIn gla_prep_load(const bf16* P, int unit, int tid) {
    const int h = unit & 3, tok0 = (unit >> 2) * 64; GlaPrepIn r;
    { const int t = tid & 63, ec = tid >> 6; const bf16* p = P + (size_t)(tok0 + t) * EINP + PC_BV + h * 128 + 8 * ec; r.v0 = *(const v4u*)p; r.v1 = *(const v4u*)(p + 64); }
    { const int t = tid >> 3, dg = tid & 7; const bf16* p = P + (size_t)(tok0 + t) * EINP;
      r.g0 = *(const v4u*)(p + PC_BG); r.g1 = *(const v4u*)(p + PC_BG + 8); r.q = *(const v4u*)(p + PC_BQ + h * 64 + 8 * dg); r.k = *(const v4u*)(p + PC_BK + h * 64 + 8 * dg); }
    return r;
}
__device__ __forceinline__ void gla_prep(Frame& F, int j) {
    const bf16* P = (const bf16*)(F.ws + WS_P); bf16* QT = (bf16*)(F.ws + WS_QT); bf16* KT = (bf16*)(F.ws + WS_KT);
    float* EBL = (float*)(F.ws + WS_EBL); float* GST = (float*)(F.ws + WS_GST);
    const float* wg2 = F.inp(7) + (size_t)j * 16 * 256; const float* bgb = F.inp(8) + j * 256;
    LAS float* sG = (LAS float*)F.lds;
    LAS float* sSeg = sG + 4096;
    LAS bf16* sKHt = (LAS bf16*)(F.lds + 18432);
    LAS bf16* sVt = (LAS bf16*)(F.lds + 27648);
    LAS float* sW = (LAS float*)(F.lds + 46080);
    const int tid = F.tid, lane = F.lane, hi = lane >> 5, r32 = lane & 31;
    const int NU = BATCH * 32 * 4;
    int hw = -1;
    GlaPrepIn cur; if (F.bx < NU) cur = gla_prep_load(P, F.bx, tid);
    for (int unit = F.bx; unit < NU; unit += F.G) {
        const int h = unit & 3, bc = unit >> 2, tok0 = bc * 64;
        GlaPrepIn nxt = cur; if (unit + F.G < NU) nxt = gla_prep_load(P, unit + F.G, tid);
        if (h != hw) { for (int i = tid; i < 1024; i += NTHR) sW[i] = wg2[(i >> 6) * 256 + h * 64 + (i & 63)]; if (tid < 64) sW[1024 + tid] = bgb[h * 64 + tid]; hw = h; }
        gla_put_vt(sVt, tid, cur.v0, cur.v1);
        __syncthreads();
        const int t8 = tid >> 3, dg = tid & 7;
        {
            float bg[16]; unpk8(cur.g0, bg); unpk8(cur.g1, bg + 8);
#pragma unroll
            for (int k = 0; k < 8; ++k) { const int d = 8 * dg + k; float z = sW[1024 + d];
#pragma unroll
                for (int r = 0; r < 16; ++r) z += bg[r] * sW[r * 64 + d];
                sG[t8 * 64 + d] = (fminf(z, 0.f) - __logf(1.f + __expf(-fabsf(z)))) * (1.f / 16.f); }
        }
        __syncthreads();
        {
            const int d = tid & 63, seg = tid >> 6; float pre[8], run = 0.f;
#pragma unroll
            for (int k = 0; k < 8; ++k) { run += sG[(8 * seg + k) * 64 + d]; pre[k] = run; }
            sSeg[seg * 64 + d] = run;
            __syncthreads();
            float off = 0.f;
#pragma unroll
            for (int s2 = 0; s2 < 7; ++s2) off += (s2 < seg) ? sSeg[s2 * 64 + d] : 0.f;
#pragma unroll
            for (int k = 0; k < 8; ++k) sG[(8 * seg + k) * 64 + d] = off + pre[k];
        }
        __syncthreads();
        {
            float q[8], kk[8]; unpk8(cur.q, q); unpk8(cur.k, kk);
            const f32x4 b0 = *(const LAS f32x4*)(sG + t8 * 64 + 8 * dg), b1 = *(const LAS f32x4*)(sG + t8 * 64 + 8 * dg + 4);
            const f32x4 l0 = *(const LAS f32x4*)(sG + 63 * 64 + 8 * dg), l1 = *(const LAS f32x4*)(sG + 63 * 64 + 8 * dg + 4);
            const float bb[8] = {b0.x, b0.y, b0.z, b0.w, b1.x, b1.y, b1.z, b1.w}, bl[8] = {l0.x, l0.y, l0.z, l0.w, l1.x, l1.y, l1.z, l1.w};
            float qo[8], ko[8];
#pragma unroll
            for (int k = 0; k < 8; ++k) { qo[k] = q[k] * 0.125f * __expf(bb[k]); ko[k] = kk[k] * __expf(-bb[k]); sKHt[(8 * dg + k) * GLA_RT + t8] = (bf16)f2bf(kk[k] * __expf(bl[k] - bb[k])); }
            v4u wq, wk; wq.x = pk2(qo[0], qo[1]); wq.y = pk2(qo[2], qo[3]); wq.z = pk2(qo[4], qo[5]); wq.w = pk2(qo[6], qo[7]); wk.x = pk2(ko[0], ko[1]); wk.y = pk2(ko[2], ko[3]); wk.z = pk2(ko[4], ko[5]); wk.w = pk2(ko[6], ko[7]);
            { const size_t fo = (size_t)unit * 4096 + (size_t)((((t8 >> 5) * 4 + (dg >> 1)) * 64 + (t8 & 31) + 32 * (dg & 1)) * 8);
              *(v4u*)(QT + fo) = wq; *(v4u*)(KT + fo) = wk; }
            if (t8 == 63) {
#pragma unroll
                for (int k = 0; k < 8; ++k) EBL[(size_t)bc * 256 + h * 64 + 8 * dg + k] = __expf(bl[k]); }
        }
        __syncthreads();
        {
            const int db = F.wave >> 2, eb = F.wave & 3; f32x16_t acc = {};
#pragma unroll
            for (int ks = 0; ks < 4; ++ks) {
                const bf16x8_t a = *(const LAS bf16x8_t*)(sKHt + (32 * db + r32) * GLA_RT + 16 * ks + 8 * hi);
                const bf16x8_t bfr = *(const LAS bf16x8_t*)(sVt + (32 * eb + r32) * GLA_RT + 16 * ks + 8 * hi);
                acc = __builtin_amdgcn_mfma_f32_32x32x16_bf16(a, bfr, acc, 0, 0, 0); }
            float* g = GST + (size_t)unit * 8192 + 4 * hi;
#pragma unroll
            for (int rg = 0; rg < 4; ++rg) *(f32x4_t*)(g + (((eb * 4 + 2 * db + (rg >> 1)) * 64 + r32 + 32 * (rg & 1)) * 8)) = (f32x4_t){acc[4 * rg], acc[4 * rg + 1], acc[4 * rg + 2], acc[4 * rg + 3]};
        }
        __syncthreads();
        cur = nxt;
    }
}
__device__ __forceinline__ void gla_scan(Frame& F) {
    float* GST = (float*)(F.ws + WS_GST); const float* EBL = (const float*)(F.ws + WS_EBL);
    const int gt = F.bx * NTHR + F.tid, NG = F.G * NTHR;
    for (int idx = gt; idx < BATCH * 4 * 8192; idx += NG) {
        const int de = idx & 8191, h = (idx >> 13) & 3, b = idx >> 15, d = 16 * ((de >> 9) & 3) + 8 * ((de >> 8) & 1) + (de & 7);
        float S = 0.f;
#pragma unroll 8
        for (int c = 0; c < 32; ++c) { const size_t off = (size_t)(((b * 32 + c) << 2) + h) * 8192 + de; const float a = GST[off]; GST[off] = S; S = EBL[(size_t)(b * 32 + c) * 256 + h * 64 + d] * S + a; }
    }
}
struct GlaOutIn { v4u v0, v1; bf16x8_t qf[4], kf[2][4]; f32x4_t st[8]; unsigned rw[8]; };
__device__ __forceinline__ GlaOutIn gla_out_load(const bf16* P, const bf16* QT, const bf16* KT, const float* GST, int unit, int tid, int wave, int lane) {
    const int h = unit & 3, tok0 = (unit >> 2) * 64, hi = lane >> 5, r32 = lane & 31, ib = wave & 1, eb = wave >> 1; GlaOutIn r;
    { const int t = tid & 63, ec = tid >> 6; const bf16* p = P + (size_t)(tok0 + t) * EINP + PC_BV + h * 128 + 8 * ec; r.v0 = *(const v4u*)p; r.v1 = *(const v4u*)(p + 64); }
#pragma unroll
    for (int ks = 0; ks < 4; ++ks) { r.qf[ks] = *(const bf16x8_t*)(QT + (size_t)unit * 4096 + ((ib * 4 + ks) * 64 + lane) * 8);
        r.kf[0][ks] = *(const bf16x8_t*)(KT + (size_t)unit * 4096 + ((0 * 4 + ks) * 64 + lane) * 8);
        r.kf[1][ks] = *(const bf16x8_t*)(KT + (size_t)unit * 4096 + ((1 * 4 + ks) * 64 + lane) * 8); }
    const float* sr = GST + (size_t)unit * 8192;
#pragma unroll
    for (int ks = 0; ks < 4; ++ks) { r.st[2 * ks] = *(const f32x4_t*)(sr + ((eb * 4 + ks) * 64 + lane) * 8); r.st[2 * ks + 1] = *(const f32x4_t*)(sr + ((eb * 4 + ks) * 64 + lane) * 8 + 4); }
#pragma unroll
    for (int i = 0; i < 8; ++i) r.rw[i] = *(const unsigned*)(P + (size_t)(tok0 + wave + 8 * i) * EINP + PC_BR + h * 128 + 2 * lane);
    return r;
}
__device__ __forceinline__ void gla_out(Frame& F, int j) {
    const bf16* P = (const bf16*)(F.ws + WS_P); const bf16* QT = (const bf16*)(F.ws + WS_QT); const bf16* KT = (const bf16*)(F.ws + WS_KT);
    const float* GST = (const float*)(F.ws + WS_GST); bf16* MIX = (bf16*)(F.ws + WS_MIX); const float* ng = F.inp(9) + j * 512;
    LAS bf16* sVt = (LAS bf16*)F.lds;
    LAS float* sO = (LAS float*)(F.lds + 18432);
    const int tid = F.tid, lane = F.lane, hi = lane >> 5, r32 = lane & 31;
    const int ib = F.wave & 1, eb = F.wave >> 1;
    const int NU = BATCH * 32 * 4;
    GlaOutIn cur; if (F.bx < NU) cur = gla_out_load(P, QT, KT, GST, F.bx, tid, F.wave, lane);
    for (int unit = F.bx; unit < NU; unit += F.G) {
        const int h = unit & 3, bc = unit >> 2, tok0 = bc * 64;
        GlaOutIn nxt = cur; if (unit + F.G < NU) nxt = gla_out_load(P, QT, KT, GST, unit + F.G, tid, F.wave, lane);
        gla_put_vt(sVt, tid, cur.v0, cur.v1);
        __syncthreads();
        f32x16_t acc = {};
#pragma unroll
        for (int jb = 0; jb < 2; ++jb) {
            if (jb <= ib) {
                f32x16_t X = {};
#pragma unroll
                for (int ks = 0; ks < 4; ++ks) X = __builtin_amdgcn_mfma_f32_32x32x16_bf16(cur.kf[jb][ks], cur.qf[ks], X, 0, 0, 0);
                if (jb == ib) {
#pragma unroll
                    for (int r = 0; r < 16; ++r) { const int jr = (r & 3) + 8 * (r >> 2) + 4 * hi; if (jr > r32) X[r] = 0.f; }
                }
#pragma unroll
                for (int s2 = 0; s2 < 2; ++s2) {
                    u32x4_t xw; xw.x = pk2(X[8 * s2], X[8 * s2 + 1]); xw.y = pk2(X[8 * s2 + 2], X[8 * s2 + 3]); xw.z = pk2(X[8 * s2 + 4], X[8 * s2 + 5]); xw.w = pk2(X[8 * s2 + 6], X[8 * s2 + 7]);
                    const LAS bf16* vr = sVt + (32 * eb + r32) * GLA_RT + 32 * jb + 16 * s2 + 4 * hi;
                    const u32x2_t a0 = *(const LAS u32x2_t*)vr, a1 = *(const LAS u32x2_t*)(vr + 8);
                    u32x4_t aw; aw.x = a0.x; aw.y = a0.y; aw.z = a1.x; aw.w = a1.y;
                    acc = __builtin_amdgcn_mfma_f32_32x32x16_bf16(__builtin_bit_cast(bf16x8_t, aw), __builtin_bit_cast(bf16x8_t, xw), acc, 0, 0, 0);
                }
            }
        }
#pragma unroll
        for (int ks = 0; ks < 4; ++ks) { const f32x4_t s0 = cur.st[2 * ks], s1 = cur.st[2 * ks + 1];
            u32x4_t aw; aw.x = pk2(s0[0], s0[1]); aw.y = pk2(s0[2], s0[3]); aw.z = pk2(s1[0], s1[1]); aw.w = pk2(s1[2], s1[3]);
            acc = __builtin_amdgcn_mfma_f32_32x32x16_bf16(__builtin_bit_cast(bf16x8_t, aw), cur.qf[ks], acc, 0, 0, 0); }
#pragma unroll
        for (int r = 0; r < 16; ++r) sO[(32 * ib + r32) * 129 + 32 * eb + (r & 3) + 8 * (r >> 2) + 4 * hi] = acc[r];
        __syncthreads();
        const float n0 = ng[h * 128 + 2 * lane], n1 = ng[h * 128 + 2 * lane + 1];
#pragma unroll
        for (int i8 = 0; i8 < 8; ++i8) { const int i = F.wave + 8 * i8;
            const float o0 = sO[i * 129 + 2 * lane], o1 = sO[i * 129 + 2 * lane + 1];
            const float rs = 1.f / sqrtf(wave_sum(o0 * o0 + o1 * o1) * (1.f / 128.f) + RMS_EPS);
            const unsigned rw = cur.rw[i8];
            *(unsigned*)(MIX + (size_t)(tok0 + i) * D + 512 + h * 128 + 2 * lane) = pk2(o0 * rs * n0 * silu_f(bflo(rw)), o1 * rs * n1 * silu_f(bfhi(rw)));
        }
        __syncthreads();
        cur = nxt;
    }
}

__device__ __forceinline__ int wave_sum_dpp(int v) {
    v += __builtin_amdgcn_mov_dpp(v, 0xB1, 0xF, 0xF, true);
    v += __builtin_amdgcn_mov_dpp(v, 0x4E, 0xF, 0xF, true);
    v += __builtin_amdgcn_mov_dpp(v, 0x141, 0xF, 0xF, true);
    v += __builtin_amdgcn_mov_dpp(v, 0x140, 0xF, 0xF, true);
    v += __builtin_amdgcn_update_dpp(0, v, 0x142, 0xA, 0xF, false);
    v += __builtin_amdgcn_update_dpp(0, v, 0x143, 0xC, 0xF, false);
    return __builtin_amdgcn_readlane(v, 63);
}
__device__ __forceinline__ unsigned mono_key(float f) { const unsigned u = __float_as_uint(f); return (u & 0x80000000u) ? ~u : (u | 0x80000000u); }
__device__ __forceinline__ float relu1(float x) { const int b = __float_as_int(x); return __int_as_float(b > 0 ? b : 0); }
__device__ __forceinline__ void dsa_index(Frame& F) {
    const bf16* P = (const bf16*)(F.ws + WS_P); const bf16* KI = (const bf16*)(F.ws + WS_KI);
    unsigned* MASK = (unsigned*)(F.ws + WS_MASK);
    LAS unsigned char* scl = F.lds;
    const int nu = 2 * ((BATCH * 64 - F.bx + F.G - 1) / F.G);
#define IDX_UNIT(u, b_, blk_) do { const int v_ = F.bx + ((u) >> 1) * F.G; b_ = (v_ >> 6) & 15; const int s_ = ((v_ & 63) + 16 * (v_ >> 8)) & 63; blk_ = ((u) & 1) ? 127 - s_ : s_; } while (0)
#define IDX_QLOAD(b_, blk_) do { int ln_ = F.lane; asm volatile("" : "+v"(ln_)); const bf16* qr_ = P + (size_t)((b_) * SEQ + (blk_) * 16 + (ln_ & 15)) * EINP; \
        _Pragma("unroll") for (int h = 0; h < 8; ++h) { qfn[h][0] = *(const bf16x8_t*)(qr_ + PC_QI + h * 64 + 8 * (ln_ >> 4)); qfn[h][1] = *(const bf16x8_t*)(qr_ + PC_QI + h * 64 + 32 + 8 * (ln_ >> 4)); } \
        wnq = *(const v4u*)(qr_ + PC_WI); } while (0)
    bf16x8_t qfn[8][2]; v4u wnq = (v4u){0u, 0u, 0u, 0u};
    { int b0_, blk0_; IDX_UNIT(0, b0_, blk0_); if (blk0_ > 15) IDX_QLOAD(b0_, blk0_); }
#pragma unroll 1
    for (int u = 0; u < nu; ++u) {
        {
            int b, blk; IDX_UNIT(u, b, blk);
            const int q0 = blk * 16, ntk = (q0 >> 6) + 1;
            if (blk > 15) {
                int lane = F.lane; asm volatile("" : "+v"(lane)); const int c16 = lane & 15, quad = lane >> 4;
                bf16x8_t qf[8][2]; float w[8];
#pragma unroll
                for (int h = 0; h < 8; ++h) { qf[h][0] = qfn[h][0]; qf[h][1] = qfn[h][1]; }
                { float f[8]; unpk8(wnq, f);
#pragma unroll
                    for (int h = 0; h < 8; ++h) w[h] = f[h]; }
                const bf16* kbase = KI + (size_t)(b * SEQ + c16) * 64 + 8 * quad;
                LAS unsigned char* wrow = scl + c16 * 8192;
                const int nit = 4 * ntk;
                const int cnt = (nit - F.wave + NWAVES - 1) / NWAVES, last = F.wave + NWAVES * (cnt - 1);
                bf16x8_t afq[4][2];
#pragma unroll
                for (int j = 0; j < 4; ++j) { const int itj = min(F.wave + NWAVES * j, last);
                    afq[j][0] = *(const bf16x8_t*)(kbase + (size_t)(16 * itj) * 64); afq[j][1] = *(const bf16x8_t*)(kbase + (size_t)(16 * itj) * 64 + 32); }
#pragma unroll 1
                for (int base = F.wave; base <= last; base += 4 * NWAVES) {
                    bf16x8_t anx[4][2];
#pragma unroll
                    for (int j = 0; j < 4; ++j) { const int itn = min(base + NWAVES * (j + 4), last);
                        anx[j][0] = *(const bf16x8_t*)(kbase + (size_t)(16 * itn) * 64); anx[j][1] = *(const bf16x8_t*)(kbase + (size_t)(16 * itn) * 64 + 32); }
#pragma unroll
                    for (int j = 0; j < 4; ++j) { const int it = min(base + NWAVES * j, last);
                        const bf16x8_t af0 = afq[j][0], af1 = afq[j][1];
                        f32x4_t sc = {0.f, 0.f, 0.f, 0.f};
                        f32x4_t c8[8];
#pragma unroll
                        for (int h = 0; h < 8; ++h) c8[h] = __builtin_amdgcn_mfma_f32_16x16x32_bf16(af0, qf[h][0], (f32x4_t){0.f, 0.f, 0.f, 0.f}, 0, 0, 0);
#pragma unroll
                        for (int h = 0; h < 8; ++h) c8[h] = __builtin_amdgcn_mfma_f32_16x16x32_bf16(af1, qf[h][1], c8[h], 0, 0, 0);
                        __builtin_amdgcn_sched_barrier(0);
#pragma unroll
                        for (int h = 0; h < 8; ++h) { sc[0] += w[h] * relu1(c8[h][0]); sc[1] += w[h] * relu1(c8[h][1]); sc[2] += w[h] * relu1(c8[h][2]); sc[3] += w[h] * relu1(c8[h][3]); }
                        const int ch = 4 * it + quad;
                        *(LAS f32x4_t*)(wrow + ((ch & ~15) | ((ch ^ (ch >> 4) ^ c16) & 15)) * 16) = sc;
                    }
#pragma unroll
                    for (int j = 0; j < 4; ++j) { afq[j][0] = anx[j][0]; afq[j][1] = anx[j][1]; }
                }
            }
            if (u + 1 < nu) { int b2_, blk2_; IDX_UNIT(u + 1, b2_, blk2_); if (blk2_ > 15) IDX_QLOAD(b2_, blk2_); }
            __syncthreads();
            int lane = F.lane; asm volatile("" : "+v"(lane));
            {
                const int ra = 2 * F.wave, ia = q0 + ra, ib = ia + 1;
                unsigned ma, mb;
                if (ib < TOPK) {
                    const int na = ia - 32 * lane + 1, nb = ib - 32 * lane + 1;
                    ma = na <= 0 ? 0u : (na >= 32 ? 0xffffffffu : ((1u << na) - 1u)); mb = nb <= 0 ? 0u : (nb >= 32 ? 0xffffffffu : ((1u << nb) - 1u));
                } else {
                    unsigned ua[32], ub[32];
#pragma unroll
                    for (int k = 0; k < 8; ++k) { const int ch = 8 * lane + k;
                        const f32x4_t xa = *(const LAS f32x4_t*)(scl + ra * 8192 + ((ch & ~15) | ((ch ^ (ch >> 4) ^ ra) & 15)) * 16);
                        const f32x4_t xb = *(const LAS f32x4_t*)(scl + (ra + 1) * 8192 + ((ch & ~15) | ((ch ^ (ch >> 4) ^ (ra + 1)) & 15)) * 16);
#pragma unroll
                        for (int e = 0; e < 4; ++e) { ua[4 * k + e] = __float_as_uint(xa[e]); ub[4 * k + e] = __float_as_uint(xb[e]); } }
#pragma unroll
                    for (int st = 0; st < 5; ++st) { const int j = 16 >> st; const unsigned m = (st == 0) ? 0x0000FFFFu : (st == 1) ? 0x00FF00FFu : (st == 2) ? 0x0F0F0F0Fu : (st == 3) ? 0x33333333u : 0x55555555u;
#pragma unroll
                        for (int k = 0; k < 32; ++k) if ((k & j) == 0) {
                            { const unsigned hi = ua[k], lo = ua[k + j]; ua[k + j] = (lo & ~m) | ((hi >> j) & m); ua[k] = (hi & ~(m << j)) | ((lo << j) & (m << j)); }
                            { const unsigned hi = ub[k], lo = ub[k + j]; ub[k + j] = (lo & ~m) | ((hi >> j) & m); ub[k] = (hi & ~(m << j)) | ((lo << j) & (m << j)); } }
                        __builtin_amdgcn_sched_barrier(0); }
                    const int nva = ia - 32 * lane + 1, nvb = ib - 32 * lane + 1;
                    unsigned Ga = 0u, Ea = nva <= 0 ? 0u : (nva >= 32 ? 0xffffffffu : ((1u << nva) - 1u)), Gb = 0u, Eb = nvb <= 0 ? 0u : (nvb >= 32 ? 0xffffffffu : ((1u << nvb) - 1u));
                    const unsigned sa = ua[31], sb = ub[31];
#pragma unroll
                    for (int bit = 17; bit >= 0; --bit) {
                        const unsigned pa_ = (bit == 17) ? ~sa : (ua[14 + bit] ^ sa), pb_ = (bit == 17) ? ~sb : (ub[14 + bit] ^ sb);
                        const unsigned ca = Ea & pa_, cb = Eb & pb_;
                        const int tot = wave_sum_dpp(__builtin_popcount(Ga | ca) + (__builtin_popcount(Gb | cb) << 16));
                        if ((tot & 0xffff) >= TOPK) Ea = ca; else { Ga |= ca; Ea ^= ca; }
                        if ((tot >> 16) >= TOPK) Eb = cb; else { Gb |= cb; Eb ^= cb; }
                    }
                    const int ea = __builtin_popcount(Ea), eb = __builtin_popcount(Eb);
                    const int totg = wave_sum_dpp(__builtin_popcount(Ga) + (__builtin_popcount(Gb) << 16));
                    const int tiet = wave_sum_dpp(ea + (eb << 16));
                    const int needa = TOPK - (totg & 0xffff), needb = TOPK - (totg >> 16);
                    if (needa == (tiet & 0xffff) && needb == (tiet >> 16)) { ma = Ga | Ea; mb = Gb | Eb; }
                    else {
                        int pa = wave_incl_scan_i(ea, lane) - ea, pb2 = wave_incl_scan_i(eb, lane) - eb; ma = Ga; mb = Gb;
#pragma unroll
                        for (int r = 0; r < 32; ++r) {
                            const unsigned ba = (Ea >> r) & 1u, bb = (Eb >> r) & 1u;
                            ma |= (ba & (pa < needa ? 1u : 0u)) << r; pa += (int)ba;
                            mb |= (bb & (pb2 < needb ? 1u : 0u)) << r; pb2 += (int)bb;
                        }
                    }
                }
                MASK[(size_t)(b * SEQ + ia) * 64 + lane] = ma; MASK[(size_t)(b * SEQ + ib) * 64 + lane] = mb;
            }
            __syncthreads();
        }
    }
#undef IDX_UNIT
#undef IDX_QLOAD
}

typedef float f32x16_d __attribute__((ext_vector_type(16)));
typedef short v4i16_d __attribute__((ext_vector_type(4)));
constexpr int DT_RSK = 72, DT_RSV = 160;
constexpr int DT_BUF = 64 * DT_RSK * 2 + 64 * DT_RSV * 2;
__device__ __forceinline__ void frame_refresh(Frame& F);
__device__ __forceinline__ void diff_attn_t(Frame& F, unsigned char* ldsg, int j, const float lam_init) {
    const bf16* QKV = (const bf16*)(F.ws + WS_QKV); bf16* MIXO = (bf16*)(F.ws + WS_MIXO);
    LAS unsigned char* lds = F.lds;
    LAS unsigned* sO0 = (LAS unsigned*)(lds + 2 * DT_BUF) + F.wave * 2048;
    LAS float* sG = (LAS float*)(lds + 2 * DT_BUF + 65536);
    const int wave = F.wave;
    float lam;
    { const int tid = F.tid, lane = F.lane;
    if (tid < 128) sG[tid] = F.inp(23)[j * 128 + tid] * (1.f - lam_init);
    { const float a = wave_sum_l(F.inp(19)[j * 64 + lane] * F.inp(20)[j * 64 + lane], lane), c = wave_sum_l(F.inp(21)[j * 64 + lane] * F.inp(22)[j * 64 + lane], lane); lam = __expf(a) - __expf(c) + lam_init; } }
    __syncthreads();
    const int vcu = (F.G % 8 == 0) ? (F.bx % 8) * (F.G / 8) + F.bx / 8 : F.bx;
    for (int v = vcu; v < BATCH * 8 * 2; v += F.G) {
        const int bh = v >> 1, p = v & 1, b = bh >> 3, h = bh & 7;
#pragma unroll 1
        for (int qi = 0; qi < 4; ++qi) {
            const int qb = (qi == 0) ? p : (qi == 1) ? 7 - p : (qi == 2) ? 2 + p : 5 - p;
            const int lane = hw_lane(), tid = wave * 64 + lane, r32 = lane & 31, hi = lane >> 5;
            const int krow = tid >> 3, kch = tid & 7, vrow = tid >> 4, vch = tid & 15;
            const int vtr = (4 * hi + ((lane & 15) >> 2)) * (DT_RSV * 2) + ((lane >> 4) & 1) * 32 + (lane & 3) * 8;
            const int nt = 4 * (qb + 1), qpos = 256 * qb + 32 * wave + r32, wmin = 256 * qb + 32 * wave;
            const size_t tokq = (size_t)b * SEQ + qpos;
#pragma unroll 1
            for (int m = 0; m < 2; ++m) {
                bf16x8_t qf[4];
#pragma unroll
                for (int ks = 0; ks < 4; ++ks) qf[ks] = *(const bf16x8_t*)(QKV + tokq * 3072 + h * 128 + m * 64 + 16 * ks + 8 * hi);
                f32x16_d O[4];
#pragma unroll
                for (int db = 0; db < 4; ++db) O[db] = f32x16_d{};
                float mrun = 0.f, lsum = 0.f; f32x16_d negm = f32x16_d{};
                const bf16* kg = QKV + ((size_t)b * SEQ + krow) * 3072 + 1024 + h * 128 + m * 64 + kch * 8;
                const bf16* vg = QKV + ((size_t)b * SEQ + vrow) * 3072 + 2048 + h * 128 + vch * 8;
                v4u sk[2], sv0[2], sv1[2];
                sk[0] = *(const v4u*)kg; sv0[0] = *(const v4u*)vg; sv1[0] = *(const v4u*)(vg + (size_t)32 * 3072);
                { const size_t ko = (size_t)64 * 3072; sk[1] = *(const v4u*)(kg + ko); sv0[1] = *(const v4u*)(vg + ko); sv1[1] = *(const v4u*)(vg + ko + (size_t)32 * 3072); }
                *(LAS v4u*)(lds + krow * (DT_RSK * 2) + kch * 16) = sk[0];
                *(LAS v4u*)(lds + 64 * DT_RSK * 2 + vrow * (DT_RSV * 2) + vch * 16) = sv0[0]; *(LAS v4u*)(lds + 64 * DT_RSK * 2 + (vrow + 32) * (DT_RSV * 2) + vch * 16) = sv1[0];
                __syncthreads();
#pragma unroll 1
                for (int t2 = 0; t2 < nt; t2 += 2) {
#pragma unroll
                  for (int tp = 0; tp < 2; ++tp) {
                    const int t = t2 + tp;
                    const int buf = tp * DT_BUF;
                    if (t + 2 < nt) { const size_t ko = (size_t)(t + 2) * 64 * 3072; sk[tp] = *(const v4u*)(kg + ko); sv0[tp] = *(const v4u*)(vg + ko); sv1[tp] = *(const v4u*)(vg + ko + (size_t)32 * 3072); }
                    if (64 * t <= wmin + 31) {
                        LAS unsigned char* kb_ = lds + buf; LAS unsigned char* vb_ = lds + buf + 64 * DT_RSK * 2;
                        f32x16_d S[2];
#pragma unroll
                        for (int kb = 0; kb < 2; ++kb) {
#pragma unroll
                            for (int ks = 0; ks < 4; ++ks) { const bf16x8_t kf = *(const LAS bf16x8_t*)(kb_ + (32 * kb + r32) * (DT_RSK * 2) + (16 * ks + 8 * hi) * 2);
                                S[kb] = __builtin_amdgcn_mfma_f32_32x32x16_bf16(kf, qf[ks], ks == 0 ? negm : S[kb], 0, 0, 0); } }
                        if (64 * t + 63 > wmin) {
#pragma unroll
                            for (int kb = 0; kb < 2; ++kb)
#pragma unroll
                                for (int r = 0; r < 16; ++r) { const int key = 64 * t + 32 * kb + (r & 3) + 8 * (r >> 2) + 4 * hi; if (key > qpos) S[kb][r] = -INFINITY; }
                        }
                        float mx = S[0][0];
#pragma unroll
                        for (int r = 1; r < 16; ++r) mx = fmaxf(mx, S[0][r]);
#pragma unroll
                        for (int r = 0; r < 16; ++r) mx = fmaxf(mx, S[1][r]);
                        { auto rr = __builtin_amdgcn_permlane32_swap(__float_as_uint(mx), __float_as_uint(mx), false, false); mx = fmaxf(__uint_as_float(rr[0]), __uint_as_float(rr[1])); }
                        if (__builtin_expect(__any(mx > 8.f), 0)) {
                            const float dl = fmaxf(mx, 0.f), alpha = __builtin_amdgcn_exp2f(-dl); mrun += dl; lsum *= alpha;
#pragma unroll
                            for (int kb = 0; kb < 2; ++kb)
#pragma unroll
                                for (int r = 0; r < 16; ++r) S[kb][r] -= dl;
#pragma unroll
                            for (int r = 0; r < 16; ++r) negm[r] = -mrun;
#pragma unroll
                            for (int db = 0; db < 4; ++db)
#pragma unroll
                                for (int r = 0; r < 16; ++r) O[db][r] *= alpha;
                        }
                        float ps = 0.f;
#pragma unroll
                        for (int kb = 0; kb < 2; ++kb)
#pragma unroll
                            for (int r = 0; r < 16; ++r) { const float pv = __builtin_amdgcn_exp2f(S[kb][r]); S[kb][r] = pv; ps += pv; }
                        lsum += ps;
#pragma unroll
                        for (int kb = 0; kb < 2; ++kb)
#pragma unroll
                            for (int s2 = 0; s2 < 2; ++s2) {
                                u32x4_t pw; pw.x = pk2(S[kb][8 * s2], S[kb][8 * s2 + 1]); pw.y = pk2(S[kb][8 * s2 + 2], S[kb][8 * s2 + 3]); pw.z = pk2(S[kb][8 * s2 + 4], S[kb][8 * s2 + 5]); pw.w = pk2(S[kb][8 * s2 + 6], S[kb][8 * s2 + 7]);
                                const bf16x8_t pf = __builtin_bit_cast(bf16x8_t, pw);
#pragma unroll
                                for (int db = 0; db < 4; ++db) {
                                    LAS unsigned char* va = vb_ + vtr + (32 * kb + 16 * s2) * (DT_RSV * 2) + db * 64;
                                    const v4i16_d lo = __builtin_amdgcn_ds_read_tr16_b64_v4i16((LAS v4i16_d*)va), hi4 = __builtin_amdgcn_ds_read_tr16_b64_v4i16((LAS v4i16_d*)(va + 8 * (DT_RSV * 2)));
                                    const bf16x8_t vf = (bf16x8_t){lo[0], lo[1], lo[2], lo[3], hi4[0], hi4[1], hi4[2], hi4[3]};
                                    O[db] = __builtin_amdgcn_mfma_f32_32x32x16_bf16(vf, pf, O[db], 0, 0, 0);
                                }
                            }
                    }
                    if (t + 1 < nt) { const int nb = (tp ^ 1) * DT_BUF;
                        *(LAS v4u*)(lds + nb + krow * (DT_RSK * 2) + kch * 16) = sk[tp ^ 1];
                        *(LAS v4u*)(lds + nb + 64 * DT_RSK * 2 + vrow * (DT_RSV * 2) + vch * 16) = sv0[tp ^ 1]; *(LAS v4u*)(lds + nb + 64 * DT_RSK * 2 + (vrow + 32) * (DT_RSV * 2) + vch * 16) = sv1[tp ^ 1]; }
                    __syncthreads();
                  }
                }
                lsum += __int_as_float(__builtin_amdgcn_ds_bpermute((lane ^ 32) << 2, __float_as_int(lsum)));
                const float linv = 1.f / lsum;
                if (m == 0) {
#pragma unroll
                    for (int db = 0; db < 4; ++db)
#pragma unroll
                        for (int r = 0; r < 16; r += 2) sO0[(db * 8 + (r >> 1)) * 64 + lane] = pk2(O[db][r] * linv, O[db][r + 1] * linv);
                } else {
                    float ss = 0.f;
#pragma unroll
                    for (int db = 0; db < 4; ++db)
#pragma unroll
                        for (int r = 0; r < 16; r += 2) { const unsigned w0 = sO0[(db * 8 + (r >> 1)) * 64 + lane];
                            const float o0 = bflo(w0) - lam * (O[db][r] * linv), o1 = bfhi(w0) - lam * (O[db][r + 1] * linv); O[db][r] = o0; O[db][r + 1] = o1; ss += o0 * o0 + o1 * o1; }
                    ss += __int_as_float(__builtin_amdgcn_ds_bpermute((lane ^ 32) << 2, __float_as_int(ss)));
                    const float rs = 1.f / sqrtf(ss * (1.f / 128.f) + RMS_EPS);
                    bf16* orow = MIXO + tokq * D + h * 128 + 4 * hi;
#pragma unroll
                    for (int db = 0; db < 4; ++db)
#pragma unroll
                        for (int rg = 0; rg < 4; ++rg) { const int d0 = 32 * db + 8 * rg + 4 * hi; const f32x4 g4 = *(const LAS f32x4*)(sG + d0);
                            u32x2_t w; w.x = pk2(O[db][4 * rg] * rs * g4.x, O[db][4 * rg + 1] * rs * g4.y); w.y = pk2(O[db][4 * rg + 2] * rs * g4.z, O[db][4 * rg + 3] * rs * g4.w);
                            *(u32x2_t*)(orow + 32 * db + 8 * rg) = w; }
                }
            }
        }
    }
    __syncthreads();
}

__device__ __forceinline__ void moe_tail_down(Frame& F, int lslot) {
    pg8::MoeOrder S; S.init((const unsigned*)(F.ctl + CW_CNT + 16 * lslot), 4, F.G, F.bx); S.cut_tail();
    const int ntail = S.so.nwg - S.so.lim;
    if (ntail <= 0) return;
    const bf16* A = (const bf16*)(F.ws + WS_HIDP); const bf16* Bt = (const bf16*)(F.ws + WS_WB + WB_MDN); bf16* O = (bf16*)(F.ws + WS_XPERM);
    int lane = F.lane; asm volatile("" : "+v"(lane)); const int fr = lane & 15, fq = lane >> 4;
    LAS unsigned char* red = F.lds;
    for (int rr = 0; rr * 16 < ntail; ++rr) {
        const int j = F.bx >> 3, t = (F.bx & 7) + 8 * ((j >> 4) + 2 * rr), p = j & 15;
        if (t >= ntail) continue;
        pg8::Unit u; S.at((long)S.so.lim + t, u);
        const int sr = (p >> 2) & 3, sc = p & 3;
        const bf16* ap = A + (size_t)(u.pm * 256 + 64 * sr + fr) * FF + 352 * F.wave + 8 * fq;
        const bf16* bp = Bt + (size_t)(u.pb * 256 + 64 * sc + fr) * FF + 352 * F.wave + 8 * fq;
        f32x4_t acc[4][4];
#pragma unroll
        for (int m = 0; m < 4; ++m)
#pragma unroll
            for (int n = 0; n < 4; ++n) acc[m][n] = (f32x4_t){0.f, 0.f, 0.f, 0.f};
        bf16x8_t fa[3][4], fb[3][4];
#define TL_LOAD(st, s) do { _Pragma("unroll") for (int g = 0; g < 4; ++g) { fa[st][g] = *(const bf16x8_t*)(ap + (size_t)(16 * g) * FF + 32 * (s)); fb[st][g] = *(const bf16x8_t*)(bp + (size_t)(16 * g) * FF + 32 * (s)); } } while (0)
        TL_LOAD(0, 0); TL_LOAD(1, 1);
#pragma unroll
        for (int s = 0; s < 11; ++s) {
            if (s + 2 < 11) TL_LOAD((s + 2) % 3, s + 2);
            __builtin_amdgcn_sched_barrier(0);
#pragma unroll
            for (int m = 0; m < 4; ++m)
#pragma unroll
                for (int n = 0; n < 4; ++n) acc[m][n] = __builtin_amdgcn_mfma_f32_16x16x32_bf16(fb[s % 3][n], fa[s % 3][m], acc[m][n], 0, 0, 0);
            __builtin_amdgcn_sched_barrier(0);
        }
#undef TL_LOAD
#pragma unroll
        for (int m = 0; m < 4; ++m)
#pragma unroll
            for (int n = 0; n < 4; ++n) *(LAS f32x4_t*)(red + ((size_t)((F.wave * 16 + m * 4 + n) * 64 + lane)) * 16) = acc[m][n];
        __syncthreads();
#pragma unroll
        for (int q2 = 0; q2 < 2; ++q2) {
            const int q = 2 * F.wave + q2, m = q >> 2, n = q & 3;
            f32x4_t t = *(const LAS f32x4_t*)(red + ((size_t)(q * 64 + lane)) * 16);
#pragma unroll
            for (int v = 1; v < 8; ++v) t += *(const LAS f32x4_t*)(red + ((size_t)((v * 16 + q) * 64 + lane)) * 16);
            bf16* op = O + (size_t)(u.pm * 256 + 64 * sr + 16 * m + fr) * D + u.pn * 256 + 64 * sc + 16 * n + 4 * fq;
            *(GAS unsigned long long*)op = (unsigned long long)pk2(t[0], t[1]) | ((unsigned long long)pk2(t[2], t[3]) << 32);
        }
        __syncthreads();
    }
}

struct Args { const float* in[34]; float* out; unsigned char* ws; int lo, hi; };
constexpr int PH_PER_PAIR = 17, NPHASE = 1 + 2 * PH_PER_PAIR;
#ifndef PHMASK
#define PHMASK 0x3FFFFu
#endif
#define PHON(k) (((PHMASK) >> (k)) & 1u)

__device__ __forceinline__ void frame_refresh(Frame& F) {
    int wv = F.wave0; asm volatile("" : "+s"(wv));
    int ln; asm volatile("v_mbcnt_lo_u32_b32 %0, -1, 0\n\tv_mbcnt_hi_u32_b32 %0, -1, %0" : "=v"(ln));
    ln &= 63; wv &= 7; const int t = wv * 64 + ln;
    int bx = blockIdx.x; asm volatile("" : "+s"(bx));
    const __attribute__((address_space(4))) unsigned char* kp = (const __attribute__((address_space(4))) unsigned char*)__builtin_amdgcn_kernarg_segment_ptr(); asm volatile("" : "+s"(kp));
    typedef unsigned char* ucp; unsigned char* w = *(const __attribute__((address_space(4))) ucp*)(kp + 280);
    F.kp = kp; F.tid = t; F.lane = t & 63; F.wave = wv;
    F.bx = bx; F.gw = bx * NWAVES + F.wave; F.ws = w; F.ctl = (gu32*)(w + WS_CTL);
}

#define IN(k) (lo <= (k) && (k) < hi)
#define SEAM(k) do { if (IN((k) + 1)) xcd_barrier(bar, F.tid); } while (0)
#define WSB(off) ((bf16*)(F.ws + (off)))
template <int lp> __device__ __forceinline__ void layer_pair(Frame& F, const int lo, const int hi, const XcdBarrier& bar, unsigned char* lds) {
        const int pb = 1 + PH_PER_PAIR * lp;
        if (PHON(1) && IN(pb + 0)) {
            frame_refresh(F);
            pg8::Gemm g{WSB(WS_XB), WSB(WS_WB + WB_WIN), M, EINP, D}; pg8::StaticOrder S; S.init(M, EINP, F.G, F.bx);
            pg8::EpiBf16<0> E{WSB(WS_P), EINP, nullptr, 0, 0, 1.f};
            pg8::gemm_phase<pg8::EpiBf16<0>, pg8::StaticOrder, true, true>(F.lds, g, S, E, F.tid);
            SEAM(pb + 0);
        }
        if (PHON(2) && IN(pb + 1)) { frame_refresh(F); dsa_prep(F, lp); gla_prep(F, lp); SEAM(pb + 1); }
        if (PHON(3) && IN(pb + 2)) { frame_refresh(F); dsa_index(F); frame_refresh(F); gla_scan(F); SEAM(pb + 2); }
        if (PHON(4) && IN(pb + 3)) { frame_refresh(F);
            dsa_body::dsa_attn_phase<8>((char*)lds, (const dsa_body::bf16*)(F.ws + WS_P) + PC_AQ, (const dsa_body::bf16*)(F.ws + WS_KD), (const dsa_body::bf16*)(F.ws + WS_VD), (dsa_body::bf16*)(F.ws + WS_MIX), (const unsigned*)(F.ws + WS_MASK), F.bx, F.G, F.tid);
            __syncthreads(); gla_out(F, lp); SEAM(pb + 3); }
        if (PHON(5) && IN(pb + 4)) {
            frame_refresh(F);
            pg8::Gemm g{WSB(WS_MIX), WSB(WS_WB + WB_WOUT), M, D, D}; pg8::PanelOrder S; S.init(M, F.bx);
            pg8::EpiLnFused E{WSB(WS_XB), F.inp(11) + lp * D, F.inp(12) + lp * D, (unsigned long long*)(F.ws + WS_XSTAT), (unsigned*)(F.ctl + CW_PANEL + 8192 * (2 * lp)), (unsigned*)(F.ctl + CW_TMO), F.lds + XTRA_OFF};
            pg8::gemm_phase<pg8::EpiLnFused, pg8::PanelOrder, true, true>(F.lds, g, S, E, F.tid);
            SEAM(pb + 4);
        }
        if (PHON(7) && IN(pb + 6)) {
            frame_refresh(F);
            pg8::Gemm g{WSB(WS_XB), WSB(WS_WB + WB_WGU), M, 2 * FF, D}; pg8::StaticOrder S; S.init(M, 2 * FF, F.G, F.bx);
            pg8::EpiSwiGLU E{WSB(WS_HID), FF};
            pg8::gemm_phase<pg8::EpiSwiGLU, pg8::StaticOrder, true, true>(F.lds, g, S, E, F.tid);
            SEAM(pb + 6);
        }
        if (PHON(8) && IN(pb + 7)) {
            frame_refresh(F);
            pg8::Gemm g{WSB(WS_HID), WSB(WS_WB + WB_WDN), M, D, FF}; pg8::PanelOrder S; S.init(M, F.bx);
            pg8::EpiLnFused E{WSB(WS_XB), F.inp(16) + lp * D, F.inp(17) + lp * D, (unsigned long long*)(F.ws + WS_XSTAT), (unsigned*)(F.ctl + CW_PANEL + 8192 * (2 * lp + 1)), (unsigned*)(F.ctl + CW_TMO), F.lds + XTRA_OFF};
            pg8::gemm_phase<pg8::EpiLnFused, pg8::PanelOrder, true, true>(F.lds, g, S, E, F.tid);
            SEAM(pb + 7);
        }
        if (PHON(9) && IN(pb + 8)) { frame_refresh(F); cvt_odd(F, lp); SEAM(pb + 8); }
        if (PHON(10) && IN(pb + 9)) {
            frame_refresh(F);
            pg8::Gemm g{WSB(WS_XB), WSB(WS_WB + WB_WQKV), M, 3072, D}; pg8::StaticOrder S; S.init(M, 3072, F.G, F.bx);
            pg8::EpiBf16<0> E{WSB(WS_QKV), 3072, nullptr, 1024, 1024, C2};
            pg8::gemm_phase<pg8::EpiBf16<0>, pg8::StaticOrder, true, true>(F.lds, g, S, E, F.tid);
            SEAM(pb + 9);
        }
        if (PHON(11) && IN(pb + 10)) {
            frame_refresh(F);
            constexpr float lam_init = (lp == 0) ? 0.355509068f : 0.556058204f;
            diff_attn_t(F, lds, lp, lam_init);
            SEAM(pb + 10);
        }
        if (PHON(12) && IN(pb + 11)) {
            frame_refresh(F);
            pg8::Gemm g{WSB(WS_MIXO), WSB(WS_WB + WB_WOUT), M, D, D}; pg8::StaticOrder S; S.init(M, D, F.G, F.bx);
            pg8::EpiBf16<0> E{WSB(WS_H_ODD), D, nullptr, 0, 0, 1.f};
            pg8::gemm_phase<pg8::EpiBf16<0>, pg8::StaticOrder, true, true>(F.lds, g, S, E, F.tid);
            SEAM(pb + 11);
        }
        if (PHON(13) && IN(pb + 12)) { frame_refresh(F);
            ln_phase<0, true, true, false>(F, (const float*)F.outp(), WSB(WS_H_ODD), F.inp(25) + lp * D, F.inp(26) + lp * D, F.outp(), WSB(WS_XB), F.inp(27) + (size_t)lp * D * NEXP, F.inp(28) + lp * NEXP, lp); SEAM(pb + 12); }
        if (PHON(14) && IN(pb + 13)) { frame_refresh(F); moe_map(F, lp); SEAM(pb + 13); }
        if (PHON(15) && IN(pb + 14)) {
            frame_refresh(F);
            pg8::MoeOrder S; S.init((const unsigned*)(F.ctl + CW_CNT + 16 * lp), 22, F.G, F.bx);
            pg8::Gemm g{WSB(WS_XB), WSB(WS_WB + WB_MGU), S.so.nM * 256, 2 * FF, D, (const int*)(F.ws + WS_INV)};
            pg8::EpiSwiGLU E{WSB(WS_HIDP), FF};
            pg8::gemm_phase<pg8::EpiSwiGLU, pg8::MoeOrder, true, true, true>(F.lds, g, S, E, F.tid);
            SEAM(pb + 14);
        }
        if (PHON(16) && IN(pb + 15)) {
            frame_refresh(F);
            pg8::MoeOrder S; S.init((const unsigned*)(F.ctl + CW_CNT + 16 * lp), 4, F.G, F.bx); S.cut_tail();
            pg8::Gemm g{WSB(WS_HIDP), WSB(WS_WB + WB_MDN), S.so.nM * 256, D, FF};
            pg8::EpiBf16<0> E{WSB(WS_XPERM), D, nullptr, 0, 0, 1.f};
            pg8::gemm_phase<pg8::EpiBf16<0>, pg8::MoeOrder, true, true>(F.lds, g, S, E, F.tid);
            frame_refresh(F); moe_tail_down(F, lp);
            SEAM(pb + 15);
        }
        if (PHON(17) && IN(pb + 16)) {
            frame_refresh(F);
            ln_phase<1, false, true, lp == 1>(F, (const float*)F.outp(), WSB(WS_XPERM), F.inp(32) + lp * D, F.inp(33) + lp * D, F.outp(), WSB(WS_XB), nullptr, nullptr, 0);
            if (lp == 0) { __syncthreads(); cvt_even(F, 1); SEAM(pb + 16); }
        }
    }

__global__ void __launch_bounds__(NTHR, 2) mega_fwd(Args args) {
    extern __shared__ __attribute__((aligned(16))) unsigned char lds[];
    Frame F;
    F.lds = (LAS unsigned char*)lds; F.MISC = (volatile LAS unsigned*)(F.lds + MISC_OFF);
    F.G = gridDim.x; F.NGW = F.G * NWAVES; F.wave0 = __builtin_amdgcn_readfirstlane((int)threadIdx.x >> 6);
    frame_refresh(F);
    for (int u = F.tid; u < (LDS_BYTES - LDSCTL_OFF) / 4; u += NTHR) ((LAS unsigned*)(F.lds + LDSCTL_OFF))[u] = 0u;
    __syncthreads();
    const int lo = args.lo, hi = args.hi;
    const bool use_bar = (hi - lo) > 1;
    XcdBarrier bar; bar.bar = (unsigned*)(F.ctl + CW_BAR); bar.x = 0; bar.st = nullptr;
    if (use_bar) bar = xcd_barrier_post((unsigned*)(F.ctl + CW_BAR), F.MISC + 8, F.tid);

    if (PHON(0) && IN(0)) { frame_refresh(F); cvt_even(F, 0); xb_from_x(F); SEAM(0); }

    layer_pair<0>(F, lo, hi, bar, lds);
    layer_pair<1>(F, lo, hi, bar, lds);
#undef IN
#undef SEAM
}

#ifndef MK_SINGLE
#define MK_SINGLE 1
#endif
extern "C" void kernel_launch(void* const* d_in, const int* in_sizes, int n_in, void* d_out, int out_size, void* d_ws, size_t ws_size, hipStream_t stream) {
    static int grid = 0;
    if (grid == 0) {
        if (n_in != 34 || in_sizes[0] != M * D || out_size != M * D || ws_size < WS_END) { fprintf(stderr, "kernel_launch: unexpected shapes or workspace (n_in %d, ws %zu)\n", n_in, ws_size); grid = -1; return; }
        int dev = 0, cus = 0, per_cu = 0;
        if (hipGetDevice(&dev) != hipSuccess || hipDeviceGetAttribute(&cus, hipDeviceAttributeMultiprocessorCount, dev) != hipSuccess) { grid = -1; return; }
        if (hipFuncSetAttribute((const void*)mega_fwd, hipFuncAttributeMaxDynamicSharedMemorySize, LDS_BYTES) != hipSuccess) { grid = -1; return; }
        if (hipOccupancyMaxActiveBlocksPerMultiprocessor(&per_cu, (const void*)mega_fwd, NTHR, LDS_BYTES) != hipSuccess || per_cu < 1) fprintf(stderr, "kernel_launch: occupancy query says %d\n", per_cu);
        (void)hipGetLastError();
        if (cus != 256) { fprintf(stderr, "kernel_launch: this kernel is laid out for 256 CUs (got %d)\n", cus); grid = -1; return; }
        grid = cus;
    }
    if (grid < 0) return;
    (void)hipMemsetAsync((char*)d_ws + WS_CTL, 0, CTL_ZERO_BYTES, stream);
    Args a{};
    for (int i = 0; i < 34; ++i) a.in[i] = (const float*)d_in[i];
    a.out = (float*)d_out; a.ws = (unsigned char*)d_ws;
    a.lo = 0; a.hi = NPHASE;
    hipLaunchKernelGGL(mega_fwd, dim3(grid), dim3(NTHR), LDS_BYTES, stream, a);
}
```

```cpp
#include <hip/hip_runtime.h>
#include <cstdio>
#include <cstdint>
#include <cmath>
namespace pg8 {
#define PG8_LAS __attribute__((address_space(3)))
typedef unsigned short bf16_t;
typedef short bf16x8 __attribute__((ext_vector_type(8)));
typedef float f32x4 __attribute__((ext_vector_type(4)));
typedef unsigned u32x4 __attribute__((ext_vector_type(4)));
constexpr int BM = 256, BK = 64, HALF = 128, HTB = HALF * BK * 2  , STAGE_BYTES = 8 * HTB, NXCD = 8, WGM = 5;

__host__ __device__ __forceinline__ int lds_byte(int r, int c) { const int st = (r >> 4) * 2 + (c >> 5), rr = r & 15, cc = c & 31, ob = rr * 64 + cc * 2; return st * 1024 + (ob ^ (((ob >> 9) & 1) << 5)); }
__host__ __device__ __forceinline__ void stage_rc(int b, int& R, int& C) { const int st = b / 1024, sb = b % 1024, swz = sb ^ (((sb >> 9) & 1) << 5); R = (st >> 1) * 16 + swz / 64; C = (st & 1) * 32 + (swz % 64) / 2; }
__host__ __device__ __forceinline__ int perm32(int rho) { const int n = rho >> 4, i = rho & 15; return 8 * (i >> 2) + 4 * n + (i & 3); }

struct Unit { int pm, pn, pb; };
struct Gemm { const bf16_t* A; const bf16_t* Bt; int M, N, K; const int* inv = nullptr; };

struct StaticOrder {
    int nM, nN, nwg, G, c, lim;
    __host__ __device__ void init(int M, int N, int G_, int c_) { nM = M / BM; nN = N / BM; nwg = nM * nN; G = G_; c = c_; lim = nwg; }
    __host__ __device__ bool next(int i, Unit& u) const { const long L = (long)i * G + c; if (L >= lim) return false; return at(L, u); }
    __host__ __device__ bool at(long L, Unit& u) const {
        if (L >= nwg) return false;
        int wgid = (int)L; { const int q = nwg / NXCD, r = nwg % NXCD, xcd = wgid % NXCD, off = wgid / NXCD; wgid = (xcd < r ? xcd * (q + 1) : r * (q + 1) + (xcd - r) * q) + off; }
        const int nig = WGM * nN, gid = wgid / nig, fm = gid * WGM, gsz = (nM - fm) < WGM ? (nM - fm) : WGM;
        u.pm = fm + ((wgid % nig) % gsz); u.pn = (wgid % nig) / gsz; u.pb = u.pn; return true;
    }
    __device__ __forceinline__ void a_ready(const Unit&) const {}
    __device__ __forceinline__ void done(const Unit&) const {}
};

__device__ __forceinline__ unsigned cvt_pk_bf16(float lo, float hi) { unsigned r; asm volatile("v_cvt_pk_bf16_f32 %0, %1, %2" : "=v"(r) : "v"(lo), "v"(hi)); return r; }
typedef float f32x2 __attribute__((ext_vector_type(2)));
__device__ __forceinline__ f32x2 gelu_pk(f32x2 v) {
    const f32x2 av = __builtin_elementwise_abs(v), d = av * 0.2316418882f + 1.0f;
    f32x2 t; t.x = __builtin_amdgcn_rcpf(d.x); t.y = __builtin_amdgcn_rcpf(d.y);
    f32x2 q = t * 0.5307027145f + (-0.7265760135f); q = q * t + 0.7107068705f; q = q * t + (-0.142248368f); q = q * t + 0.127414796f; q = q * t;
    const f32x2 s = (v * v) * (-0.72134752044f);
    f32x2 e; e.x = __builtin_amdgcn_exp2f(s.x); e.y = __builtin_amdgcn_exp2f(s.y);
    const f32x2 m = v * (q * e), r = v - m;
    f32x2 o; o.x = v.x < 0.f ? m.x : r.x; o.y = v.y < 0.f ? m.y : r.y; return o;
}

template <int ACT  > struct EpiBf16 {
    static constexpr bool PERM = true, AFTER_DRAIN = false; static_assert(ACT == 0 || ACT == 1, "EpiBf16: ACT is 0 (none) or 1 (gelu_pk)");
    bf16_t* O; int ldc; const float* bias; int split_cols; size_t split_stride; float scale0;
    __device__ __forceinline__ void operator()(const f32x4 (&acc)[2][2][4][2], const Unit& u, int wr, int wc, int fr, int fq) const {
        const int row0 = u.pm * BM + wr * 64 + fr; int colt = u.pn * BM; bf16_t* base = O;
        float sc = 1.f; if (split_cols) { const int t = colt / split_cols; base += (size_t)t * split_stride; colt -= t * split_cols; if (t == 0) sc = scale0; }
        const int col0 = colt + wc * 32 + 8 * fq, bcol0 = u.pn * BM + wc * 32 + 8 * fq;
        f32x4 bv[2][2];
#pragma unroll
        for (int bj = 0; bj < 2; ++bj)
#pragma unroll
            for (int n = 0; n < 2; ++n) bv[bj][n] = bias ? *(const f32x4*)(bias + bcol0 + bj * HALF + 4 * n) : (f32x4){0.f, 0.f, 0.f, 0.f};
#pragma unroll
        for (int ai = 0; ai < 2; ++ai)
#pragma unroll
            for (int m = 0; m < 4; ++m) { bf16_t* rowp = base + (size_t)(row0 + ai * HALF + m * 16) * ldc + col0;
#pragma unroll
                for (int bj = 0; bj < 2; ++bj) { f32x4 v0 = acc[ai][bj][m][0] + bv[bj][0], v1 = acc[ai][bj][m][1] + bv[bj][1];
                    if (ACT == 1) { f32x2 a = gelu_pk((f32x2){v0[0], v0[1]}), b = gelu_pk((f32x2){v0[2], v0[3]}), c = gelu_pk((f32x2){v1[0], v1[1]}), d = gelu_pk((f32x2){v1[2], v1[3]});
                        v0 = (f32x4){a.x, a.y, b.x, b.y}; v1 = (f32x4){c.x, c.y, d.x, d.y}; }
                    v0 = v0 * sc; v1 = v1 * sc; u32x4 w; w.x = cvt_pk_bf16(v0[0], v0[1]); w.y = cvt_pk_bf16(v0[2], v0[3]); w.z = cvt_pk_bf16(v1[0], v1[1]); w.w = cvt_pk_bf16(v1[2], v1[3]);
                    *(u32x4*)(rowp + bj * HALF) = w; } }
    }
};
template <class Epi, class Sched, bool ALIGN_EPI = false, bool SP2 = false, bool GATHER = false>
__device__ __forceinline__ void gemm_phase(PG8_LAS unsigned char* lds, const Gemm g, const Sched& S, const Epi& E, const int tid) {
    const int wid = __builtin_amdgcn_readfirstlane(tid >> 6), lane = tid & 63, wr = wid >> 2, wc = wid & 3, fr = lane & 15, fq = lane >> 4;
    const int K = g.K, nt = K / BK;
    unsigned voffA[2], voffB[2];
#pragma unroll
    for (int i = 0; i < 2; ++i) { int R, C; stage_rc(tid * 16 + i * 8192, R, C); const int Rb = Epi::PERM ? ((R & ~31) + perm32(R & 31)) : R;
        voffA[i] = (unsigned)(R * K + C) * 2u; voffB[i] = (unsigned)(Rb * K + C) * 2u; }
    unsigned vA[2][2], vN[2][2]; int rawN[2][2]; int gR[2], gC[2];
#pragma unroll
    for (int i = 0; i < 2; ++i) { stage_rc(tid * 16 + i * 8192, gR[i], gC[i]); vA[0][i] = vA[1][i] = vN[0][i] = vN[1][i] = voffA[i]; rawN[0][i] = rawN[1][i] = 0; }
    const size_t kstep = (size_t)(BK * 2);
    const size_t hstep = (size_t)HALF * K * 2;
    const size_t hsA = GATHER ? (size_t)0 : hstep;
    const size_t tstep = 2 * hstep;
    const unsigned ldsw = (unsigned)wid * 1024u;
    const int aoff = lds_byte(wr * 64 + fr, fq * 8), boff = lds_byte(wc * 32 + fr, fq * 8);
#define PG8_SA(b, h) (((b) * 2 + (h)) * HTB)
#define PG8_SB(b, h) ((4 + (b) * 2 + (h)) * HTB)
#define PG8_STAGE(bufoff, gbase, voff) do { _Pragma("unroll") for (int _i = 0; _i < 2; ++_i) \
        __builtin_amdgcn_global_load_lds((const unsigned*)((const char*)(gbase) + (voff)[_i]), (PG8_LAS unsigned*)(lds + (bufoff) + ldsw + _i * 8192), 16, 0, 0); } while (0)
#define PG8_LDA(dst, b, h) do { _Pragma("unroll") for (int m = 0; m < 4; ++m) _Pragma("unroll") for (int k = 0; k < 2; ++k) dst[m][k] = *(const PG8_LAS bf16x8*)(lds + PG8_SA(b, h) + aoff + m * 2048 + k * 1024); } while (0)
#define PG8_LDB(dst, b, h) do { _Pragma("unroll") for (int n = 0; n < 2; ++n) _Pragma("unroll") for (int k = 0; k < 2; ++k) dst[n][k] = *(const PG8_LAS bf16x8*)(lds + PG8_SB(b, h) + boff + n * 2048 + k * 1024); } while (0)
#define PG8_MMA(ai, bj, At, Bt) do { __builtin_amdgcn_s_setprio(1); _Pragma("unroll") for (int m = 0; m < 4; ++m) _Pragma("unroll") for (int n = 0; n < 2; ++n) _Pragma("unroll") for (int k = 0; k < 2; ++k) \
        acc[ai][bj][m][n] = __builtin_amdgcn_mfma_f32_16x16x32_bf16(Bt[n][k], At[m][k], acc[ai][bj][m][n], 0, 0, 0); __builtin_amdgcn_s_setprio(0); } while (0)
#define PG8_WAIT_V(n) asm volatile("s_waitcnt vmcnt(" #n ")" ::: "memory")
#define PG8_WAIT_L(n) asm volatile("s_waitcnt lgkmcnt(" #n ")" ::: "memory")
#define PG8_BAR __builtin_amdgcn_s_barrier()
#define PG8_SCHED __builtin_amdgcn_sched_barrier(0)
    Unit cur, nxt; int ui = 0;
    if (!S.next(0, cur)) return;
    f32x4 acc[2][2][4][2];
#pragma unroll
    for (int a = 0; a < 2; ++a)
#pragma unroll
        for (int b = 0; b < 2; ++b)
#pragma unroll
            for (int m = 0; m < 4; ++m)
#pragma unroll
                for (int n = 0; n < 2; ++n) acc[a][b][m][n] = (f32x4){0.f, 0.f, 0.f, 0.f};
    bf16x8 At[4][2], B0[2][2], B1[2][2];
    const char* cA = GATHER ? (const char*)g.A : (const char*)g.A + (size_t)cur.pm * tstep; const char* cB = (const char*)g.Bt + (size_t)cur.pb * tstep;
    if constexpr (GATHER) {
#pragma unroll
        for (int h = 0; h < 2; ++h)
#pragma unroll
            for (int i = 0; i < 2; ++i) vA[h][i] = vN[h][i] = (unsigned)g.inv[cur.pm * BM + HALF * h + gR[i]] * (unsigned)(K * 2) + (unsigned)(gC[i] * 2);
    }
    S.a_ready(cur);
    if constexpr (SP2) {
        PG8_STAGE(PG8_SB(0, 0), cB, voffB); PG8_STAGE(PG8_SB(0, 1), cB + hstep, voffB); PG8_STAGE(PG8_SA(0, 0), cA, vA[0]); PG8_STAGE(PG8_SA(0, 1), cA + hsA, vA[1]);
        if (wr == 1) PG8_BAR;
        PG8_WAIT_V(2); PG8_BAR;
        PG8_STAGE(PG8_SB(1, 0), cB + kstep, voffB); PG8_STAGE(PG8_SA(1, 0), cA + kstep, vA[0]); PG8_STAGE(PG8_SB(1, 1), cB + hstep + kstep, voffB);
        PG8_WAIT_V(6); PG8_BAR;
    } else {
        PG8_STAGE(PG8_SB(0, 0), cB, voffB); PG8_STAGE(PG8_SA(0, 0), cA, vA[0]); PG8_STAGE(PG8_SB(0, 1), cB + hstep, voffB); PG8_STAGE(PG8_SA(0, 1), cA + hsA, vA[1]);
        if (wr == 1) PG8_BAR;
        PG8_WAIT_V(4); PG8_BAR;
        PG8_STAGE(PG8_SB(1, 0), cB + kstep, voffB); PG8_STAGE(PG8_SA(1, 0), cA + kstep, vA[0]); PG8_STAGE(PG8_SB(1, 1), cB + hstep + kstep, voffB);
        PG8_WAIT_V(6); PG8_BAR;
    }
    for (;;) {
        const bool has_next = S.next(ui + 1, nxt);
        if constexpr (GATHER) {
            if (has_next) {
#pragma unroll
                for (int h = 0; h < 2; ++h)
#pragma unroll
                    for (int i = 0; i < 2; ++i) asm volatile("global_load_dword %0, %1, off" : "=&v"(rawN[h][i]) : "v"(g.inv + nxt.pm * BM + HALF * h + gR[i]) : "memory");
            }
        }
        const char* nA = GATHER ? cA : (has_next ? (const char*)g.A + (size_t)nxt.pm * tstep : cA); const char* nB = has_next ? (const char*)g.Bt + (size_t)nxt.pb * tstep : cB;
        for (int t = 0; t < nt; t += 2) {
            const bool last = (t == nt - 2);
            const char* a1 = cA + (size_t)(t + 1) * kstep;
            const char* a2 = last ? nA : cA + (size_t)(t + 2) * kstep; const char* b2 = last ? nB : cB + (size_t)(t + 2) * kstep;
            const char* a3 = a2 + kstep; const char* b3 = b2 + kstep;
            if (last && has_next) S.a_ready(nxt);
            if constexpr (GATHER) {
                if (last) {
                    if (has_next) {
#pragma unroll
                        for (int h = 0; h < 2; ++h)
#pragma unroll
                            for (int i = 0; i < 2; ++i) { int tkn; asm volatile("v_mov_b32 %0, %1" : "=v"(tkn) : "v"(rawN[h][i])); vN[h][i] = (unsigned)tkn * (unsigned)(K * 2) + (unsigned)(gC[i] * 2); }
                    } else {
#pragma unroll
                        for (int h = 0; h < 2; ++h)
#pragma unroll
                            for (int i = 0; i < 2; ++i) vN[h][i] = vA[h][i];
                    }
                }
            }
            unsigned v2[2][2];
#pragma unroll
            for (int h = 0; h < 2; ++h)
#pragma unroll
                for (int i = 0; i < 2; ++i) v2[h][i] = last ? vN[h][i] : vA[h][i];
            if constexpr (SP2) {
            PG8_LDB(B0, 0, 0); PG8_LDB(B1, 0, 1); PG8_SCHED; PG8_LDA(At, 0, 0); PG8_STAGE(PG8_SA(1, 1), a1 + hsA, vA[1]);
            PG8_WAIT_V(8); PG8_WAIT_L(0); PG8_BAR; PG8_MMA(0, 0, At, B0); PG8_MMA(0, 1, At, B1); PG8_BAR; PG8_SCHED;
            PG8_LDA(At, 0, 1); PG8_STAGE(PG8_SB(0, 0), b2, voffB); PG8_STAGE(PG8_SB(0, 1), b2 + hstep, voffB); PG8_STAGE(PG8_SA(0, 0), a2, v2[0]);
            PG8_WAIT_V(8); PG8_WAIT_L(0); PG8_BAR; PG8_MMA(1, 0, At, B0); PG8_MMA(1, 1, At, B1); PG8_BAR; PG8_SCHED;
            PG8_LDB(B0, 1, 0); PG8_LDB(B1, 1, 1); PG8_SCHED; PG8_LDA(At, 1, 0); PG8_STAGE(PG8_SA(0, 1), a2 + hsA, v2[1]);
            PG8_WAIT_V(8); PG8_WAIT_L(0); PG8_BAR; PG8_MMA(0, 0, At, B0); PG8_MMA(0, 1, At, B1); PG8_BAR; PG8_SCHED;
            PG8_LDA(At, 1, 1); PG8_STAGE(PG8_SB(1, 0), b3, voffB); PG8_STAGE(PG8_SB(1, 1), b3 + hstep, voffB); PG8_STAGE(PG8_SA(1, 0), a3, v2[0]);
            PG8_WAIT_V(8); PG8_WAIT_L(0); PG8_BAR; PG8_MMA(1, 0, At, B0); PG8_MMA(1, 1, At, B1); PG8_BAR; PG8_SCHED;
            } else {
            PG8_LDB(B0, 0, 0); PG8_SCHED; PG8_LDA(At, 0, 0); PG8_STAGE(PG8_SA(1, 1), a1 + hsA, vA[1]);
            PG8_WAIT_L(8); PG8_BAR; PG8_WAIT_L(0); PG8_MMA(0, 0, At, B0); PG8_BAR; PG8_SCHED;
            PG8_LDB(B1, 0, 1); PG8_STAGE(PG8_SB(0, 0), b2, voffB);
            PG8_BAR; PG8_WAIT_L(0); PG8_MMA(0, 1, At, B1); PG8_BAR;
            PG8_LDA(At, 0, 1); PG8_STAGE(PG8_SA(0, 0), a2, v2[0]);
            PG8_BAR; PG8_WAIT_L(0); PG8_MMA(1, 0, At, B0); PG8_BAR; PG8_SCHED;
            PG8_STAGE(PG8_SB(0, 1), b2 + hstep, voffB);
            PG8_WAIT_V(6); PG8_BAR; PG8_MMA(1, 1, At, B1); PG8_BAR;
            PG8_LDB(B0, 1, 0); PG8_SCHED; PG8_LDA(At, 1, 0); PG8_STAGE(PG8_SA(0, 1), a2 + hsA, v2[1]);
            PG8_WAIT_L(8); PG8_BAR; PG8_WAIT_L(0); PG8_MMA(0, 0, At, B0); PG8_BAR; PG8_SCHED;
            PG8_LDB(B1, 1, 1); PG8_STAGE(PG8_SB(1, 0), b3, voffB);
            PG8_BAR; PG8_WAIT_L(0); PG8_MMA(0, 1, At, B1); PG8_BAR;
            PG8_LDA(At, 1, 1); PG8_STAGE(PG8_SA(1, 0), a3, v2[0]);
            PG8_BAR; PG8_WAIT_L(0); PG8_MMA(1, 0, At, B0); PG8_BAR; PG8_SCHED;
            PG8_STAGE(PG8_SB(1, 1), b3 + hstep, voffB);
            PG8_WAIT_V(6); PG8_BAR; PG8_MMA(1, 1, At, B1); PG8_BAR;
            }
        }
        if constexpr (ALIGN_EPI) { if (wr == 0) PG8_BAR; }
        if constexpr (!Epi::AFTER_DRAIN) { E(acc, cur, wr, wc, fr, fq); S.done(cur); }
        if (!has_next) break;
#pragma unroll
        for (int a = 0; a < 2; ++a)
#pragma unroll
            for (int b = 0; b < 2; ++b)
#pragma unroll
                for (int m = 0; m < 4; ++m)
#pragma unroll
                    for (int n = 0; n < 2; ++n) acc[a][b][m][n] = (f32x4){0.f, 0.f, 0.f, 0.f};
        cur = nxt; cA = nA; cB = nB; ++ui;
#pragma unroll
        for (int h = 0; h < 2; ++h)
#pragma unroll
            for (int i = 0; i < 2; ++i) vA[h][i] = vN[h][i];
        if constexpr (ALIGN_EPI) { if (wr == 1) PG8_BAR; }
    }
    PG8_WAIT_V(0);
    if constexpr (!ALIGN_EPI) { if (wr == 0) PG8_BAR; }
    PG8_BAR;
    if constexpr (Epi::AFTER_DRAIN) { E.fused(acc, cur, wr, wc, fr, fq, lds, wid, lane); S.done(cur); }
#undef PG8_SA
#undef PG8_SB
#undef PG8_STAGE
#undef PG8_LDA
#undef PG8_LDB
#undef PG8_MMA
#undef PG8_WAIT_V
#undef PG8_WAIT_L
#undef PG8_BAR
#undef PG8_SCHED
}
}
#define GAS __attribute__((address_space(1)))
#define LAS __attribute__((address_space(3)))
typedef unsigned short bf16;
typedef unsigned v4u __attribute__((ext_vector_type(4)));
typedef float f32x4 __attribute__((ext_vector_type(4)));
typedef short bf16x8 __attribute__((ext_vector_type(8)));
typedef GAS unsigned gu32;
typedef GAS unsigned long long gu64;
#define RLX_AGENT __ATOMIC_RELAXED, __HIP_MEMORY_SCOPE_AGENT
#define LDS_WAIT() asm volatile("s_waitcnt lgkmcnt(0)" ::: "memory")
#define VM_WAIT() asm volatile("s_waitcnt vmcnt(0)" ::: "memory")
#define LDS_BAR() do { asm volatile("s_waitcnt lgkmcnt(0)" ::: "memory"); __builtin_amdgcn_s_barrier(); asm volatile("" ::: "memory"); } while (0)
__device__ __forceinline__ unsigned long long rt() { return __builtin_amdgcn_s_memrealtime(); }
__device__ __forceinline__ unsigned f2bf(float f) { unsigned u = __builtin_bit_cast(unsigned, f); return (u + 0x7fffu + ((u >> 16) & 1u)) >> 16; }
__device__ __forceinline__ unsigned pk2(float lo, float hi) { typedef float f2_t __attribute__((ext_vector_type(2))); typedef __bf16 b2_t __attribute__((ext_vector_type(2))); f2_t v = {lo, hi}; b2_t b = __builtin_convertvector(v, b2_t); return __builtin_bit_cast(unsigned, b); }

#define XB_TMO      128
#define XB_XCNT(j)  (256  + 64 * (j))
#define XB_XSUB(j)  (1280 + 64 * (j))
#define XB_XGEN(j)  (2304 + 64 * (j))
#define XB_TOP      3328
#define XB_TOPGEN   3392
#define XCD_BAR_WORDS 3456
#define XB_SPIN_CAP (1u << 18)

__device__ __forceinline__ unsigned xb_ld(unsigned* p)              { return __hip_atomic_load(p, __ATOMIC_RELAXED, __HIP_MEMORY_SCOPE_AGENT); }
__device__ __forceinline__ unsigned xb_add(unsigned* p, unsigned v) { return __hip_atomic_fetch_add(p, v, __ATOMIC_RELAXED, __HIP_MEMORY_SCOPE_AGENT); }
__device__ __forceinline__ unsigned xb_xcc_id() { return (unsigned)__builtin_amdgcn_s_getreg((3 << 11) | 20) & 0xFu; }
#define XB_SPIN(cond, bar) do { unsigned _sp = 0; while (cond) { __builtin_amdgcn_s_sleep(1); \
    if ((++_sp & 255u) == 0u) { if (xb_ld(&(bar)[XB_TMO])) break; if (_sp > XB_SPIN_CAP) { atomicAdd(&(bar)[XB_TMO], 1u); break; } } } } while (0)

struct XcdBarrier {
    unsigned* bar; unsigned x;
    volatile LAS unsigned* st;
};

__device__ __forceinline__ XcdBarrier xcd_barrier_post(unsigned* bar, volatile LAS unsigned* st, const int tid) {
    XcdBarrier b; b.bar = bar; b.x = xb_xcc_id(); b.st = st;
    if (tid == 0) (void)xb_add(&bar[XB_XCNT(b.x)], 1u);
    return b;
}
__device__ __forceinline__ void xcd_barrier_complete(unsigned* bar, unsigned x, unsigned& nloc, unsigned& nx) {
    const unsigned G = gridDim.x * gridDim.y * gridDim.z;
    unsigned sum, cnt, mine, sp = 0u;
    for (;;) {
        sum = 0u; cnt = 0u; mine = 0u;
#pragma unroll 1
        for (unsigned j = 0; j < 16; ++j) { const unsigned c = xb_ld(&bar[XB_XCNT(j)]); sum += c; cnt += (c > 0u) ? 1u : 0u; mine = (j == x) ? c : mine; }
        if (sum == G) break;
        __builtin_amdgcn_s_sleep(1);
        if ((++sp & 255u) == 0u) { if (xb_ld(&bar[XB_TMO])) break; if (sp > XB_SPIN_CAP) { atomicAdd(&bar[XB_TMO], 1u); break; } }
    }
    nloc = mine > 0u ? mine : 1u; nx = cnt > 0u ? cnt : 1u;
}

__device__ __forceinline__ void xcd_barrier(const XcdBarrier& b, const int tid) {
    asm volatile("s_waitcnt vmcnt(0)" ::: "memory");
    __syncthreads();
    if (tid == 0) {
        unsigned* bar = b.bar;
        __builtin_amdgcn_s_waitcnt(0);
        unsigned nloc = b.st[0], nx = b.st[1];
        if (nloc == 0u) { xcd_barrier_complete(bar, b.x, nloc, nx); b.st[0] = nloc; b.st[1] = nx; }
        const unsigned old = xb_add(&bar[XB_XSUB(b.x)], 1u);
        const unsigned gen = old / nloc;
        if (old + 1u == (gen + 1u) * nloc) {
            __builtin_amdgcn_fence(__ATOMIC_RELEASE, "agent");
            asm volatile("s_waitcnt vmcnt(0)" ::: "memory");
            const unsigned og = xb_add(&bar[XB_TOP], 1u);
            const unsigned tg = og / nx;
            if (og + 1u == (tg + 1u) * nx) xb_add(&bar[XB_TOPGEN], 1u);
            else XB_SPIN(xb_ld(&bar[XB_TOPGEN]) == tg, bar);
            __builtin_amdgcn_fence(__ATOMIC_ACQUIRE, "agent");
            xb_add(&bar[XB_XGEN(b.x)], 1u);
            asm volatile("s_waitcnt vmcnt(0)" ::: "memory");
        } else {
            XB_SPIN(xb_ld(&bar[XB_XGEN(b.x)]) == gen, bar);
            __builtin_amdgcn_fence(__ATOMIC_ACQUIRE, "agent");
            asm volatile("s_waitcnt vmcnt(0)" ::: "memory");
        }
    }
    __syncthreads();
}

#include <hip/hip_bf16.h>
#include <cmath>
namespace dsa_body {
using bf16=__hip_bfloat16;
using bf16x8=__attribute__((ext_vector_type(8)))short;
using s16x4=__attribute__((ext_vector_type(4)))short;
using f32x16=__attribute__((ext_vector_type(16)))float;
using u32x4=__attribute__((ext_vector_type(4)))unsigned;
constexpr int SEQ=2048,D=64,DM=64,DMQ=2816,DMO=1024;
constexpr int NW=8,QBLK=32,QB=QBLK*NW,KVBLK=64,NQB=SEQ/QB;
__device__ __forceinline__ int crow(int r,int hi){return (r&3)+8*(r>>2)+4*hi;}
#define SBAR() __builtin_amdgcn_sched_barrier(0)
typedef unsigned u32x2 __attribute__((ext_vector_type(2)));
__device__ __forceinline__ void smask(f32x16&p0,f32x16&p1,u32x2 mk,int hi){
  const int m0=(int)(mk.x>>(4*hi)), m1=(int)(mk.y>>(4*hi));
  #pragma unroll
  for(int r=0;r<16;++r){ const int cb=(r&3)+8*(r>>2);
    const unsigned n0=(unsigned)__builtin_amdgcn_sbfe(m0,cb,1), n1=(unsigned)__builtin_amdgcn_sbfe(m1,cb,1);
    p0[r]=__uint_as_float((__float_as_uint(p0[r])&n0)|(~n0&0xff800000u)); p1[r]=__uint_as_float((__float_as_uint(p1[r])&n1)|(~n1&0xff800000u)); }
}
constexpr int NSLOT=3, SLOTB=8192;
constexpr int LDS_K=0, LDS_V=NSLOT*SLOTB, LDS_WS=2*NSLOT*SLOTB, LDS_OST=LDS_WS+NW*64*4, LDS_BYTES=LDS_OST+NW*4096;
constexpr float C2=0.125f*1.4426950408889634f;
__device__ __forceinline__ void glds16(const void*gsrc,unsigned lds_dst){unsigned keep;
  asm volatile("s_mov_b32 %0, m0\n\ts_mov_b32 m0, %2\n\ts_nop 0\n\tglobal_load_lds_dwordx4 %1, off\n\ts_mov_b32 m0, %0":"=&s"(keep):"v"(gsrc),"s"(lds_dst):"memory");}
__device__ __forceinline__ float max3f(float a,float b,float c){float r;asm("v_max3_f32 %0, %1, %2, %3":"=v"(r):"v"(a),"v"(b),"v"(c));return r;}
__device__ __forceinline__ float max2f(float a,float b){float r;asm("v_max_f32_e32 %0, %1, %2":"=v"(r):"v"(a),"v"(b));return r;}
__device__ __forceinline__ float fadd_s(float a,float b){float r;asm("v_add_f32_e32 %0, %1, %2":"=v"(r):"v"(a),"v"(b));return r;}
__device__ __forceinline__ float fsub_s(float a,float b){float r;asm("v_sub_f32_e32 %0, %1, %2":"=v"(r):"v"(a),"v"(b));return r;}
typedef float f32x2_t __attribute__((ext_vector_type(2))); typedef __bf16 bf16x2_t __attribute__((ext_vector_type(2)));
__device__ __forceinline__ unsigned cvtpk_s(float lo,float hi){f32x2_t v={lo,hi};bf16x2_t b=__builtin_convertvector(v,bf16x2_t);return __builtin_bit_cast(unsigned,b);}
#define WAIT_BAR(N) asm volatile("s_waitcnt vmcnt(" #N ") lgkmcnt(0)\n\ts_barrier":::"memory")

__device__ __forceinline__ void qkt(f32x16&p0,f32x16&p1,const char*Kslot,const bf16x8*qr,const f32x16&negm,int r32,int hi){
  const char*kb=Kslot+hi*1024+r32*16;
  #pragma unroll
  for(int d0=0;d0<4;++d0){
    const bf16x8 b0=*reinterpret_cast<const bf16x8*>(kb+d0*2048);
    const bf16x8 b1=*reinterpret_cast<const bf16x8*>(kb+d0*2048+512);
    if(d0==0){p0=__builtin_amdgcn_mfma_f32_32x32x16_bf16(b0,qr[0],negm,0,0,0);p1=__builtin_amdgcn_mfma_f32_32x32x16_bf16(b1,qr[0],negm,0,0,0);}
    else{p0=__builtin_amdgcn_mfma_f32_32x32x16_bf16(b0,qr[d0],p0,0,0,0);p1=__builtin_amdgcn_mfma_f32_32x32x16_bf16(b1,qr[d0],p1,0,0,0);}}
}
typedef __attribute__((address_space(3))) const char* lds_cptr;
typedef short v4i16_t __attribute__((ext_vector_type(4)));
__device__ __forceinline__ void kload8(bf16x8*kf,lds_cptr kp){
  kf[0]=*(const __attribute__((address_space(3))) bf16x8*)(kp);      kf[1]=*(const __attribute__((address_space(3))) bf16x8*)(kp+512);
  kf[2]=*(const __attribute__((address_space(3))) bf16x8*)(kp+2048); kf[3]=*(const __attribute__((address_space(3))) bf16x8*)(kp+2560);
  kf[4]=*(const __attribute__((address_space(3))) bf16x8*)(kp+4096); kf[5]=*(const __attribute__((address_space(3))) bf16x8*)(kp+4608);
  kf[6]=*(const __attribute__((address_space(3))) bf16x8*)(kp+6144); kf[7]=*(const __attribute__((address_space(3))) bf16x8*)(kp+6656);
}
__device__ __forceinline__ void kload2(bf16x8*kf,lds_cptr kp,int j){ kf[2*j]=*(const __attribute__((address_space(3))) bf16x8*)(kp+j*2048); kf[2*j+1]=*(const __attribute__((address_space(3))) bf16x8*)(kp+j*2048+512); }
__device__ __forceinline__ s16x4 vtr(lds_cptr p){ return __builtin_bit_cast(s16x4,__builtin_amdgcn_ds_read_tr16_b64_v4i16((__attribute__((address_space(3))) v4i16_t*)p)); }
__device__ __forceinline__ float rowmax(const f32x16&p0,const f32x16&p1){
  float a=max3f(p0[0],p0[1],p1[0]),b=max3f(p0[2],p0[3],p1[1]);a=max3f(a,p1[2],p1[3]);
  #pragma unroll
  for(int r=4;r<16;r+=4){a=max3f(a,p0[r],p0[r+1]);b=max3f(b,p0[r+2],p0[r+3]);a=max3f(a,p1[r],p1[r+1]);b=max3f(b,p1[r+2],p1[r+3]);}
  const float m=max2f(a,b);
  auto rr=__builtin_amdgcn_permlane32_swap(__float_as_uint(m),__float_as_uint(m),false,false);
  return max2f(__uint_as_float(rr[0]),__uint_as_float(rr[1]));
}
__device__ __forceinline__ void pv(f32x16*o,int vb,bf16x8 pa0,bf16x8 pa1,bf16x8 pa2,bf16x8 pa3){
  #pragma unroll
  for(int d0=0;d0<2;++d0){s16x4 lo[4],hi[4];
    #pragma unroll
    for(int ks=0;ks<4;++ks){
      asm volatile("ds_read_b64_tr_b16 %0,%1 offset:%c2":"=&v"(lo[ks]):"v"(vb),"i"(d0*4096+ks*1024):"memory");
      asm volatile("ds_read_b64_tr_b16 %0,%1 offset:%c2":"=&v"(hi[ks]):"v"(vb),"i"(d0*4096+ks*1024+512):"memory");}
    asm volatile("s_waitcnt lgkmcnt(0)":::"memory");SBAR();
    #define PK(k) (bf16x8){lo[k][0],lo[k][1],lo[k][2],lo[k][3],hi[k][0],hi[k][1],hi[k][2],hi[k][3]}
    o[d0]=__builtin_amdgcn_mfma_f32_32x32x16_bf16(pa0,PK(0),o[d0],0,0,0);
    o[d0]=__builtin_amdgcn_mfma_f32_32x32x16_bf16(pa1,PK(1),o[d0],0,0,0);
    o[d0]=__builtin_amdgcn_mfma_f32_32x32x16_bf16(pa2,PK(2),o[d0],0,0,0);
    o[d0]=__builtin_amdgcn_mfma_f32_32x32x16_bf16(pa3,PK(3),o[d0],0,0,0);
    #undef PK
  }
}

#ifndef ATTN_STORE16
#define ATTN_STORE16(p,v) (*(u32x4*)(p)=(v))
#endif
template<int THRL> __device__ __forceinline__ void dsa_unit(int b,int u,const bf16*Q,const bf16*__restrict__ K,const bf16*__restrict__ V,bf16*O,const unsigned*MASKW,char*shm,const int tid){
  const int lane=tid&63,r32=lane&31,hi=lane>>5; const int wid=__builtin_amdgcn_readfirstlane(tid>>6);
  const long rowbase=(long)b*SEQ; const int q0=u*32;
  const bf16*Qw=Q+(rowbase+q0+wid*4+(r32>>3))*DMQ+(r32&7)*64;
  const bf16*Kh=K+rowbase*DM,*Vh=V+rowbase*DM;
  const unsigned*mrow=MASKW+(rowbase+q0+wid*4+(r32>>3))*64;
  const unsigned lds0=(unsigned)(uintptr_t)shm;
  float*wsf=(float*)(shm+LDS_WS)+wid*64;
  const bf16*ksrc=Kh+(long)lane*DM+wid*8;
  const bf16*vsrc=Vh+(long)(16*(wid&3)+(lane>>2))*DM+(wid>>2)*32+(lane&3)*8;
  const unsigned kdst=lds0+LDS_K+wid*1024, vdst=lds0+LDS_V+wid*1024;
  #define DMA_K(t,slot) glds16(ksrc+(long)(t)*KVBLK*DM,(unsigned)__builtin_amdgcn_readfirstlane(kdst+(slot)))
  #define DMA_V(t,slot) glds16(vsrc+(long)(t)*KVBLK*DM,(unsigned)__builtin_amdgcn_readfirstlane(vdst+(slot)))
  const int vb0=(int)(lds0+LDS_V)+((lane>>4)&1)*32+(lane&3)*8+(4*hi+((lane&15)>>2))*64;
  const char*Kbase=shm+LDS_K; bf16x8 kf[8];
  const lds_cptr shm3=(lds_cptr)shm; const lds_cptr kp0=shm3+LDS_K+hi*1024+r32*16; const lds_cptr vp0=shm3+LDS_V+((lane>>4)&1)*32+(lane&3)*8+(4*hi+((lane&15)>>2))*64;
  int NT_=(((u>>1)+1)+1)&~1; if(NT_<4)NT_=4; const int NT=NT_;
  u32x2 mraw0,mkn,mkc;
  #define MLOAD(dst,t) asm volatile("global_load_dwordx2 %0, %1, off":"=&v"(dst):"v"(mrow+2*(t)):"memory")
  #define MCOPY(dst,src) asm volatile("v_mov_b32 %0, %2\n\tv_mov_b32 %1, %3":"=&v"(dst.x),"=&v"(dst.y):"v"(src.x),"v"(src.y))
  MLOAD(mraw0,0); MLOAD(mkn,1);
  DMA_K(0,0);DMA_V(0,0);DMA_K(1,SLOTB);
  bf16x8 qr[4];
  #pragma unroll
  for(int d0=0;d0<4;++d0)qr[d0]=*reinterpret_cast<const bf16x8*>(&Qw[d0*16+hi*8]);
  float mhat=0.f,l_reg=0.f;f32x16 o[2];o[0]=f32x16{};o[1]=f32x16{};const f32x16 negm=f32x16{};
  #define CMASK(P0,P1,t) smask(P0,P1,mkc,hi)
  bool resc=false;
  #define START(P0,P1) do{ const float rm=rowmax(P0,P1); resc=false; \
    { const float dl=__any(rm>(float)THRL)?__builtin_fmaxf(rm,0.f):0.f; mhat=fadd_s(mhat,dl); \
      _Pragma("unroll") for(int r=0;r<16;++r){P0[r]=fsub_s(P0[r],dl);P1[r]=fsub_s(P1[r],dl);} \
      } \
    _Pragma("unroll") for(int r=0;r<16;++r)P0[r]=__builtin_amdgcn_exp2f(P0[r]); }while(0)
  #define RESC() do{ if(resc){ asm volatile("s_waitcnt lgkmcnt(0)":::"memory"); \
      _Pragma("unroll") for(int d_=0;d_<2;++d_) _Pragma("unroll") for(int r=0;r<16;++r)o[d_][r]*=wsf[crow(r,hi)]; } }while(0)
  f32x16 pA0,pA1,pB0,pB1;
  int sl_prev=0,sl_cur=0,sl_next=SLOTB;
  #define ROT() do{sl_prev=sl_cur;sl_cur=sl_next;sl_next=(sl_next==(NSLOT-1)*SLOTB)?0:sl_next+SLOTB;}while(0)
  DMA_K(2,2*SLOTB);
  WAIT_BAR(3);
  MCOPY(mkc,mraw0);
  qkt(pA0,pA1,Kbase,qr,negm,r32,hi);asm volatile("s_nop 15\n\ts_nop 7":"+v"(pA0),"+v"(pA1));CMASK(pA0,pA1,0);
  START(pA0,pA1);
  _Pragma("unroll") for(int r=0;r<16;++r)pA1[r]=__builtin_amdgcn_exp2f(pA1[r]);
  WAIT_BAR(0);
  DMA_K(3,0);DMA_V(1,SLOTB);
  ROT();
  kload8(kf,kp0+sl_cur);
  WAIT_BAR(2);
  s16x4 vlo[8],vhi[8]; u32x4 pw0,pw1,pw2,pw3;
  #define PKW(P,B) cvtpk_s(P[B],P[B+1])
  #define PAF(k) __builtin_bit_cast(bf16x8,pw##k)
  #define VFR(i) (bf16x8){vlo[i][0],vlo[i][1],vlo[i][2],vlo[i][3],vhi[i][0],vhi[i][1],vhi[i][2],vhi[i][3]}
  #define PIN(x) asm volatile("":"+v"(x))
  #define MX3(a,b,c) __builtin_fmaxf(__builtin_fmaxf((a),(b)),(c))
  #define GAPA(MF,A0,A1,A2,A3,W0,W1,PW) do{ MF; sacc+=A0; sacc+=A1; sacc+=A2; sacc+=A3; PIN(sacc); W0; W1; PIN(PW); SBAR(); }while(0)
  #define EX(v) __builtin_amdgcn_exp2f(v)
  #define GAPB(MF,X,B) do{ MF; X[B]=EX(X[B]); X[B+1]=EX(X[B+1]); X[B+2]=EX(X[B+2]); X[B+3]=EX(X[B+3]); PIN(X); SBAR(); }while(0)
  #define VRD(i) do{ vlo[i]=vtr(vp_+(((i)>>2)*4096+((i)&3)*1024)); vhi[i]=vtr(vp_+(((i)>>2)*4096+((i)&3)*1024+512)); }while(0)
  #define KRD(G,j) do{ if(G){ kload2(kf,kp0+sl_next,j); SBAR(); } }while(0)
  #define STEP(C0,C1,P0,P1,t,GK,GV,GL) do{ SBAR(); MCOPY(mkc,mkn); if(GV){MLOAD(mkn,(t)+1);} \
    const lds_cptr vp_=vp0+sl_prev; \
    VRD(0); SBAR(); float sacc=(P0[0]+P0[1]); \
    GAPA(C0=__builtin_amdgcn_mfma_f32_32x32x16_bf16(kf[0],qr[0],negm,0,0,0), P0[2],P0[3],P0[4],P0[5],     pw0[0]=PKW(P0,0), pw0[1]=PKW(P0,2), pw0); \
    VRD(4); SBAR(); GAPA(C1=__builtin_amdgcn_mfma_f32_32x32x16_bf16(kf[1],qr[0],negm,0,0,0), P0[6],P0[7],P0[8],P0[9],     pw0[2]=PKW(P0,4), pw0[3]=PKW(P0,6), pw0); \
    VRD(1); SBAR(); GAPA(C0=__builtin_amdgcn_mfma_f32_32x32x16_bf16(kf[2],qr[1],C0,0,0,0),   P0[10],P0[11],P0[12],P0[13], pw1[0]=PKW(P0,8), pw1[1]=PKW(P0,10), pw1); \
    VRD(5); SBAR(); GAPA(C1=__builtin_amdgcn_mfma_f32_32x32x16_bf16(kf[3],qr[1],C1,0,0,0),   P0[14],P0[15],P1[0],P1[1],   pw1[2]=PKW(P0,12),pw1[3]=PKW(P0,14), pw1); \
    VRD(2); SBAR(); GAPA(C0=__builtin_amdgcn_mfma_f32_32x32x16_bf16(kf[4],qr[2],C0,0,0,0),   P1[2],P1[3],P1[4],P1[5],     pw2[0]=PKW(P1,0), pw2[1]=PKW(P1,2), pw2); \
    VRD(6); SBAR(); GAPA(C1=__builtin_amdgcn_mfma_f32_32x32x16_bf16(kf[5],qr[2],C1,0,0,0),   P1[6],P1[7],P1[8],P1[9],     pw2[2]=PKW(P1,4), pw2[3]=PKW(P1,6), pw2); \
    VRD(3); SBAR(); GAPA(C0=__builtin_amdgcn_mfma_f32_32x32x16_bf16(kf[6],qr[3],C0,0,0,0),   P1[10],P1[11],P1[12],P1[13], pw3[0]=PKW(P1,8), pw3[1]=PKW(P1,10), pw3); \
    VRD(7); SBAR(); GAPA(C1=__builtin_amdgcn_mfma_f32_32x32x16_bf16(kf[7],qr[3],C1,0,0,0),   P1[14],P1[15],0.f,0.f,       pw3[2]=PKW(P1,12),pw3[3]=PKW(P1,14), pw3); \
    l_reg+=sacc; \
    if(GK){DMA_K((t)+3,sl_cur);} if(GV){DMA_V((t)+1,sl_next);} \
    CMASK(C0,C1,t); \
    _Pragma("unroll") for(int r=0;r<16;++r){C0[r]-=mhat;C1[r]-=mhat;} \
    { float a=MX3(C0[0],C0[1],C1[0]),b=MX3(C0[2],C0[3],C1[1]); a=MX3(a,C1[2],C1[3]); \
      _Pragma("unroll") for(int r=4;r<16;r+=4){a=MX3(a,C0[r],C0[r+1]);b=MX3(b,C0[r+2],C0[r+3]);a=MX3(a,C1[r],C1[r+1]);b=MX3(b,C1[r+2],C1[r+3]);} \
      float rm=__builtin_fmaxf(a,b); { auto rr=__builtin_amdgcn_permlane32_swap(__float_as_uint(rm),__float_as_uint(rm),false,false); rm=__builtin_fmaxf(__uint_as_float(rr[0]),__uint_as_float(rr[1])); } \
      resc=false; \
      if(__builtin_expect(__any(rm>(float)THRL),0)){ const float dl=__builtin_fmaxf(rm,0.f); mhat+=dl; \
        _Pragma("unroll") for(int r=0;r<16;++r){C0[r]-=dl;C1[r]-=dl;} \
        const float f=__builtin_amdgcn_exp2f(-dl); l_reg*=f; if(hi==0)wsf[r32]=f; resc=true; } } \
    SBAR(); \
    GAPB(o[0]=__builtin_amdgcn_mfma_f32_32x32x16_bf16(PAF(0),VFR(0),o[0],0,0,0), C0,0); \
    GAPB(o[1]=__builtin_amdgcn_mfma_f32_32x32x16_bf16(PAF(0),VFR(4),o[1],0,0,0), C0,4); \
    KRD(GL,0); GAPB(o[0]=__builtin_amdgcn_mfma_f32_32x32x16_bf16(PAF(1),VFR(1),o[0],0,0,0), C0,8); \
    KRD(GL,1); GAPB(o[1]=__builtin_amdgcn_mfma_f32_32x32x16_bf16(PAF(1),VFR(5),o[1],0,0,0), C0,12); \
    KRD(GL,2); GAPB(o[0]=__builtin_amdgcn_mfma_f32_32x32x16_bf16(PAF(2),VFR(2),o[0],0,0,0), C1,0); \
    KRD(GL,3); GAPB(o[1]=__builtin_amdgcn_mfma_f32_32x32x16_bf16(PAF(2),VFR(6),o[1],0,0,0), C1,4); \
    GAPB(o[0]=__builtin_amdgcn_mfma_f32_32x32x16_bf16(PAF(3),VFR(3),o[0],0,0,0), C1,8); \
    GAPB(o[1]=__builtin_amdgcn_mfma_f32_32x32x16_bf16(PAF(3),VFR(7),o[1],0,0,0), C1,12); \
    }while(0)
  int t=1;
  for(;t+5<NT;t+=2){
    STEP(pB0,pB1,pA0,pA1,t,true,true,true);     WAIT_BAR(2); RESC(); ROT();
    STEP(pA0,pA1,pB0,pB1,t+1,true,true,true);   WAIT_BAR(2); RESC(); ROT();
  }
  #define ENDW(tt) do{ if((tt)+3<NT){WAIT_BAR(2);} else if((tt)+2<NT){WAIT_BAR(1);} else {WAIT_BAR(0);} }while(0)
  for(;t+1<NT;t+=2){
    STEP(pB0,pB1,pA0,pA1,t,(t+3<NT),(t+1<NT),(t+1<NT));       ENDW(t);   RESC(); ROT();
    STEP(pA0,pA1,pB0,pB1,t+1,(t+4<NT),(t+2<NT),(t+2<NT));     ENDW(t+1); RESC(); ROT();
  }
  STEP(pB0,pB1,pA0,pA1,NT-1,false,false,false); RESC();
  { float sacc=pB0[0]+pB0[1]; _Pragma("unroll") for(int r=2;r<16;++r)sacc+=pB0[r]; _Pragma("unroll") for(int r=0;r<16;++r)sacc+=pB1[r]; l_reg+=sacc;
    pw0=(u32x4){PKW(pB0,0),PKW(pB0,2),PKW(pB0,4),PKW(pB0,6)};pw1=(u32x4){PKW(pB0,8),PKW(pB0,10),PKW(pB0,12),PKW(pB0,14)};pw2=(u32x4){PKW(pB1,0),PKW(pB1,2),PKW(pB1,4),PKW(pB1,6)};pw3=(u32x4){PKW(pB1,8),PKW(pB1,10),PKW(pB1,12),PKW(pB1,14)};
    SBAR(); pv(o,vb0+sl_cur,PAF(0),PAF(1),PAF(2),PAF(3)); }
  #undef PKW
  #undef PAF
  #undef VFR
  #undef PIN
  #undef MX3
  #undef GAPA
  #undef GAPB
  #undef EX
  #undef VRD
  #undef KRD
  #undef STEP
  #undef ENDW
  {auto rr=__builtin_amdgcn_permlane32_swap(__float_as_uint(l_reg),__float_as_uint(l_reg),false,false);l_reg=__uint_as_float(rr[0])+__uint_as_float(rr[1]);}
  if(hi==0)wsf[32+r32]=l_reg;asm volatile("s_waitcnt lgkmcnt(0)":::"memory");
  float rli[16];
  #pragma unroll
  for(int r=0;r<16;++r)rli[r]=__builtin_amdgcn_rcpf(wsf[32+crow(r,hi)]);
  bf16*Ow=O+(rowbase+q0+wid*4)*DMO;
  { bf16*stg=(bf16*)(shm+LDS_OST)+wid*2048;
    #pragma unroll
    for(int r=0;r<16;++r){const int orow=crow(r,hi);
      #pragma unroll
      for(int d0=0;d0<2;++d0)stg[orow*64+d0*32+r32]=__float2bfloat16(o[d0][r]*rli[r]);}
    asm volatile("s_waitcnt lgkmcnt(0)":::"memory");
    #pragma unroll
    for(int i=0;i<4;++i){const int row=i*8+(lane>>3),ch=lane&7; const u32x4 v=*(const u32x4*)(stg+row*64+ch*8); ATTN_STORE16(Ow+(long)(row>>3)*DMO+(row&7)*64+ch*8,v);} }
  asm volatile("s_waitcnt lgkmcnt(0)\n\ts_barrier":::"memory");
  #undef DMA_K
  #undef DMA_V
  #undef CMASK
  #undef MLOAD
  #undef MCOPY
  #undef START
  #undef RESC
  #undef ROT
}
constexpr int ATTN_LDS_BYTES=LDS_BYTES;
template<int THRL=8> __device__ __forceinline__ void dsa_attn_phase(char*lds,const bf16*Pq,const bf16*KD,const bf16*VD,bf16*MIXp,const unsigned*MASKW,int vcu,int ncu,int tid){
  for(int v=vcu;v<16*16;v+=ncu){
    const int b=v>>4, s=v&15;
    #pragma unroll 1
    for(int i=0;i<4;++i){ const int u=(i==0)?s:(i==1)?63-s:(i==2)?31-s:32+s;
      dsa_unit<THRL>(b,u,Pq,KD,VD,MIXp,MASKW,lds,tid); }
  }
}
#undef SBAR
#undef WAIT_BAR
}

constexpr int NWAVES = 8, NTHR = 512;
constexpr int BATCH = 16, SEQ = 2048, D = 1024, M = BATCH * SEQ;
constexpr int EIN = 2776, EINP = 2816, FF = 2816, NEXP = 8;
constexpr int PC_AQ = 0, PC_CKV = 512, PC_QI = 640, PC_KI = 1152, PC_WI = 1216, PC_BQ = 1224, PC_BK = 1480, PC_BV = 1736, PC_BG = 2248, PC_BR = 2264;
constexpr float ALPHA = 1.6817928305074290f;
constexpr float LN_EPS = 1e-5f, RMS_EPS = 1e-6f;
constexpr float C2 = 0.125f * 1.4426950408889634f;
constexpr int MOE_ROWS = 2 * M + NEXP * 256;
constexpr int TOPK = 256;

constexpr size_t MiB = 1u << 20;
constexpr size_t WS_CTL = 0, CTL_ZERO_BYTES = 256 * 1024;
constexpr size_t WS_XSTAT = 1u << 20;
constexpr int CW_PANEL = 16384;
constexpr size_t WS_WB = 2 * MiB;
constexpr size_t WB_WIN = 0, WB_WOUT = 6 * MiB, WB_WGU = 8 * MiB, WB_WDN = 20 * MiB;
constexpr size_t WB_WQKV = 0, WB_MGU = 8 * MiB, WB_MDN = 96 * MiB;
constexpr size_t WS_XB = 146 * MiB;
constexpr size_t WS_P = 210 * MiB, WS_HID = 210 * MiB, WS_MIX = 386 * MiB;
constexpr size_t WS_KD = 450 * MiB, WS_VD = 454 * MiB, WS_KI = 458 * MiB, WS_MASK = 462 * MiB;
constexpr size_t WS_GST = 470 * MiB, WS_H_EVEN = 470 * MiB;
constexpr size_t WS_QT = 534 * MiB, WS_KT = 550 * MiB, WS_EBL = 582 * MiB, WS_SC = 584 * MiB;
constexpr size_t WS_QKV = 210 * MiB, WS_AO = 402 * MiB, WS_MIXO = 530 * MiB, WS_H_ODD = 594 * MiB;
constexpr size_t WS_XPERM = 210 * MiB, WS_HIDP = 342 * MiB;
constexpr size_t WS_ROUTE = 722 * MiB, WS_INV = 723 * MiB, WS_CNTT = 723 * MiB + 512 * 1024  , WS_END = 724 * MiB;
constexpr int CW_TMO = 0, CW_CNT = 64  , CW_BAR = 4096;

constexpr int RING_BYTES = 131072, LDSCTL_OFF = RING_BYTES, MISC_OFF = LDSCTL_OFF + 320, LDS_BYTES = 147456;
constexpr int XTRA_OFF = MISC_OFF + 128;

__device__ __forceinline__ float bf2f(unsigned short u) { return __uint_as_float((unsigned)u << 16); }
__device__ __forceinline__ float bflo(unsigned w) { return __uint_as_float(w << 16); }
__device__ __forceinline__ float bfhi(unsigned w) { return __uint_as_float(w & 0xffff0000u); }
__device__ __forceinline__ float wave_sum_fd(float v);
__device__ __forceinline__ float wave_sum(float v) { return wave_sum_fd(v); }
__device__ __forceinline__ float wave_sum_l(float v, int lane) {
#pragma unroll
    for (int o = 1; o < 64; o <<= 1) v += __int_as_float(__builtin_amdgcn_ds_bpermute((lane ^ o) << 2, __float_as_int(v)));
    return v;
}
__device__ __forceinline__ int hw_lane() { int ln; asm volatile("v_mbcnt_lo_u32_b32 %0, -1, 0\n\tv_mbcnt_hi_u32_b32 %0, -1, %0" : "=v"(ln)); return ln & 63; }
__device__ __forceinline__ float wave_sum_fd(float v) {
    v += __int_as_float(__builtin_amdgcn_mov_dpp(__float_as_int(v), 0xB1, 0xF, 0xF, true));
    v += __int_as_float(__builtin_amdgcn_mov_dpp(__float_as_int(v), 0x4E, 0xF, 0xF, true));
    v += __int_as_float(__builtin_amdgcn_mov_dpp(__float_as_int(v), 0x141, 0xF, 0xF, true));
    v += __int_as_float(__builtin_amdgcn_mov_dpp(__float_as_int(v), 0x140, 0xF, 0xF, true));
    const int b = __float_as_int(v);
    return (__int_as_float(__builtin_amdgcn_readlane(b, 0)) + __int_as_float(__builtin_amdgcn_readlane(b, 16))) + (__int_as_float(__builtin_amdgcn_readlane(b, 32)) + __int_as_float(__builtin_amdgcn_readlane(b, 48)));
}
__device__ __forceinline__ float wave_max(float v) {
#pragma unroll
    for (int o = 1; o < 64; o <<= 1) v = fmaxf(v, __shfl_xor(v, o));
    return v;
}
__device__ __forceinline__ int wave_sum_i(int v) {
#pragma unroll
    for (int o = 1; o < 64; o <<= 1) v += __shfl_xor(v, o);
    return v;
}
__device__ __forceinline__ int wave_incl_scan_i(int v, int lane) {
#pragma unroll
    for (int o = 1; o < 64; o <<= 1) { const int t = __shfl_up(v, o); if (lane >= o) v += t; }
    return v;
}
__device__ __forceinline__ void ld8bf(const bf16* p, float* f) {
    const v4u w = *(const v4u*)p;
    f[0] = bflo(w.x); f[1] = bfhi(w.x); f[2] = bflo(w.y); f[3] = bfhi(w.y); f[4] = bflo(w.z); f[5] = bfhi(w.z); f[6] = bflo(w.w); f[7] = bfhi(w.w);
}
__device__ __forceinline__ float silu_f(float x) { return x * __builtin_amdgcn_rcpf(1.0f + __builtin_amdgcn_exp2f(-1.4426950408889634f * x)); }

struct Frame {
    LAS unsigned char* lds;
    volatile LAS unsigned* MISC;
    gu32* ctl;
    int tid, lane, wave, G, gw, NGW, bx, wave0;
    unsigned char* ws;
    const __attribute__((address_space(4))) unsigned char* kp;
    __device__ __forceinline__ const float* inp(int i) const { typedef const float* cfp; return *(const __attribute__((address_space(4))) cfp*)(kp + 8 * i); }
    __device__ __forceinline__ float* outp() const { typedef float* fp; return *(const __attribute__((address_space(4))) fp*)(kp + 272); }
};

namespace pg8 {
struct EpiSwiGLU {
    static constexpr bool PERM = true, AFTER_DRAIN = false;
    bf16_t* O; int ldc;
    __device__ __forceinline__ void operator()(const f32x4 (&acc)[2][2][4][2], const Unit& u, int wr, int wc, int fr, int fq) const {
        const int row0 = u.pm * BM + wr * 64 + fr, col0 = u.pn * HALF + wc * 32 + 8 * fq;
#pragma unroll
        for (int ai = 0; ai < 2; ++ai)
#pragma unroll
            for (int m = 0; m < 4; ++m) {
                bf16_t* rowp = O + (size_t)(row0 + ai * HALF + m * 16) * ldc + col0;
                const f32x4 g0 = acc[ai][0][m][0], g1 = acc[ai][0][m][1], u0 = acc[ai][1][m][0], u1 = acc[ai][1][m][1];
                u32x4 w;
                w.x = cvt_pk_bf16(silu_f(g0[0]) * u0[0], silu_f(g0[1]) * u0[1]); w.y = cvt_pk_bf16(silu_f(g0[2]) * u0[2], silu_f(g0[3]) * u0[3]);
                w.z = cvt_pk_bf16(silu_f(g1[0]) * u1[0], silu_f(g1[1]) * u1[1]); w.w = cvt_pk_bf16(silu_f(g1[2]) * u1[2], silu_f(g1[3]) * u1[3]);
                *(u32x4*)rowp = w;
            }
    }
};
struct MoeOrder {
    StaticOrder so; int tb[NEXP + 1]; int nN;
    __device__ __forceinline__ void init(const unsigned* cnt, int nN_, int G, int c) {
        tb[0] = 0;
#pragma unroll
        for (int e = 0; e < NEXP; ++e) tb[e + 1] = tb[e] + (int)((__builtin_amdgcn_readfirstlane(cnt[e]) + 255u) >> 8);
        nN = nN_; so.nM = tb[NEXP]; so.nN = nN_; so.nwg = so.nM * nN_; so.G = G; so.c = c; so.lim = so.nwg;
    }
    __device__ __forceinline__ void cut_tail() { const int tail = so.nwg % so.G; if (tail * 16 <= 2 * so.G) so.lim = so.nwg - tail; }
    __device__ __forceinline__ bool next(int i, Unit& u) const {
        if (!so.next(i, u)) return false;
        int e = 0;
#pragma unroll
        for (int k = 1; k < NEXP; ++k) e += (u.pm >= tb[k]) ? 1 : 0;
        u.pb = e * nN + u.pn; return true;
    }
    __device__ __forceinline__ bool at(long L, Unit& u) const {
        if (!so.at(L, u)) return false;
        int e = 0;
#pragma unroll
        for (int k = 1; k < NEXP; ++k) e += (u.pm >= tb[k]) ? 1 : 0;
        u.pb = e * nN + u.pn; return true;
    }
    __device__ __forceinline__ void a_ready(const Unit&) const {}
    __device__ __forceinline__ void done(const Unit&) const {}
};
struct PanelOrder {
    int nM, c;
    __device__ __forceinline__ void init(int M, int c_) { nM = M / BM; c = c_; }
    __device__ __forceinline__ bool next(int i, Unit& u) const { const int j = c >> 3, pm = i * 64 + (c & 7) * 8 + (j >> 2); if (pm >= nM) return false; u.pm = pm; u.pn = j & 3; u.pb = u.pn; return true; }
    __device__ __forceinline__ void a_ready(const Unit&) const {}
    __device__ __forceinline__ void done(const Unit&) const {}
};
struct EpiLnFused {
    static constexpr bool PERM = true, AFTER_DRAIN = false;
    bf16_t* X; const float* g; const float* b; unsigned long long* xbuf; unsigned* cnt; unsigned* tmo; PG8_LAS unsigned char* tl;
    __device__ __forceinline__ void operator()(f32x4 (&acc)[2][2][4][2], const Unit& u, int wr, int wc, int fr, int fq) const {
        typedef float f32x2v __attribute__((ext_vector_type(2)));
        const int wid = wr * 4 + wc, lane = fq * 16 + fr;
        PG8_LAS f32x2v* P = (PG8_LAS f32x2v*)tl;
        PG8_LAS f32x2v* S = (PG8_LAS f32x2v*)(tl + 8192);
        bf16_t* xb0 = X + (size_t)(u.pm * BM + wr * 64 + fr) * 1024 + u.pn * BM + wc * 32 + 8 * fq;
        {
            u32x4 xw[2][4][2];
#pragma unroll
            for (int ai = 0; ai < 2; ++ai)
#pragma unroll
                for (int m = 0; m < 4; ++m)
#pragma unroll
                    for (int bj = 0; bj < 2; ++bj) xw[ai][m][bj] = *(const u32x4*)(xb0 + (size_t)(ai * HALF + m * 16) * 1024 + bj * HALF);
#pragma unroll
            for (int ai = 0; ai < 2; ++ai)
#pragma unroll
                for (int m = 0; m < 4; ++m)
#pragma unroll
                    for (int bj = 0; bj < 2; ++bj) { const u32x4 w = xw[ai][m][bj];
                        acc[ai][bj][m][0] += (f32x4){bflo(w.x), bfhi(w.x), bflo(w.y), bfhi(w.y)} * ALPHA; acc[ai][bj][m][1] += (f32x4){bflo(w.z), bfhi(w.z), bflo(w.w), bfhi(w.w)} * ALPHA; }
            asm volatile("" ::: "memory");
        }
#pragma unroll
        for (int ai = 0; ai < 2; ++ai)
#pragma unroll
            for (int m = 0; m < 4; ++m) {
                float s = 0.f;
#pragma unroll
                for (int bj = 0; bj < 2; ++bj)
#pragma unroll
                    for (int n = 0; n < 2; ++n) { const f32x4 x = acc[ai][bj][m][n]; s += (x[0] + x[1]) + (x[2] + x[3]); }
                s += __int_as_float(__builtin_amdgcn_ds_bpermute((lane ^ 16) << 2, __float_as_int(s))); s += __int_as_float(__builtin_amdgcn_ds_bpermute((lane ^ 32) << 2, __float_as_int(s)));
                const float mw = s * (1.0f / 64.0f); float q = 0.f;
#pragma unroll
                for (int bj = 0; bj < 2; ++bj)
#pragma unroll
                    for (int n = 0; n < 2; ++n) { const f32x4 d = acc[ai][bj][m][n] - mw; q += (d[0] * d[0] + d[1] * d[1]) + (d[2] * d[2] + d[3] * d[3]); }
                q += __int_as_float(__builtin_amdgcn_ds_bpermute((lane ^ 16) << 2, __float_as_int(q))); q += __int_as_float(__builtin_amdgcn_ds_bpermute((lane ^ 32) << 2, __float_as_int(q)));
                if (fq == 0) P[(ai * HALF + wr * 64 + m * 16 + fr) * 4 + wc] = (f32x2v){mw, q};
            }
        asm volatile("s_waitcnt lgkmcnt(0)" ::: "memory"); __builtin_amdgcn_s_barrier(); asm volatile("" ::: "memory");
        const int row = wid * 32 + (lane & 31);
        if (lane < 32) {
            const f32x2v a = P[row * 4 + 0], b2 = P[row * 4 + 1], c2 = P[row * 4 + 2], d = P[row * 4 + 3];
            const float mt = (a.x + b2.x + c2.x + d.x) * 0.25f;
            const float da = a.x - mt, db = b2.x - mt, dc = c2.x - mt, dd = d.x - mt;
            const float m2 = (a.y + b2.y) + (c2.y + d.y) + 64.0f * ((da * da + db * db) + (dc * dc + dd * dd));
            unsigned long long* slot = xbuf + ((size_t)(u.pm * BM + row) * 4 + u.pn);
            __hip_atomic_store(slot, ((unsigned long long)__float_as_uint(m2) << 32) | __float_as_uint(mt), __ATOMIC_RELAXED, __HIP_MEMORY_SCOPE_AGENT);
        }
        asm volatile("s_waitcnt vmcnt(0)" ::: "memory");
        if (lane == 0) __hip_atomic_fetch_add(cnt + 64 * u.pm, 1u, __ATOMIC_RELAXED, __HIP_MEMORY_SCOPE_AGENT);
        if (wid == 0) {
            unsigned sp = 0u;
            while ((unsigned)__builtin_amdgcn_readfirstlane(__hip_atomic_load(cnt + 64 * u.pm, __ATOMIC_RELAXED, __HIP_MEMORY_SCOPE_AGENT)) < 32u) {
                __builtin_amdgcn_s_sleep(2);
                if (++sp > (1u << 17)) { if (lane == 0) __hip_atomic_store(tmo, 1u, __ATOMIC_RELAXED, __HIP_MEMORY_SCOPE_AGENT); break; }
            }
            __builtin_amdgcn_fence(__ATOMIC_ACQUIRE, "agent");
        }
        asm volatile("s_waitcnt vmcnt(0) lgkmcnt(0)" ::: "memory"); __builtin_amdgcn_s_barrier(); asm volatile("" ::: "memory");
        if (lane < 32) {
            const unsigned long long* slot = xbuf + (size_t)(u.pm * BM + row) * 4; float mt[4], m2[4]; float ms = 0.f;
#pragma unroll
            for (int t = 0; t < 4; ++t) { const unsigned long long w = __hip_atomic_load(slot + t, __ATOMIC_RELAXED, __HIP_MEMORY_SCOPE_AGENT); mt[t] = __uint_as_float((unsigned)w); m2[t] = __uint_as_float((unsigned)(w >> 32)); ms += mt[t]; }
            const float mean = ms * 0.25f; float q = 0.f;
#pragma unroll
            for (int t = 0; t < 4; ++t) { const float dm = mt[t] - mean; q += m2[t] + 256.0f * dm * dm; }
            S[row] = (f32x2v){mean, 1.0f / sqrtf(q * (1.0f / 1024.0f) + LN_EPS)};
        }
        asm volatile("s_waitcnt lgkmcnt(0)" ::: "memory"); __builtin_amdgcn_s_barrier(); asm volatile("" ::: "memory");
        const int colg = u.pn * BM + wc * 32 + 8 * fq;
        f32x4 gv[2][2], bv[2][2];
#pragma unroll
        for (int bj = 0; bj < 2; ++bj)
#pragma unroll
            for (int n = 0; n < 2; ++n) { gv[bj][n] = *(const f32x4*)(g + colg + bj * HALF + 4 * n); bv[bj][n] = *(const f32x4*)(b + colg + bj * HALF + 4 * n); }
#pragma unroll
        for (int ai = 0; ai < 2; ++ai)
#pragma unroll
            for (int m = 0; m < 4; ++m) { const f32x2v sr = S[ai * HALF + wr * 64 + m * 16 + fr];
#pragma unroll
                for (int bj = 0; bj < 2; ++bj) {
                    const f32x4 v0 = (acc[ai][bj][m][0] - sr.x) * sr.y * gv[bj][0] + bv[bj][0], v1 = (acc[ai][bj][m][1] - sr.x) * sr.y * gv[bj][1] + bv[bj][1];
                    u32x4 w; w.x = cvt_pk_bf16(v0[0], v0[1]); w.y = cvt_pk_bf16(v0[2], v0[3]); w.z = cvt_pk_bf16(v1[0], v1[1]); w.w = cvt_pk_bf16(v1[2], v1[3]);
                    *(u32x4*)(xb0 + (size_t)(ai * HALF + m * 16) * 1024 + bj * HALF) = w; } }
    }
};
}

__device__ __forceinline__ void cvt_item(const float* W, int K, int N, bf16* WT, int mode, int rowbase, int item, int nblk, int lane) {
    const int kb = item / nblk, nb = item - kb * nblk, k0 = 32 * kb, n = 64 * nb + lane;
    const bool ok = n < N;
    const float* src = W + (size_t)k0 * N + (ok ? n : 0);
    float v[32];
#pragma unroll
    for (int i = 0; i < 32; ++i) v[i] = __builtin_nontemporal_load(src + (size_t)i * N);
    const int row = (mode == 0) ? n : ((n >> 7) * 256 + (n & 127) + (mode == 2 ? 128 : 0));
    bf16* dst = WT + (size_t)(rowbase + row) * K + k0;
#pragma unroll
    for (int g = 0; g < 4; ++g) { v4u o;
        o.x = ok ? pk2(v[8 * g], v[8 * g + 1]) : 0u; o.y = ok ? pk2(v[8 * g + 2], v[8 * g + 3]) : 0u; o.z = ok ? pk2(v[8 * g + 4], v[8 * g + 5]) : 0u; o.w = ok ? pk2(v[8 * g + 6], v[8 * g + 7]) : 0u;
        *(GAS v4u*)(dst + 8 * g) = o; }
}
__device__ __forceinline__ void cvt_even(Frame& F, int j) {
    bf16* wb = (bf16*)(F.ws + WS_WB);
    const float* w_in = F.inp(1) + (size_t)j * D * EIN; const float* w_out = F.inp(10) + (size_t)j * D * D;
    const float* w_g = F.inp(13) + (size_t)j * D * FF; const float* w_u = F.inp(14) + (size_t)j * D * FF; const float* w_d = F.inp(15) + (size_t)j * FF * D;
    constexpr int I_IN = 32 * 44, I_OUT = 32 * 16, I_G = 32 * 44, I_D = 88 * 16, TOT = I_IN + I_OUT + 2 * I_G + I_D;
    for (int it = F.gw; it < TOT; it += F.NGW) {
        int r = it;
        if (r < I_IN) { cvt_item(w_in, D, EIN, wb + WB_WIN / 2, 0, 0, r, 44, F.lane); continue; } r -= I_IN;
        if (r < I_OUT) { cvt_item(w_out, D, D, wb + WB_WOUT / 2, 0, 0, r, 16, F.lane); continue; } r -= I_OUT;
        if (r < I_G) { cvt_item(w_g, D, FF, wb + WB_WGU / 2, 1, 0, r, 44, F.lane); continue; } r -= I_G;
        if (r < I_G) { cvt_item(w_u, D, FF, wb + WB_WGU / 2, 2, 0, r, 44, F.lane); continue; } r -= I_G;
        cvt_item(w_d, FF, D, wb + WB_WDN / 2, 0, 0, r, 16, F.lane);
    }
}
__device__ __forceinline__ void cvt_odd(Frame& F, int j) {
    bf16* wb = (bf16*)(F.ws + WS_WB);
    const float* w_qkv = F.inp(18) + (size_t)j * D * 3072; const float* w_out = F.inp(24) + (size_t)j * D * D;
    const float* w_g = F.inp(29) + (size_t)j * NEXP * D * FF; const float* w_u = F.inp(30) + (size_t)j * NEXP * D * FF; const float* w_d = F.inp(31) + (size_t)j * NEXP * FF * D;
    constexpr int I_QKV = 32 * 48, I_OUT = 32 * 16, I_E = 1408, TOT = I_QKV + I_OUT + 24 * I_E;
    for (int it = F.gw; it < TOT; it += F.NGW) {
        int r = it;
        if (r < I_QKV) { cvt_item(w_qkv, D, 3072, wb + WB_WQKV / 2, 0, 0, r, 48, F.lane); continue; } r -= I_QKV;
        if (r < I_OUT) { cvt_item(w_out, D, D, wb + WB_WOUT / 2, 0, 0, r, 16, F.lane); continue; } r -= I_OUT;
        const int mat = r / I_E, item = r - mat * I_E, kind = mat >> 3, e = mat & 7;
        if (kind == 0) cvt_item(w_g + (size_t)e * D * FF, D, FF, wb + WB_MGU / 2, 1, e * 5632, item, 44, F.lane);
        else if (kind == 1) cvt_item(w_u + (size_t)e * D * FF, D, FF, wb + WB_MGU / 2, 2, e * 5632, item, 44, F.lane);
        else cvt_item(w_d + (size_t)e * FF * D, FF, D, wb + WB_MDN / 2, 0, e * 1024, item, 16, F.lane);
    }
}
__device__ __forceinline__ void xb_from_x(Frame& F) {
    const float* x = F.inp(0); bf16* xb = (bf16*)(F.ws + WS_XB);
    for (int m = F.gw; m < M; m += F.NGW) {
        const GAS f32x4* xr = (const GAS f32x4*)(x + (size_t)m * D) + F.lane;
        GAS unsigned long long* o8 = (GAS unsigned long long*)(xb + (size_t)m * D) + F.lane;
#pragma unroll
        for (int j = 0; j < 4; ++j) { const f32x4 v = xr[64 * j]; o8[64 * j] = (unsigned long long)pk2(v.x, v.y) | ((unsigned long long)pk2(v.z, v.w) << 32); }
    }
}

template <int MODE, bool XBF>
__device__ __forceinline__ void ln_load(f32x4 (&v)[4], int m, int lane, const float* xin, const bf16* xb, const bf16* Hb, const int* r_p, const float* r_g) {
    f32x4 xv4[4];
    if (XBF) { const GAS unsigned long long* xr8 = (const GAS unsigned long long*)(xb + (size_t)m * D) + lane;
#pragma unroll
        for (int j = 0; j < 4; ++j) { const unsigned long long xw = xr8[64 * j]; const unsigned lo = (unsigned)xw, hi = (unsigned)(xw >> 32); xv4[j] = (f32x4){bflo(lo), bfhi(lo), bflo(hi), bfhi(hi)}; } }
    else { const GAS f32x4* xr = (const GAS f32x4*)(xin + (size_t)m * D) + lane;
#pragma unroll
        for (int j = 0; j < 4; ++j) xv4[j] = xr[64 * j]; }
    if (MODE == 0) {
        const GAS unsigned long long* hr = (const GAS unsigned long long*)(Hb + (size_t)m * D) + lane;
#pragma unroll
        for (int j = 0; j < 4; ++j) { const f32x4 xv = xv4[j]; const unsigned long long hw = hr[64 * j]; const unsigned lo = (unsigned)hw, hi = (unsigned)(hw >> 32);
            v[j].x = ALPHA * xv.x + bflo(lo); v[j].y = ALPHA * xv.y + bfhi(lo); v[j].z = ALPHA * xv.z + bflo(hi); v[j].w = ALPHA * xv.w + bfhi(hi); }
    } else {
        const int p0 = r_p[2 * m], p1 = r_p[2 * m + 1]; const float g0 = r_g[2 * m], g1 = r_g[2 * m + 1];
        const GAS unsigned long long* h0 = (const GAS unsigned long long*)(Hb + (size_t)p0 * D) + lane;
        const GAS unsigned long long* h1 = (const GAS unsigned long long*)(Hb + (size_t)p1 * D) + lane;
#pragma unroll
        for (int j = 0; j < 4; ++j) { const f32x4 xv = xv4[j]; const unsigned long long a = h0[64 * j], c = h1[64 * j];
            const unsigned al = (unsigned)a, ah = (unsigned)(a >> 32), cl = (unsigned)c, ch = (unsigned)(c >> 32);
            v[j].x = ALPHA * xv.x + (g0 * bflo(al) + g1 * bflo(cl)); v[j].y = ALPHA * xv.y + (g0 * bfhi(al) + g1 * bfhi(cl));
            v[j].z = ALPHA * xv.z + (g0 * bflo(ah) + g1 * bflo(ch)); v[j].w = ALPHA * xv.w + (g0 * bfhi(ah) + g1 * bfhi(ch)); }
    }
}
template <int MODE, bool ROUTER, bool XBF  , bool WRITE_F32>
__device__ __forceinline__ void ln_phase(Frame& F, const float* xin, const bf16* Hb, const float* g, const float* b, float* xout, bf16* xb,
                                         const float* rw, const float* rb, int lslot) {
    int* r_e = (int*)(F.ws + WS_ROUTE); float* r_g = (float*)(F.ws + WS_ROUTE + 256 * 1024); int* r_i = (int*)(F.ws + WS_ROUTE + 512 * 1024); int* r_p = (int*)(F.ws + WS_ROUTE + 768 * 1024);
    LAS float* wr = (LAS float*)F.lds;
    LAS int* lcnt = (LAS int*)(F.lds + 32768);
    LAS int* lrk = (LAS int*)(F.lds + 32768 + 64);
    LAS int* lex = (LAS int*)(F.lds + 32768 + 64 + 4096);
    LAS int* wbase = (LAS int*)(F.lds + 32768 + 32);
    const int r0 = (int)((long)F.bx * M / F.G), r1 = (int)((long)(F.bx + 1) * M / F.G);
    if (ROUTER) {
        for (int i = F.tid; i < D * NEXP; i += NTHR) wr[i] = rw[i];
        if (F.tid < 8) lcnt[F.tid] = 0;
        __syncthreads();
    }
    f32x4 gg[4], bb[4];
#pragma unroll
    for (int j = 0; j < 4; ++j) { gg[j] = *((const GAS f32x4*)g + F.lane + 64 * j); bb[j] = *((const GAS f32x4*)b + F.lane + 64 * j); }
    f32x4 v[4], vn[4];
    int m = r0 + F.wave;
    if (m < r1) ln_load<MODE, XBF>(v, m, F.lane, xin, xb, Hb, r_p, r_g);
    for (; m < r1; m += NWAVES) {
        const bool more = m + NWAVES < r1;
        if (more) ln_load<MODE, XBF>(vn, m + NWAVES, F.lane, xin, xb, Hb, r_p, r_g);
        float s = 0.f;
#pragma unroll
        for (int j = 0; j < 4; ++j) s += (v[j].x + v[j].y) + (v[j].z + v[j].w);
        const float mean = wave_sum_fd(s) * (1.f / D); float s2 = 0.f;
#pragma unroll
        for (int j = 0; j < 4; ++j) { v[j] = v[j] - mean; s2 += (v[j].x * v[j].x + v[j].y * v[j].y) + (v[j].z * v[j].z + v[j].w * v[j].w); }
        const float rstd = 1.f / sqrtf(wave_sum_fd(s2) * (1.f / D) + LN_EPS);
        GAS f32x4* xo = (GAS f32x4*)(xout + (size_t)m * D) + F.lane;
        GAS unsigned long long* o8 = (GAS unsigned long long*)(xb + (size_t)m * D) + F.lane;
#pragma unroll
        for (int j = 0; j < 4; ++j) {
            v[j] = v[j] * rstd * gg[j] + bb[j]; if (WRITE_F32) xo[64 * j] = v[j];
            else o8[64 * j] = (unsigned long long)pk2(v[j].x, v[j].y) | ((unsigned long long)pk2(v[j].z, v[j].w) << 32);
        }
        if (ROUTER) {
            float pl[NEXP];
#pragma unroll
            for (int e = 0; e < NEXP; ++e) pl[e] = 0.f;
#pragma unroll
            for (int j = 0; j < 4; ++j)
#pragma unroll
                for (int c = 0; c < 4; ++c) { const float xv = v[j][c]; const LAS f32x4* w4 = (const LAS f32x4*)(wr + (size_t)(4 * F.lane + 256 * j + c) * NEXP); const f32x4 wa = w4[0], wb = w4[1];
                    pl[0] += xv * wa.x; pl[1] += xv * wa.y; pl[2] += xv * wa.z; pl[3] += xv * wa.w; pl[4] += xv * wb.x; pl[5] += xv * wb.y; pl[6] += xv * wb.z; pl[7] += xv * wb.w; }
            float best0 = -INFINITY, best1 = -INFINITY; int e0 = 0, e1 = 0;
#pragma unroll
            for (int e = 0; e < NEXP; ++e) { const float l = wave_sum_fd(pl[e]) + rb[e];
                if (l > best0) { best1 = best0; e1 = e0; best0 = l; e0 = e; } else if (l > best1) { best1 = l; e1 = e; } }
            const float ex = __expf(best1 - best0), g0 = 1.f / (1.f + ex), g1 = ex / (1.f + ex);
            if (F.lane == 0) {
                lex[2 * (m - r0)] = e0; lex[2 * (m - r0) + 1] = e1;
                r_g[2 * m] = g0; r_g[2 * m + 1] = g1;
            }
        }
        if (more) {
#pragma unroll
            for (int j = 0; j < 4; ++j) v[j] = vn[j];
        }
    }
    if (ROUTER) {
        __syncthreads();
        const int nent = 2 * (r1 - r0);
        const int e = (F.tid < nent) ? lex[F.tid] : -1; int inr = 0;
#pragma unroll
        for (int k = 0; k < NEXP; ++k) {
            const unsigned long long mk = __ballot(e == k);
            const int below = (int)__builtin_amdgcn_mbcnt_hi((unsigned)(mk >> 32), __builtin_amdgcn_mbcnt_lo((unsigned)mk, 0u));
            inr = (e == k) ? below : inr;
            if (F.lane == 0) lrk[F.wave * NEXP + k] = (int)__builtin_popcountll(mk);
        }
        __syncthreads();
        if (F.tid < nent) { int base = 0;
#pragma unroll
            for (int w = 0; w < NWAVES; ++w) base += (w < F.wave) ? lrk[w * NEXP + e] : 0;
            r_e[2 * r0 + F.tid] = e; r_i[2 * r0 + F.tid] = base + inr; }
        if (F.tid < NEXP) { int t = 0;
#pragma unroll
            for (int w = 0; w < NWAVES; ++w) t += lrk[w * NEXP + F.tid];
            ((int*)(F.ws + WS_CNTT))[F.bx * NEXP + F.tid] = t; }
        __syncthreads();
    }
    (void)lcnt; (void)wbase; (void)lslot;
}

__device__ __forceinline__ void moe_map(Frame& F, int lslot) {
    const int* r_e = (const int*)(F.ws + WS_ROUTE); const int* r_i = (const int*)(F.ws + WS_ROUTE + 512 * 1024); int* r_p = (int*)(F.ws + WS_ROUTE + 768 * 1024);
    int* inv = (int*)(F.ws + WS_INV);
    LAS int* tab = (LAS int*)F.lds; LAS int* pre = (LAS int*)(F.lds + 8192); LAS int* tot = (LAS int*)(F.lds + 16384);
    { const int* cntt = (const int*)(F.ws + WS_CNTT); for (int i = F.tid; i < F.G * NEXP; i += NTHR) tab[i] = cntt[i]; }
    __syncthreads();
    { const int e = F.wave, l4 = 4 * F.lane;
        const int c0 = tab[(l4 + 0) * NEXP + e], c1 = tab[(l4 + 1) * NEXP + e], c2 = tab[(l4 + 2) * NEXP + e], c3 = tab[(l4 + 3) * NEXP + e];
        const int sm = (c0 + c1) + (c2 + c3), inc = wave_incl_scan_i(sm, F.lane), ex = inc - sm;
        pre[(l4 + 0) * NEXP + e] = ex; pre[(l4 + 1) * NEXP + e] = ex + c0; pre[(l4 + 2) * NEXP + e] = ex + c0 + c1; pre[(l4 + 3) * NEXP + e] = ex + c0 + c1 + c2;
        if (F.lane == 63) tot[e] = inc; }
    __syncthreads();
    int sb[NEXP + 1]; unsigned cn[NEXP]; { int a = 0;
#pragma unroll
        for (int e = 0; e < NEXP; ++e) { cn[e] = (unsigned)tot[e]; sb[e] = a; a += (int)((cn[e] + 255u) & ~255u); } sb[NEXP] = a; }
    if (F.bx == 0 && F.tid < NEXP) F.ctl[CW_CNT + 16 * lslot + F.tid] = (unsigned)tot[F.tid];
    const int gt = F.bx * NTHR + F.tid, NG = F.G * NTHR;
    for (int ent = gt; ent < 2 * M; ent += NG) {
        const int e = r_e[ent], idx = r_i[ent] + pre[(ent >> 8) * NEXP + e]; int base = 0;
#pragma unroll
        for (int k = 0; k < NEXP; ++k) base = (e == k) ? sb[k] : base;
        const int pos = base + idx; r_p[ent] = pos; inv[pos] = ent >> 1;
    }
    for (int p = gt; p < NEXP * 256; p += NG) { const int e = p >> 8, k = p & 255; int b0 = 0, b1 = 0; unsigned c = 0;
#pragma unroll
        for (int q = 0; q < NEXP; ++q) { if (e == q) { b0 = sb[q]; b1 = sb[q + 1]; c = cn[q]; } }
        const int pos = b0 + (int)c + k; if (pos < b1) inv[pos] = 0; }
    __syncthreads();
}

typedef float f32x4_t __attribute__((ext_vector_type(4)));
typedef short bf16x8_t __attribute__((ext_vector_type(8)));
typedef unsigned u32x4_t __attribute__((ext_vector_type(4)));
typedef float f32x16_t __attribute__((ext_vector_type(16)));
typedef unsigned u32x2_t __attribute__((ext_vector_type(2)));
constexpr int GLA_RT = 72;
__device__ __forceinline__ void gla_put_vt(LAS bf16* sVt, int tid, v4u w0, v4u w1) {
    const int t = tid & 63, ec = tid >> 6;
#pragma unroll
    for (int it = 0; it < 2; ++it) { const v4u w = it ? w1 : w0; LAS bf16* d = sVt + 8 * (ec + 8 * it) * GLA_RT + t;
        d[0 * GLA_RT] = (bf16)(w.x & 0xffffu); d[1 * GLA_RT] = (bf16)(w.x >> 16); d[2 * GLA_RT] = (bf16)(w.y & 0xffffu); d[3 * GLA_RT] = (bf16)(w.y >> 16);
        d[4 * GLA_RT] = (bf16)(w.z & 0xffffu); d[5 * GLA_RT] = (bf16)(w.z >> 16); d[6 * GLA_RT] = (bf16)(w.w & 0xffffu); d[7 * GLA_RT] = (bf16)(w.w >> 16); }
}
__device__ __forceinline__ void unpk8(v4u w, float* f) { f[0] = bflo(w.x); f[1] = bfhi(w.x); f[2] = bflo(w.y); f[3] = bfhi(w.y); f[4] = bflo(w.z); f[5] = bfhi(w.z); f[6] = bflo(w.w); f[7] = bfhi(w.w); }
__device__ __forceinline__ void dsa_prep(Frame& F, int j) {
    const bf16* P = (const bf16*)(F.ws + WS_P); bf16* KD = (bf16*)(F.ws + WS_KD); bf16* VD = (bf16*)(F.ws + WS_VD); bf16* KI = (bf16*)(F.ws + WS_KI);
    const float* kvg = F.inp(2) + j * 128; const float* wuk = F.inp(3) + (size_t)j * 128 * 64; const float* wuv = F.inp(4) + (size_t)j * 128 * 64;
    const float* kg = F.inp(5) + j * 64; const float* kb = F.inp(6) + j * 64;
    constexpr int WT_RS = 136;
    LAS bf16* sWt = (LAS bf16*)F.lds;
    for (int i = F.tid; i < 128 * 128; i += NTHR) {
        const int c = i >> 7, f = i & 127; const float w = (f < 64) ? wuk[c * 64 + f] * C2 : wuv[c * 64 + (f - 64)];
        sWt[f * WT_RS + c] = (bf16)f2bf(w * kvg[c]); }
    __syncthreads();
    const int lane = F.lane, t16 = lane & 15, quad = lane >> 4;
    bf16x8_t af[8][4];
#pragma unroll
    for (int ft = 0; ft < 8; ++ft)
#pragma unroll
        for (int ks = 0; ks < 4; ++ks) af[ft][ks] = *(const LAS bf16x8_t*)(sWt + (16 * ft + t16) * WT_RS + 32 * ks + 8 * quad);
    float kgl[16], kbl[16];
#pragma unroll
    for (int k = 0; k < 16; ++k) { kgl[k] = kg[16 * quad + k]; kbl[k] = kb[16 * quad + k]; }
    for (int m0 = F.gw * 16; m0 < M; m0 += F.NGW * 16) {
        const bf16* pr = P + (size_t)(m0 + t16) * EINP;
        bf16x8_t cf[4]; float ss = 0.f;
#pragma unroll
        for (int ks = 0; ks < 4; ++ks) { const v4u w = *(const v4u*)(pr + PC_CKV + 32 * ks + 8 * quad); cf[ks] = __builtin_bit_cast(bf16x8_t, w);
            float f8[8]; unpk8(w, f8);
#pragma unroll
            for (int k = 0; k < 8; ++k) ss += f8[k] * f8[k]; }
        ss += __int_as_float(__builtin_amdgcn_ds_bpermute((lane ^ 16) << 2, __float_as_int(ss))); ss += __int_as_float(__builtin_amdgcn_ds_bpermute((lane ^ 32) << 2, __float_as_int(ss)));
        const float rs = 1.f / sqrtf(ss * (1.f / 128.f) + RMS_EPS);
#pragma unroll
        for (int ft = 0; ft < 8; ++ft) {
            f32x4_t c = {0.f, 0.f, 0.f, 0.f};
#pragma unroll
            for (int ks = 0; ks < 4; ++ks) c = __builtin_amdgcn_mfma_f32_16x16x32_bf16(af[ft][ks], cf[ks], c, 0, 0, 0);
            u32x2_t o; o.x = pk2(c[0] * rs, c[1] * rs); o.y = pk2(c[2] * rs, c[3] * rs);
            bf16* dst = (ft < 4 ? KD : VD) + (size_t)(m0 + t16) * 64 + 16 * (ft & 3) + 4 * quad;
            *(u32x2_t*)dst = o;
        }
        {
            float x[16]; const v4u w0 = *(const v4u*)(pr + PC_KI + 16 * quad), w1 = *(const v4u*)(pr + PC_KI + 16 * quad + 8); unpk8(w0, x); unpk8(w1, x + 8);
            float s = 0.f;
#pragma unroll
            for (int k = 0; k < 16; ++k) s += x[k];
            s += __int_as_float(__builtin_amdgcn_ds_bpermute((lane ^ 16) << 2, __float_as_int(s))); s += __int_as_float(__builtin_amdgcn_ds_bpermute((lane ^ 32) << 2, __float_as_int(s)));
            const float mean = s * (1.f / 64.f); float q = 0.f;
#pragma unroll
            for (int k = 0; k < 16; ++k) { x[k] -= mean; q += x[k] * x[k]; }
            q += __int_as_float(__builtin_amdgcn_ds_bpermute((lane ^ 16) << 2, __float_as_int(q))); q += __int_as_float(__builtin_amdgcn_ds_bpermute((lane ^ 32) << 2, __float_as_int(q)));
            const float rstd = 1.f / sqrtf(q * (1.f / 64.f) + LN_EPS);
            v4u o0, o1;
            o0.x = pk2(x[0] * rstd * kgl[0] + kbl[0], x[1] * rstd * kgl[1] + kbl[1]); o0.y = pk2(x[2] * rstd * kgl[2] + kbl[2], x[3] * rstd * kgl[3] + kbl[3]);
            o0.z = pk2(x[4] * rstd * kgl[4] + kbl[4], x[5] * rstd * kgl[5] + kbl[5]); o0.w = pk2(x[6] * rstd * kgl[6] + kbl[6], x[7] * rstd * kgl[7] + kbl[7]);
            o1.x = pk2(x[8] * rstd * kgl[8] + kbl[8], x[9] * rstd * kgl[9] + kbl[9]); o1.y = pk2(x[10] * rstd * kgl[10] + kbl[10], x[11] * rstd * kgl[11] + kbl[11]);
            o1.z = pk2(x[12] * rstd * kgl[12] + kbl[12], x[13] * rstd * kgl[13] + kbl[13]); o1.w = pk2(x[14] * rstd * kgl[14] + kbl[14], x[15] * rstd * kgl[15] + kbl[15]);
            bf16* kd = KI + (size_t)(m0 + t16) * 64 + 16 * quad; *(v4u*)kd = o0; *(v4u*)(kd + 8) = o1;
        }
    }
    __syncthreads();
}

struct GlaPrepIn { v4u v0, v1, g0, g1, q, k; };
__device__ __forceinline__ GlaPrepIn gla_prep_load(const bf16* P, int unit, int tid) {
    const int h = unit & 3, tok0 = (unit >> 2) * 64; GlaPrepIn r;
    { const int t = tid & 63, ec = tid >> 6; const bf16* p = P + (size_t)(tok0 + t) * EINP + PC_BV + h * 128 + 8 * ec; r.v0 = *(const v4u*)p; r.v1 = *(const v4u*)(p + 64); }
    { const int t = tid >> 3, dg = tid & 7; const bf16* p = P + (size_t)(tok0 + t) * EINP;
      r.g0 = *(const v4u*)(p + PC_BG); r.g1 = *(const v4u*)(p + PC_BG + 8); r.q = *(const v4u*)(p + PC_BQ + h * 64 + 8 * dg); r.k = *(const v4u*)(p + PC_BK + h * 64 + 8 * dg); }
    return r;
}
__device__ __forceinline__ void gla_prep(Frame& F, int j) {
    const bf16* P = (const bf16*)(F.ws + WS_P); bf16* QT = (bf16*)(F.ws + WS_QT); bf16* KT = (bf16*)(F.ws + WS_KT);
    float* EBL = (float*)(F.ws + WS_EBL); float* GST = (float*)(F.ws + WS_GST);
    const float* wg2 = F.inp(7) + (size_t)j * 16 * 256; const float* bgb = F.inp(8) + j * 256;
    LAS float* sG = (LAS float*)F.lds;
    LAS float* sSeg = sG + 4096;
    LAS bf16* sKHt = (LAS bf16*)(F.lds + 18432);
    LAS bf16* sVt = (LAS bf16*)(F.lds + 27648);
    LAS float* sW = (LAS float*)(F.lds + 46080);
    const int tid = F.tid, lane = F.lane, hi = lane >> 5, r32 = lane & 31;
    const int NU = BATCH * 32 * 4;
    int hw = -1;
    GlaPrepIn cur; if (F.bx < NU) cur = gla_prep_load(P, F.bx, tid);
    for (int unit = F.bx; unit < NU; unit += F.G) {
        const int h = unit & 3, bc = unit >> 2, tok0 = bc * 64;
        GlaPrepIn nxt = cur; if (unit + F.G < NU) nxt = gla_prep_load(P, unit + F.G, tid);
        if (h != hw) { for (int i = tid; i < 1024; i += NTHR) sW[i] = wg2[(i >> 6) * 256 + h * 64 + (i & 63)]; if (tid < 64) sW[1024 + tid] = bgb[h * 64 + tid]; hw = h; }
        gla_put_vt(sVt, tid, cur.v0, cur.v1);
        LDS_BAR();
        const int t8 = tid >> 3, dg = tid & 7;
        {
            float bg[16]; unpk8(cur.g0, bg); unpk8(cur.g1, bg + 8);
#pragma unroll
            for (int k = 0; k < 8; ++k) { const int d = 8 * dg + k; float z = sW[1024 + d];
#pragma unroll
                for (int r = 0; r < 16; ++r) z += bg[r] * sW[r * 64 + d];
                sG[t8 * 64 + d] = (fminf(z, 0.f) - __logf(1.f + __expf(-fabsf(z)))) * (1.f / 16.f); }
        }
        LDS_BAR();
        {
            const int d = tid & 63, seg = tid >> 6; float pre[8], run = 0.f;
#pragma unroll
            for (int k = 0; k < 8; ++k) { run += sG[(8 * seg + k) * 64 + d]; pre[k] = run; }
            sSeg[seg * 64 + d] = run;
            LDS_BAR();
            float off = 0.f;
#pragma unroll
            for (int s2 = 0; s2 < 7; ++s2) off += (s2 < seg) ? sSeg[s2 * 64 + d] : 0.f;
#pragma unroll
            for (int k = 0; k < 8; ++k) sG[(8 * seg + k) * 64 + d] = off + pre[k];
        }
        LDS_BAR();
        {
            float q[8], kk[8]; unpk8(cur.q, q); unpk8(cur.k, kk);
            const f32x4 b0 = *(const LAS f32x4*)(sG + t8 * 64 + 8 * dg), b1 = *(const LAS f32x4*)(sG + t8 * 64 + 8 * dg + 4);
            const f32x4 l0 = *(const LAS f32x4*)(sG + 63 * 64 + 8 * dg), l1 = *(const LAS f32x4*)(sG + 63 * 64 + 8 * dg + 4);
            const float bb[8] = {b0.x, b0.y, b0.z, b0.w, b1.x, b1.y, b1.z, b1.w}, bl[8] = {l0.x, l0.y, l0.z, l0.w, l1.x, l1.y, l1.z, l1.w};
            float qo[8], ko[8];
#pragma unroll
            for (int k = 0; k < 8; ++k) { qo[k] = q[k] * 0.125f * __expf(bb[k]); ko[k] = kk[k] * __expf(-bb[k]); sKHt[(8 * dg + k) * GLA_RT + t8] = (bf16)f2bf(kk[k] * __expf(bl[k] - bb[k])); }
            v4u wq, wk; wq.x = pk2(qo[0], qo[1]); wq.y = pk2(qo[2], qo[3]); wq.z = pk2(qo[4], qo[5]); wq.w = pk2(qo[6], qo[7]); wk.x = pk2(ko[0], ko[1]); wk.y = pk2(ko[2], ko[3]); wk.z = pk2(ko[4], ko[5]); wk.w = pk2(ko[6], ko[7]);
            { const size_t fo = (size_t)unit * 4096 + (size_t)((((t8 >> 5) * 4 + (dg >> 1)) * 64 + (t8 & 31) + 32 * (dg & 1)) * 8);
              *(v4u*)(QT + fo) = wq; *(v4u*)(KT + fo) = wk; }
            if (t8 == 63) {
#pragma unroll
                for (int k = 0; k < 8; ++k) EBL[(size_t)bc * 256 + h * 64 + 8 * dg + k] = __expf(bl[k]); }
        }
        LDS_BAR();
        {
            const int db = F.wave >> 2, eb = F.wave & 3; f32x16_t acc = {};
#pragma unroll
            for (int ks = 0; ks < 4; ++ks) {
                const bf16x8_t a = *(const LAS bf16x8_t*)(sKHt + (32 * db + r32) * GLA_RT + 16 * ks + 8 * hi);
                const bf16x8_t bfr = *(const LAS bf16x8_t*)(sVt + (32 * eb + r32) * GLA_RT + 16 * ks + 8 * hi);
                acc = __builtin_amdgcn_mfma_f32_32x32x16_bf16(a, bfr, acc, 0, 0, 0); }
            float* g = GST + (size_t)unit * 8192 + 4 * hi;
#pragma unroll
            for (int rg = 0; rg < 4; ++rg) *(f32x4_t*)(g + (((eb * 4 + 2 * db + (rg >> 1)) * 64 + r32 + 32 * (rg & 1)) * 8)) = (f32x4_t){acc[4 * rg], acc[4 * rg + 1], acc[4 * rg + 2], acc[4 * rg + 3]};
        }
        LDS_BAR();
        cur = nxt;
    }
}
__device__ __forceinline__ void gla_scan(Frame& F) {
    float* GST = (float*)(F.ws + WS_GST); const float* EBL = (const float*)(F.ws + WS_EBL);
    const int gt = F.bx * NTHR + F.tid, NG = F.G * NTHR;
    for (int idx = gt; idx < BATCH * 4 * 8192; idx += NG) {
        const int de = idx & 8191, h = (idx >> 13) & 3, b = idx >> 15, d = 16 * ((de >> 9) & 3) + 8 * ((de >> 8) & 1) + (de & 7);
        float S = 0.f;
#pragma unroll 8
        for (int c = 0; c < 32; ++c) { const size_t off = (size_t)(((b * 32 + c) << 2) + h) * 8192 + de; const float a = GST[off]; GST[off] = S; S = EBL[(size_t)(b * 32 + c) * 256 + h * 64 + d] * S + a; }
    }
}
struct GlaOutIn { v4u v0, v1; bf16x8_t qf[4], kf[2][4]; f32x4_t st[8]; unsigned rw[8]; };
__device__ __forceinline__ GlaOutIn gla_out_load(const bf16* P, const bf16* QT, const bf16* KT, const float* GST, int unit, int tid, int wave, int lane) {
    const int h = unit & 3, tok0 = (unit >> 2) * 64, hi = lane >> 5, r32 = lane & 31, ib = wave & 1, eb = wave >> 1; GlaOutIn r;
    { const int t = tid & 63, ec = tid >> 6; const bf16* p = P + (size_t)(tok0 + t) * EINP + PC_BV + h * 128 + 8 * ec; r.v0 = *(const v4u*)p; r.v1 = *(const v4u*)(p + 64); }
#pragma unroll
    for (int ks = 0; ks < 4; ++ks) { r.qf[ks] = *(const bf16x8_t*)(QT + (size_t)unit * 4096 + ((ib * 4 + ks) * 64 + lane) * 8);
        r.kf[0][ks] = *(const bf16x8_t*)(KT + (size_t)unit * 4096 + ((0 * 4 + ks) * 64 + lane) * 8);
        r.kf[1][ks] = *(const bf16x8_t*)(KT + (size_t)unit * 4096 + ((1 * 4 + ks) * 64 + lane) * 8); }
    const float* sr = GST + (size_t)unit * 8192;
#pragma unroll
    for (int ks = 0; ks < 4; ++ks) { r.st[2 * ks] = *(const f32x4_t*)(sr + ((eb * 4 + ks) * 64 + lane) * 8); r.st[2 * ks + 1] = *(const f32x4_t*)(sr + ((eb * 4 + ks) * 64 + lane) * 8 + 4); }
#pragma unroll
    for (int i = 0; i < 8; ++i) r.rw[i] = *(const unsigned*)(P + (size_t)(tok0 + wave + 8 * i) * EINP + PC_BR + h * 128 + 2 * lane);
    return r;
}
__device__ __forceinline__ void gla_out(Frame& F, int j) {
    const bf16* P = (const bf16*)(F.ws + WS_P); const bf16* QT = (const bf16*)(F.ws + WS_QT); const bf16* KT = (const bf16*)(F.ws + WS_KT);
    const float* GST = (const float*)(F.ws + WS_GST); bf16* MIX = (bf16*)(F.ws + WS_MIX); const float* ng = F.inp(9) + j * 512;
    LAS bf16* sVt = (LAS bf16*)F.lds;
    LAS float* sO = (LAS float*)(F.lds + 18432);
    const int tid = F.tid, lane = F.lane, hi = lane >> 5, r32 = lane & 31;
    const int ib = F.wave & 1, eb = F.wave >> 1;
    const int NU = BATCH * 32 * 4;
    GlaOutIn cur; if (F.bx < NU) cur = gla_out_load(P, QT, KT, GST, F.bx, tid, F.wave, lane);
    for (int unit = F.bx; unit < NU; unit += F.G) {
        const int h = unit & 3, bc = unit >> 2, tok0 = bc * 64;
        GlaOutIn nxt = cur; if (unit + F.G < NU) nxt = gla_out_load(P, QT, KT, GST, unit + F.G, tid, F.wave, lane);
        gla_put_vt(sVt, tid, cur.v0, cur.v1);
        LDS_BAR();
        f32x16_t acc = {};
#pragma unroll
        for (int jb = 0; jb < 2; ++jb) {
            if (jb <= ib) {
                f32x16_t X = {};
#pragma unroll
                for (int ks = 0; ks < 4; ++ks) X = __builtin_amdgcn_mfma_f32_32x32x16_bf16(cur.kf[jb][ks], cur.qf[ks], X, 0, 0, 0);
                if (jb == ib) {
#pragma unroll
                    for (int r = 0; r < 16; ++r) { const int jr = (r & 3) + 8 * (r >> 2) + 4 * hi; if (jr > r32) X[r] = 0.f; }
                }
#pragma unroll
                for (int s2 = 0; s2 < 2; ++s2) {
                    u32x4_t xw; xw.x = pk2(X[8 * s2], X[8 * s2 + 1]); xw.y = pk2(X[8 * s2 + 2], X[8 * s2 + 3]); xw.z = pk2(X[8 * s2 + 4], X[8 * s2 + 5]); xw.w = pk2(X[8 * s2 + 6], X[8 * s2 + 7]);
                    const LAS bf16* vr = sVt + (32 * eb + r32) * GLA_RT + 32 * jb + 16 * s2 + 4 * hi;
                    const u32x2_t a0 = *(const LAS u32x2_t*)vr, a1 = *(const LAS u32x2_t*)(vr + 8);
                    u32x4_t aw; aw.x = a0.x; aw.y = a0.y; aw.z = a1.x; aw.w = a1.y;
                    acc = __builtin_amdgcn_mfma_f32_32x32x16_bf16(__builtin_bit_cast(bf16x8_t, aw), __builtin_bit_cast(bf16x8_t, xw), acc, 0, 0, 0);
                }
            }
        }
#pragma unroll
        for (int ks = 0; ks < 4; ++ks) { const f32x4_t s0 = cur.st[2 * ks], s1 = cur.st[2 * ks + 1];
            u32x4_t aw; aw.x = pk2(s0[0], s0[1]); aw.y = pk2(s0[2], s0[3]); aw.z = pk2(s1[0], s1[1]); aw.w = pk2(s1[2], s1[3]);
            acc = __builtin_amdgcn_mfma_f32_32x32x16_bf16(__builtin_bit_cast(bf16x8_t, aw), cur.qf[ks], acc, 0, 0, 0); }
#pragma unroll
        for (int r = 0; r < 16; ++r) sO[(32 * ib + r32) * 129 + 32 * eb + (r & 3) + 8 * (r >> 2) + 4 * hi] = acc[r];
        LDS_BAR();
        const float n0 = ng[h * 128 + 2 * lane], n1 = ng[h * 128 + 2 * lane + 1];
#pragma unroll
        for (int i8 = 0; i8 < 8; ++i8) { const int i = F.wave + 8 * i8;
            const float o0 = sO[i * 129 + 2 * lane], o1 = sO[i * 129 + 2 * lane + 1];
            const float rs = 1.f / sqrtf(wave_sum(o0 * o0 + o1 * o1) * (1.f / 128.f) + RMS_EPS);
            const unsigned rw = cur.rw[i8];
            *(unsigned*)(MIX + (size_t)(tok0 + i) * D + 512 + h * 128 + 2 * lane) = pk2(o0 * rs * n0 * silu_f(bflo(rw)), o1 * rs * n1 * silu_f(bfhi(rw)));
        }
        LDS_BAR();
        cur = nxt;
    }
}

__device__ __forceinline__ int wave_sum_dpp(int v) {
    v += __builtin_amdgcn_mov_dpp(v, 0xB1, 0xF, 0xF, true);
    v += __builtin_amdgcn_mov_dpp(v, 0x4E, 0xF, 0xF, true);
    v += __builtin_amdgcn_mov_dpp(v, 0x141, 0xF, 0xF, true);
    v += __builtin_amdgcn_mov_dpp(v, 0x140, 0xF, 0xF, true);
    v += __builtin_amdgcn_update_dpp(0, v, 0x142, 0xA, 0xF, false);
    v += __builtin_amdgcn_update_dpp(0, v, 0x143, 0xC, 0xF, false);
    return __builtin_amdgcn_readlane(v, 63);
}
__device__ __forceinline__ unsigned mono_key(float f) { const unsigned u = __float_as_uint(f); return (u & 0x80000000u) ? ~u : (u | 0x80000000u); }
__device__ __forceinline__ float relu1(float x) { const int b = __float_as_int(x); return __int_as_float(b > 0 ? b : 0); }
__device__ __forceinline__ void dsa_index(Frame& F) {
    const bf16* P = (const bf16*)(F.ws + WS_P); const bf16* KI = (const bf16*)(F.ws + WS_KI);
    unsigned* MASK = (unsigned*)(F.ws + WS_MASK);
    LAS unsigned char* scl = F.lds;
    const int nu = 2 * ((BATCH * 64 - F.bx + F.G - 1) / F.G);
#define IDX_UNIT(u, b_, blk_) do { const int v_ = F.bx + ((u) >> 1) * F.G; b_ = (v_ >> 6) & 15; const int s_ = ((v_ & 63) + 16 * (v_ >> 8)) & 63; blk_ = ((u) & 1) ? 127 - s_ : s_; } while (0)
#define IDX_QLOAD(b_, blk_) do { int ln_ = F.lane; asm volatile("" : "+v"(ln_)); const bf16* qr_ = P + (size_t)((b_) * SEQ + (blk_) * 16 + (ln_ & 15)) * EINP; \
        _Pragma("unroll") for (int h = 0; h < 8; ++h) { qfn[h][0] = *(const bf16x8_t*)(qr_ + PC_QI + h * 64 + 8 * (ln_ >> 4)); qfn[h][1] = *(const bf16x8_t*)(qr_ + PC_QI + h * 64 + 32 + 8 * (ln_ >> 4)); } \
        wnq = *(const v4u*)(qr_ + PC_WI); } while (0)
    bf16x8_t qfn[8][2]; v4u wnq = (v4u){0u, 0u, 0u, 0u};
    { int b0_, blk0_; IDX_UNIT(0, b0_, blk0_); if (blk0_ > 15) IDX_QLOAD(b0_, blk0_); }
#pragma unroll 1
    for (int u = 0; u < nu; ++u) {
        {
            int b, blk; IDX_UNIT(u, b, blk);
            const int q0 = blk * 16, ntk = (q0 >> 6) + 1;
            if (blk > 15) {
                int lane = F.lane; asm volatile("" : "+v"(lane)); const int c16 = lane & 15, quad = lane >> 4;
                bf16x8_t qf[8][2]; float w[8];
#pragma unroll
                for (int h = 0; h < 8; ++h) { qf[h][0] = qfn[h][0]; qf[h][1] = qfn[h][1]; }
                { float f[8]; unpk8(wnq, f);
#pragma unroll
                    for (int h = 0; h < 8; ++h) w[h] = f[h]; }
                const bf16* kbase = KI + (size_t)(b * SEQ + c16) * 64 + 8 * quad;
                LAS unsigned char* wrow = scl + c16 * 8192;
                const int nit = 4 * ntk;
                bf16x8_t afq[4][2];
#pragma unroll
                for (int j = 0; j < 4; ++j) { const int itj = F.wave + NWAVES * j;
                    if (itj < nit) { afq[j][0] = *(const bf16x8_t*)(kbase + (size_t)(16 * itj) * 64); afq[j][1] = *(const bf16x8_t*)(kbase + (size_t)(16 * itj) * 64 + 32); } }
#pragma unroll 1
                for (int base = F.wave; base < nit; base += 4 * NWAVES) {
#pragma unroll
                    for (int j = 0; j < 4; ++j) { const int it = base + NWAVES * j;
                        if (it < nit) {
                            const bf16x8_t af0 = afq[j][0], af1 = afq[j][1];
                            if (it + 4 * NWAVES < nit) { afq[j][0] = *(const bf16x8_t*)(kbase + (size_t)(16 * (it + 4 * NWAVES)) * 64); afq[j][1] = *(const bf16x8_t*)(kbase + (size_t)(16 * (it + 4 * NWAVES)) * 64 + 32); }
                            f32x4_t sc = {0.f, 0.f, 0.f, 0.f};
#pragma unroll
                            for (int h = 0; h < 8; ++h) {
                                f32x4_t c = {0.f, 0.f, 0.f, 0.f};
                                c = __builtin_amdgcn_mfma_f32_16x16x32_bf16(af0, qf[h][0], c, 0, 0, 0);
                                c = __builtin_amdgcn_mfma_f32_16x16x32_bf16(af1, qf[h][1], c, 0, 0, 0);
                                sc[0] += w[h] * relu1(c[0]); sc[1] += w[h] * relu1(c[1]); sc[2] += w[h] * relu1(c[2]); sc[3] += w[h] * relu1(c[3]);
                            }
                            const int ch = 4 * it + quad;
                            *(LAS f32x4_t*)(wrow + ((ch & ~15) | ((ch ^ (ch >> 4) ^ c16) & 15)) * 16) = sc;
                        }
                    }
                }
            }
            if (u + 1 < nu) { int b2_, blk2_; IDX_UNIT(u + 1, b2_, blk2_); if (blk2_ > 15) IDX_QLOAD(b2_, blk2_); }
            LDS_BAR();
            int lane = F.lane; asm volatile("" : "+v"(lane));
            {
                const int ra = 2 * F.wave, ia = q0 + ra, ib = ia + 1;
                unsigned ma, mb;
                if (ib < TOPK) {
                    const int na = ia - 32 * lane + 1, nb = ib - 32 * lane + 1;
                    ma = na <= 0 ? 0u : (na >= 32 ? 0xffffffffu : ((1u << na) - 1u)); mb = nb <= 0 ? 0u : (nb >= 32 ? 0xffffffffu : ((1u << nb) - 1u));
                } else {
                    unsigned ua[32], ub[32];
#pragma unroll
                    for (int k = 0; k < 8; ++k) { const int ch = 8 * lane + k;
                        const f32x4_t xa = *(const LAS f32x4_t*)(scl + ra * 8192 + ((ch & ~15) | ((ch ^ (ch >> 4) ^ ra) & 15)) * 16);
                        const f32x4_t xb = *(const LAS f32x4_t*)(scl + (ra + 1) * 8192 + ((ch & ~15) | ((ch ^ (ch >> 4) ^ (ra + 1)) & 15)) * 16);
#pragma unroll
                        for (int e = 0; e < 4; ++e) { ua[4 * k + e] = __float_as_uint(xa[e]); ub[4 * k + e] = __float_as_uint(xb[e]); } }
#pragma unroll
                    for (int st = 0; st < 5; ++st) { const int j = 16 >> st; const unsigned m = (st == 0) ? 0x0000FFFFu : (st == 1) ? 0x00FF00FFu : (st == 2) ? 0x0F0F0F0Fu : (st == 3) ? 0x33333333u : 0x55555555u;
#pragma unroll
                        for (int k = 0; k < 32; ++k) if ((k & j) == 0) {
                            { const unsigned hi = ua[k], lo = ua[k + j]; ua[k + j] = (lo & ~m) | ((hi >> j) & m); ua[k] = (hi & ~(m << j)) | ((lo << j) & (m << j)); }
                            { const unsigned hi = ub[k], lo = ub[k + j]; ub[k + j] = (lo & ~m) | ((hi >> j) & m); ub[k] = (hi & ~(m << j)) | ((lo << j) & (m << j)); } }
                        __builtin_amdgcn_sched_barrier(0); }
                    const int nva = ia - 32 * lane + 1, nvb = ib - 32 * lane + 1;
                    unsigned Ga = 0u, Ea = nva <= 0 ? 0u : (nva >= 32 ? 0xffffffffu : ((1u << nva) - 1u)), Gb = 0u, Eb = nvb <= 0 ? 0u : (nvb >= 32 ? 0xffffffffu : ((1u << nvb) - 1u));
                    const unsigned sa = ua[31], sb = ub[31];
#pragma unroll
                    for (int bit = 17; bit >= 0; --bit) {
                        const unsigned pa_ = (bit == 17) ? ~sa : (ua[14 + bit] ^ sa), pb_ = (bit == 17) ? ~sb : (ub[14 + bit] ^ sb);
                        const unsigned ca = Ea & pa_, cb = Eb & pb_;
                        const int tot = wave_sum_dpp(__builtin_popcount(Ga | ca) + (__builtin_popcount(Gb | cb) << 16));
                        if ((tot & 0xffff) >= TOPK) Ea = ca; else { Ga |= ca; Ea ^= ca; }
                        if ((tot >> 16) >= TOPK) Eb = cb; else { Gb |= cb; Eb ^= cb; }
                    }
                    const int ea = __builtin_popcount(Ea), eb = __builtin_popcount(Eb);
                    const int totg = wave_sum_dpp(__builtin_popcount(Ga) + (__builtin_popcount(Gb) << 16));
                    const int tiet = wave_sum_dpp(ea + (eb << 16));
                    const int needa = TOPK - (totg & 0xffff), needb = TOPK - (totg >> 16);
                    if (needa == (tiet & 0xffff) && needb == (tiet >> 16)) { ma = Ga | Ea; mb = Gb | Eb; }
                    else {
                        int pa = wave_incl_scan_i(ea, lane) - ea, pb2 = wave_incl_scan_i(eb, lane) - eb; ma = Ga; mb = Gb;
#pragma unroll
                        for (int r = 0; r < 32; ++r) {
                            const unsigned ba = (Ea >> r) & 1u, bb = (Eb >> r) & 1u;
                            ma |= (ba & (pa < needa ? 1u : 0u)) << r; pa += (int)ba;
                            mb |= (bb & (pb2 < needb ? 1u : 0u)) << r; pb2 += (int)bb;
                        }
                    }
                }
                MASK[(size_t)(b * SEQ + ia) * 64 + lane] = ma; MASK[(size_t)(b * SEQ + ib) * 64 + lane] = mb;
            }
            LDS_BAR();
        }
    }
#undef IDX_UNIT
#undef IDX_QLOAD
}

typedef float f32x16_d __attribute__((ext_vector_type(16)));
typedef short v4i16_d __attribute__((ext_vector_type(4)));
constexpr int DT_RSK = 72, DT_RSV = 160;
constexpr int DT_BUF = 64 * DT_RSK * 2 + 64 * DT_RSV * 2;
__device__ __forceinline__ void frame_refresh(Frame& F);
__device__ __forceinline__ void diff_attn_t(Frame& F, unsigned char* ldsg, int j, const float lam_init) {
    const bf16* QKV = (const bf16*)(F.ws + WS_QKV); bf16* MIXO = (bf16*)(F.ws + WS_MIXO);
    LAS unsigned char* lds = F.lds;
    LAS unsigned* sO0 = (LAS unsigned*)(lds + 2 * DT_BUF) + F.wave * 2048;
    LAS float* sG = (LAS float*)(lds + 2 * DT_BUF + 65536);
    const int wave = F.wave;
    float lam;
    { const int tid = F.tid, lane = F.lane;
    if (tid < 128) sG[tid] = F.inp(23)[j * 128 + tid] * (1.f - lam_init);
    { const float a = wave_sum_l(F.inp(19)[j * 64 + lane] * F.inp(20)[j * 64 + lane], lane), c = wave_sum_l(F.inp(21)[j * 64 + lane] * F.inp(22)[j * 64 + lane], lane); lam = __expf(a) - __expf(c) + lam_init; } }
    __syncthreads();
    const int vcu = (F.G % 8 == 0) ? (F.bx % 8) * (F.G / 8) + F.bx / 8 : F.bx;
    for (int v = vcu; v < BATCH * 8 * 2; v += F.G) {
        const int bh = v >> 1, p = v & 1, b = bh >> 3, h = bh & 7;
#pragma unroll 1
        for (int qi = 0; qi < 4; ++qi) {
            const int qb = (qi == 0) ? p : (qi == 1) ? 7 - p : (qi == 2) ? 2 + p : 5 - p;
            const int lane = hw_lane(), tid = wave * 64 + lane, r32 = lane & 31, hi = lane >> 5;
            const int krow = tid >> 3, kch = tid & 7, vrow = tid >> 4, vch = tid & 15;
            const int vtr = (4 * hi + ((lane & 15) >> 2)) * (DT_RSV * 2) + ((lane >> 4) & 1) * 32 + (lane & 3) * 8;
            const int nt = 4 * (qb + 1), qpos = 256 * qb + 32 * wave + r32, wmin = 256 * qb + 32 * wave;
            const size_t tokq = (size_t)b * SEQ + qpos;
#pragma unroll 1
            for (int m = 0; m < 2; ++m) {
                bf16x8_t qf[4];
#pragma unroll
                for (int ks = 0; ks < 4; ++ks) qf[ks] = *(const bf16x8_t*)(QKV + tokq * 3072 + h * 128 + m * 64 + 16 * ks + 8 * hi);
                f32x16_d O[4];
#pragma unroll
                for (int db = 0; db < 4; ++db) O[db] = f32x16_d{};
                float mrun = 0.f, lsum = 0.f; f32x16_d negm = f32x16_d{};
                const bf16* kg = QKV + ((size_t)b * SEQ + krow) * 3072 + 1024 + h * 128 + m * 64 + kch * 8;
                const bf16* vg = QKV + ((size_t)b * SEQ + vrow) * 3072 + 2048 + h * 128 + vch * 8;
                v4u sk[2], sv0[2], sv1[2];
                sk[0] = *(const v4u*)kg; sv0[0] = *(const v4u*)vg; sv1[0] = *(const v4u*)(vg + (size_t)32 * 3072);
                { const size_t ko = (size_t)64 * 3072; sk[1] = *(const v4u*)(kg + ko); sv0[1] = *(const v4u*)(vg + ko); sv1[1] = *(const v4u*)(vg + ko + (size_t)32 * 3072); }
                *(LAS v4u*)(lds + krow * (DT_RSK * 2) + kch * 16) = sk[0];
                *(LAS v4u*)(lds + 64 * DT_RSK * 2 + vrow * (DT_RSV * 2) + vch * 16) = sv0[0]; *(LAS v4u*)(lds + 64 * DT_RSK * 2 + (vrow + 32) * (DT_RSV * 2) + vch * 16) = sv1[0];
                __syncthreads();
#pragma unroll 1
                for (int t2 = 0; t2 < nt; t2 += 2) {
#pragma unroll
                  for (int tp = 0; tp < 2; ++tp) {
                    const int t = t2 + tp;
                    const int buf = tp * DT_BUF;
                    if (t + 2 < nt) { const size_t ko = (size_t)(t + 2) * 64 * 3072; sk[tp] = *(const v4u*)(kg + ko); sv0[tp] = *(const v4u*)(vg + ko); sv1[tp] = *(const v4u*)(vg + ko + (size_t)32 * 3072); }
                    if (64 * t <= wmin + 31) {
                        LAS unsigned char* kb_ = lds + buf; LAS unsigned char* vb_ = lds + buf + 64 * DT_RSK * 2;
                        f32x16_d S[2];
#pragma unroll
                        for (int kb = 0; kb < 2; ++kb) {
#pragma unroll
                            for (int ks = 0; ks < 4; ++ks) { const bf16x8_t kf = *(const LAS bf16x8_t*)(kb_ + (32 * kb + r32) * (DT_RSK * 2) + (16 * ks + 8 * hi) * 2);
                                S[kb] = __builtin_amdgcn_mfma_f32_32x32x16_bf16(kf, qf[ks], ks == 0 ? negm : S[kb], 0, 0, 0); } }
                        if (64 * t + 63 > wmin) {
#pragma unroll
                            for (int kb = 0; kb < 2; ++kb)
#pragma unroll
                                for (int r = 0; r < 16; ++r) { const int key = 64 * t + 32 * kb + (r & 3) + 8 * (r >> 2) + 4 * hi; if (key > qpos) S[kb][r] = -INFINITY; }
                        }
                        float mx = S[0][0];
#pragma unroll
                        for (int r = 1; r < 16; ++r) mx = fmaxf(mx, S[0][r]);
#pragma unroll
                        for (int r = 0; r < 16; ++r) mx = fmaxf(mx, S[1][r]);
                        { auto rr = __builtin_amdgcn_permlane32_swap(__float_as_uint(mx), __float_as_uint(mx), false, false); mx = fmaxf(__uint_as_float(rr[0]), __uint_as_float(rr[1])); }
                        if (__builtin_expect(__any(mx > 8.f), 0)) {
                            const float dl = fmaxf(mx, 0.f), alpha = __builtin_amdgcn_exp2f(-dl); mrun += dl; lsum *= alpha;
#pragma unroll
                            for (int kb = 0; kb < 2; ++kb)
#pragma unroll
                                for (int r = 0; r < 16; ++r) S[kb][r] -= dl;
#pragma unroll
                            for (int r = 0; r < 16; ++r) negm[r] = -mrun;
#pragma unroll
                            for (int db = 0; db < 4; ++db)
#pragma unroll
                                for (int r = 0; r < 16; ++r) O[db][r] *= alpha;
                        }
                        float ps = 0.f;
#pragma unroll
                        for (int kb = 0; kb < 2; ++kb)
#pragma unroll
                            for (int r = 0; r < 16; ++r) { const float pv = __builtin_amdgcn_exp2f(S[kb][r]); S[kb][r] = pv; ps += pv; }
                        lsum += ps;
#pragma unroll
                        for (int kb = 0; kb < 2; ++kb)
#pragma unroll
                            for (int s2 = 0; s2 < 2; ++s2) {
                                u32x4_t pw; pw.x = pk2(S[kb][8 * s2], S[kb][8 * s2 + 1]); pw.y = pk2(S[kb][8 * s2 + 2], S[kb][8 * s2 + 3]); pw.z = pk2(S[kb][8 * s2 + 4], S[kb][8 * s2 + 5]); pw.w = pk2(S[kb][8 * s2 + 6], S[kb][8 * s2 + 7]);
                                const bf16x8_t pf = __builtin_bit_cast(bf16x8_t, pw);
#pragma unroll
                                for (int db = 0; db < 4; ++db) {
                                    LAS unsigned char* va = vb_ + vtr + (32 * kb + 16 * s2) * (DT_RSV * 2) + db * 64;
                                    const v4i16_d lo = __builtin_amdgcn_ds_read_tr16_b64_v4i16((LAS v4i16_d*)va), hi4 = __builtin_amdgcn_ds_read_tr16_b64_v4i16((LAS v4i16_d*)(va + 8 * (DT_RSV * 2)));
                                    const bf16x8_t vf = (bf16x8_t){lo[0], lo[1], lo[2], lo[3], hi4[0], hi4[1], hi4[2], hi4[3]};
                                    O[db] = __builtin_amdgcn_mfma_f32_32x32x16_bf16(vf, pf, O[db], 0, 0, 0);
                                }
                            }
                    }
                    if (t + 1 < nt) { const int nb = (tp ^ 1) * DT_BUF;
                        *(LAS v4u*)(lds + nb + krow * (DT_RSK * 2) + kch * 16) = sk[tp ^ 1];
                        *(LAS v4u*)(lds + nb + 64 * DT_RSK * 2 + vrow * (DT_RSV * 2) + vch * 16) = sv0[tp ^ 1]; *(LAS v4u*)(lds + nb + 64 * DT_RSK * 2 + (vrow + 32) * (DT_RSV * 2) + vch * 16) = sv1[tp ^ 1]; }
                    __syncthreads();
                  }
                }
                lsum += __int_as_float(__builtin_amdgcn_ds_bpermute((lane ^ 32) << 2, __float_as_int(lsum)));
                const float linv = 1.f / lsum;
                if (m == 0) {
#pragma unroll
                    for (int db = 0; db < 4; ++db)
#pragma unroll
                        for (int r = 0; r < 16; r += 2) sO0[(db * 8 + (r >> 1)) * 64 + lane] = pk2(O[db][r] * linv, O[db][r + 1] * linv);
                } else {
                    float ss = 0.f;
#pragma unroll
                    for (int db = 0; db < 4; ++db)
#pragma unroll
                        for (int r = 0; r < 16; r += 2) { const unsigned w0 = sO0[(db * 8 + (r >> 1)) * 64 + lane];
                            const float o0 = bflo(w0) - lam * (O[db][r] * linv), o1 = bfhi(w0) - lam * (O[db][r + 1] * linv); O[db][r] = o0; O[db][r + 1] = o1; ss += o0 * o0 + o1 * o1; }
                    ss += __int_as_float(__builtin_amdgcn_ds_bpermute((lane ^ 32) << 2, __float_as_int(ss)));
                    const float rs = 1.f / sqrtf(ss * (1.f / 128.f) + RMS_EPS);
                    bf16* orow = MIXO + tokq * D + h * 128 + 4 * hi;
#pragma unroll
                    for (int db = 0; db < 4; ++db)
#pragma unroll
                        for (int rg = 0; rg < 4; ++rg) { const int d0 = 32 * db + 8 * rg + 4 * hi; const f32x4 g4 = *(const LAS f32x4*)(sG + d0);
                            u32x2_t w; w.x = pk2(O[db][4 * rg] * rs * g4.x, O[db][4 * rg + 1] * rs * g4.y); w.y = pk2(O[db][4 * rg + 2] * rs * g4.z, O[db][4 * rg + 3] * rs * g4.w);
                            *(u32x2_t*)(orow + 32 * db + 8 * rg) = w; }
                }
            }
        }
    }
    __syncthreads();
}

__device__ __forceinline__ void moe_tail_down(Frame& F, int lslot) {
    pg8::MoeOrder S; S.init((const unsigned*)(F.ctl + CW_CNT + 16 * lslot), 4, F.G, F.bx); S.cut_tail();
    const int ntail = S.so.nwg - S.so.lim;
    if (ntail <= 0) return;
    const bf16* A = (const bf16*)(F.ws + WS_HIDP); const bf16* Bt = (const bf16*)(F.ws + WS_WB + WB_MDN); bf16* O = (bf16*)(F.ws + WS_XPERM);
    int lane = F.lane; asm volatile("" : "+v"(lane)); const int fr = lane & 15, fq = lane >> 4;
    LAS unsigned char* red = F.lds;
    for (int rr = 0; rr * 16 < ntail; ++rr) {
        const int j = F.bx >> 3, t = (F.bx & 7) + 8 * ((j >> 4) + 2 * rr), p = j & 15;
        if (t >= ntail) continue;
        pg8::Unit u; S.at((long)S.so.lim + t, u);
        const int sr = (p >> 2) & 3, sc = p & 3;
        const bf16* ap = A + (size_t)(u.pm * 256 + 64 * sr + fr) * FF + 352 * F.wave + 8 * fq;
        const bf16* bp = Bt + (size_t)(u.pb * 256 + 64 * sc + fr) * FF + 352 * F.wave + 8 * fq;
        f32x4_t acc[4][4];
#pragma unroll
        for (int m = 0; m < 4; ++m)
#pragma unroll
            for (int n = 0; n < 4; ++n) acc[m][n] = (f32x4_t){0.f, 0.f, 0.f, 0.f};
        bf16x8_t fa[3][4], fb[3][4];
#define TL_LOAD(st, s) do { _Pragma("unroll") for (int g = 0; g < 4; ++g) { fa[st][g] = *(const bf16x8_t*)(ap + (size_t)(16 * g) * FF + 32 * (s)); fb[st][g] = *(const bf16x8_t*)(bp + (size_t)(16 * g) * FF + 32 * (s)); } } while (0)
        TL_LOAD(0, 0); TL_LOAD(1, 1);
#pragma unroll
        for (int s = 0; s < 11; ++s) {
            if (s + 2 < 11) TL_LOAD((s + 2) % 3, s + 2);
            __builtin_amdgcn_sched_barrier(0);
#pragma unroll
            for (int m = 0; m < 4; ++m)
#pragma unroll
                for (int n = 0; n < 4; ++n) acc[m][n] = __builtin_amdgcn_mfma_f32_16x16x32_bf16(fb[s % 3][n], fa[s % 3][m], acc[m][n], 0, 0, 0);
            __builtin_amdgcn_sched_barrier(0);
        }
#undef TL_LOAD
#pragma unroll
        for (int m = 0; m < 4; ++m)
#pragma unroll
            for (int n = 0; n < 4; ++n) *(LAS f32x4_t*)(red + ((size_t)((F.wave * 16 + m * 4 + n) * 64 + lane)) * 16) = acc[m][n];
        __syncthreads();
#pragma unroll
        for (int q2 = 0; q2 < 2; ++q2) {
            const int q = 2 * F.wave + q2, m = q >> 2, n = q & 3;
            f32x4_t t = *(const LAS f32x4_t*)(red + ((size_t)(q * 64 + lane)) * 16);
#pragma unroll
            for (int v = 1; v < 8; ++v) t += *(const LAS f32x4_t*)(red + ((size_t)((v * 16 + q) * 64 + lane)) * 16);
            bf16* op = O + (size_t)(u.pm * 256 + 64 * sr + 16 * m + fr) * D + u.pn * 256 + 64 * sc + 16 * n + 4 * fq;
            *(GAS unsigned long long*)op = (unsigned long long)pk2(t[0], t[1]) | ((unsigned long long)pk2(t[2], t[3]) << 32);
        }
        __syncthreads();
    }
}

struct Args { const float* in[34]; float* out; unsigned char* ws; int lo, hi; };
constexpr int PH_PER_PAIR = 17, NPHASE = 1 + 2 * PH_PER_PAIR;
#ifndef PHMASK
#define PHMASK 0x3FFFFu
#endif
#define PHON(k) (((PHMASK) >> (k)) & 1u)

__device__ __forceinline__ void frame_refresh(Frame& F) {
    int wv = F.wave0; asm volatile("" : "+s"(wv));
    int ln; asm volatile("v_mbcnt_lo_u32_b32 %0, -1, 0\n\tv_mbcnt_hi_u32_b32 %0, -1, %0" : "=v"(ln));
    ln &= 63; wv &= 7; const int t = wv * 64 + ln;
    int bx = blockIdx.x; asm volatile("" : "+s"(bx));
    const __attribute__((address_space(4))) unsigned char* kp = (const __attribute__((address_space(4))) unsigned char*)__builtin_amdgcn_kernarg_segment_ptr(); asm volatile("" : "+s"(kp));
    typedef unsigned char* ucp; unsigned char* w = *(const __attribute__((address_space(4))) ucp*)(kp + 280);
    F.kp = kp; F.tid = t; F.lane = t & 63; F.wave = wv;
    F.bx = bx; F.gw = bx * NWAVES + F.wave; F.ws = w; F.ctl = (gu32*)(w + WS_CTL);
}

#define IN(k) (lo <= (k) && (k) < hi)
#define SEAM(k) do { if (IN((k) + 1)) xcd_barrier(bar, F.tid); } while (0)
#define WSB(off) ((bf16*)(F.ws + (off)))
template <int lp> __device__ __forceinline__ void layer_pair(Frame& F, const int lo, const int hi, const XcdBarrier& bar, unsigned char* lds) {
        const int pb = 1 + PH_PER_PAIR * lp;
        if (PHON(1) && IN(pb + 0)) {
            frame_refresh(F);
            pg8::Gemm g{WSB(WS_XB), WSB(WS_WB + WB_WIN), M, EINP, D}; pg8::StaticOrder S; S.init(M, EINP, F.G, F.bx);
            pg8::EpiBf16<0> E{WSB(WS_P), EINP, nullptr, 0, 0, 1.f};
            pg8::gemm_phase<pg8::EpiBf16<0>, pg8::StaticOrder, true, true>(F.lds, g, S, E, F.tid);
            SEAM(pb + 0);
        }
        if (PHON(2) && IN(pb + 1)) { frame_refresh(F); dsa_prep(F, lp); gla_prep(F, lp); SEAM(pb + 1); }
        if (PHON(3) && IN(pb + 2)) { frame_refresh(F); dsa_index(F); frame_refresh(F); gla_scan(F); SEAM(pb + 2); }
        if (PHON(4) && IN(pb + 3)) { frame_refresh(F);
            dsa_body::dsa_attn_phase<8>((char*)lds, (const dsa_body::bf16*)(F.ws + WS_P) + PC_AQ, (const dsa_body::bf16*)(F.ws + WS_KD), (const dsa_body::bf16*)(F.ws + WS_VD), (dsa_body::bf16*)(F.ws + WS_MIX), (const unsigned*)(F.ws + WS_MASK), F.bx, F.G, F.tid);
            __syncthreads(); gla_out(F, lp); SEAM(pb + 3); }
        if (PHON(5) && IN(pb + 4)) {
            frame_refresh(F);
            pg8::Gemm g{WSB(WS_MIX), WSB(WS_WB + WB_WOUT), M, D, D}; pg8::PanelOrder S; S.init(M, F.bx);
            pg8::EpiLnFused E{WSB(WS_XB), F.inp(11) + lp * D, F.inp(12) + lp * D, (unsigned long long*)(F.ws + WS_XSTAT), (unsigned*)(F.ctl + CW_PANEL + 8192 * (2 * lp)), (unsigned*)(F.ctl + CW_TMO), F.lds + XTRA_OFF};
            pg8::gemm_phase<pg8::EpiLnFused, pg8::PanelOrder, true, true>(F.lds, g, S, E, F.tid);
            SEAM(pb + 4);
        }
        if (PHON(7) && IN(pb + 6)) {
            frame_refresh(F);
            pg8::Gemm g{WSB(WS_XB), WSB(WS_WB + WB_WGU), M, 2 * FF, D}; pg8::StaticOrder S; S.init(M, 2 * FF, F.G, F.bx);
            pg8::EpiSwiGLU E{WSB(WS_HID), FF};
            pg8::gemm_phase<pg8::EpiSwiGLU, pg8::StaticOrder, true, true>(F.lds, g, S, E, F.tid);
            SEAM(pb + 6);
        }
        if (PHON(8) && IN(pb + 7)) {
            frame_refresh(F);
            pg8::Gemm g{WSB(WS_HID), WSB(WS_WB + WB_WDN), M, D, FF}; pg8::PanelOrder S; S.init(M, F.bx);
            pg8::EpiLnFused E{WSB(WS_XB), F.inp(16) + lp * D, F.inp(17) + lp * D, (unsigned long long*)(F.ws + WS_XSTAT), (unsigned*)(F.ctl + CW_PANEL + 8192 * (2 * lp + 1)), (unsigned*)(F.ctl + CW_TMO), F.lds + XTRA_OFF};
            pg8::gemm_phase<pg8::EpiLnFused, pg8::PanelOrder, true, true>(F.lds, g, S, E, F.tid);
            SEAM(pb + 7);
        }
        if (PHON(9) && IN(pb + 8)) { frame_refresh(F); cvt_odd(F, lp); SEAM(pb + 8); }
        if (PHON(10) && IN(pb + 9)) {
            frame_refresh(F);
            pg8::Gemm g{WSB(WS_XB), WSB(WS_WB + WB_WQKV), M, 3072, D}; pg8::StaticOrder S; S.init(M, 3072, F.G, F.bx);
            pg8::EpiBf16<0> E{WSB(WS_QKV), 3072, nullptr, 1024, 1024, C2};
            pg8::gemm_phase<pg8::EpiBf16<0>, pg8::StaticOrder, true, true>(F.lds, g, S, E, F.tid);
            SEAM(pb + 9);
        }
        if (PHON(11) && IN(pb + 10)) {
            frame_refresh(F);
            constexpr float lam_init = (lp == 0) ? 0.355509068f : 0.556058204f;
            diff_attn_t(F, lds, lp, lam_init);
            SEAM(pb + 10);
        }
        if (PHON(12) && IN(pb + 11)) {
            frame_refresh(F);
            pg8::Gemm g{WSB(WS_MIXO), WSB(WS_WB + WB_WOUT), M, D, D}; pg8::StaticOrder S; S.init(M, D, F.G, F.bx);
            pg8::EpiBf16<0> E{WSB(WS_H_ODD), D, nullptr, 0, 0, 1.f};
            pg8::gemm_phase<pg8::EpiBf16<0>, pg8::StaticOrder, true, true>(F.lds, g, S, E, F.tid);
            SEAM(pb + 11);
        }
        if (PHON(13) && IN(pb + 12)) { frame_refresh(F);
            ln_phase<0, true, true, false>(F, (const float*)F.outp(), WSB(WS_H_ODD), F.inp(25) + lp * D, F.inp(26) + lp * D, F.outp(), WSB(WS_XB), F.inp(27) + (size_t)lp * D * NEXP, F.inp(28) + lp * NEXP, lp); SEAM(pb + 12); }
        if (PHON(14) && IN(pb + 13)) { frame_refresh(F); moe_map(F, lp); SEAM(pb + 13); }
        if (PHON(15) && IN(pb + 14)) {
            frame_refresh(F);
            pg8::MoeOrder S; S.init((const unsigned*)(F.ctl + CW_CNT + 16 * lp), 22, F.G, F.bx);
            pg8::Gemm g{WSB(WS_XB), WSB(WS_WB + WB_MGU), S.so.nM * 256, 2 * FF, D, (const int*)(F.ws + WS_INV)};
            pg8::EpiSwiGLU E{WSB(WS_HIDP), FF};
            pg8::gemm_phase<pg8::EpiSwiGLU, pg8::MoeOrder, true, true, true>(F.lds, g, S, E, F.tid);
            SEAM(pb + 14);
        }
        if (PHON(16) && IN(pb + 15)) {
            frame_refresh(F);
            pg8::MoeOrder S; S.init((const unsigned*)(F.ctl + CW_CNT + 16 * lp), 4, F.G, F.bx); S.cut_tail();
            pg8::Gemm g{WSB(WS_HIDP), WSB(WS_WB + WB_MDN), S.so.nM * 256, D, FF};
            pg8::EpiBf16<0> E{WSB(WS_XPERM), D, nullptr, 0, 0, 1.f};
            pg8::gemm_phase<pg8::EpiBf16<0>, pg8::MoeOrder, true, true>(F.lds, g, S, E, F.tid);
            frame_refresh(F); moe_tail_down(F, lp);
            SEAM(pb + 15);
        }
        if (PHON(17) && IN(pb + 16)) {
            frame_refresh(F);
            ln_phase<1, false, true, lp == 1>(F, (const float*)F.outp(), WSB(WS_XPERM), F.inp(32) + lp * D, F.inp(33) + lp * D, F.outp(), WSB(WS_XB), nullptr, nullptr, 0);
            if (lp == 0) { __syncthreads(); cvt_even(F, 1); SEAM(pb + 16); }
        }
    }

__global__ void __launch_bounds__(NTHR, 2) mega_fwd(Args args) {
    extern __shared__ __attribute__((aligned(16))) unsigned char lds[];
    Frame F;
    F.lds = (LAS unsigned char*)lds; F.MISC = (volatile LAS unsigned*)(F.lds + MISC_OFF);
    F.G = gridDim.x; F.NGW = F.G * NWAVES; F.wave0 = __builtin_amdgcn_readfirstlane((int)threadIdx.x >> 6);
    frame_refresh(F);
    for (int u = F.tid; u < (LDS_BYTES - LDSCTL_OFF) / 4; u += NTHR) ((LAS unsigned*)(F.lds + LDSCTL_OFF))[u] = 0u;
    __syncthreads();
    const int lo = args.lo, hi = args.hi;
    const bool use_bar = (hi - lo) > 1;
    XcdBarrier bar; bar.bar = (unsigned*)(F.ctl + CW_BAR); bar.x = 0; bar.st = nullptr;
    if (use_bar) bar = xcd_barrier_post((unsigned*)(F.ctl + CW_BAR), F.MISC + 8, F.tid);

    if (PHON(0) && IN(0)) { frame_refresh(F); cvt_even(F, 0); xb_from_x(F); SEAM(0); }

    layer_pair<0>(F, lo, hi, bar, lds);
    layer_pair<1>(F, lo, hi, bar, lds);
#undef IN
#undef SEAM
}

#ifndef MK_SINGLE
#define MK_SINGLE 1
#endif
extern "C" void kernel_launch(void* const* d_in, const int* in_sizes, int n_in, void* d_out, int out_size, void* d_ws, size_t ws_size, hipStream_t stream) {
    static int grid = 0;
    if (grid == 0) {
        if (n_in != 34 || in_sizes[0] != M * D || out_size != M * D || ws_size < WS_END) { fprintf(stderr, "kernel_launch: unexpected shapes or workspace (n_in %d, ws %zu)\n", n_in, ws_size); grid = -1; return; }
        int dev = 0, cus = 0, per_cu = 0;
        if (hipGetDevice(&dev) != hipSuccess || hipDeviceGetAttribute(&cus, hipDeviceAttributeMultiprocessorCount, dev) != hipSuccess) { grid = -1; return; }
        if (hipFuncSetAttribute((const void*)mega_fwd, hipFuncAttributeMaxDynamicSharedMemorySize, LDS_BYTES) != hipSuccess) { grid = -1; return; }
        if (hipOccupancyMaxActiveBlocksPerMultiprocessor(&per_cu, (const void*)mega_fwd, NTHR, LDS_BYTES) != hipSuccess || per_cu < 1) fprintf(stderr, "kernel_launch: occupancy query says %d\n", per_cu);
        (void)hipGetLastError();
        if (cus != 256) { fprintf(stderr, "kernel_launch: this kernel is laid out for 256 CUs (got %d)\n", cus); grid = -1; return; }
        grid = cus;
    }
    if (grid < 0) return;
    (void)hipMemsetAsync((char*)d_ws + WS_CTL, 0, CTL_ZERO_BYTES, stream);
    Args a{};
    for (int i = 0; i < 34; ++i) a.in[i] = (const float*)d_in[i];
    a.out = (float*)d_out; a.ws = (unsigned char*)d_ws;
    a.lo = 0; a.hi = NPHASE;
    hipLaunchKernelGGL(mega_fwd, dim3(grid), dim3(NTHR), LDS_BYTES, stream, a);
}
```

```cpp
#include <hip/hip_runtime.h>
#include <cstdio>
#include <cstdint>
#include <cmath>
namespace pg8 {
#define PG8_LAS __attribute__((address_space(3)))
typedef unsigned short bf16_t;
typedef short bf16x8 __attribute__((ext_vector_type(8)));
typedef float f32x4 __attribute__((ext_vector_type(4)));
typedef unsigned u32x4 __attribute__((ext_vector_type(4)));
constexpr int BM = 256, BK = 64, HALF = 128, HTB = HALF * BK * 2  , STAGE_BYTES = 8 * HTB, NXCD = 8, WGM = 5;

__host__ __device__ __forceinline__ int lds_byte(int r, int c) { const int st = (r >> 4) * 2 + (c >> 5), rr = r & 15, cc = c & 31, ob = rr * 64 + cc * 2; return st * 1024 + (ob ^ (((ob >> 9) & 1) << 5)); }
__host__ __device__ __forceinline__ void stage_rc(int b, int& R, int& C) { const int st = b / 1024, sb = b % 1024, swz = sb ^ (((sb >> 9) & 1) << 5); R = (st >> 1) * 16 + swz / 64; C = (st & 1) * 32 + (swz % 64) / 2; }
__host__ __device__ __forceinline__ int perm32(int rho) { const int n = rho >> 4, i = rho & 15; return 8 * (i >> 2) + 4 * n + (i & 3); }

struct Unit { int pm, pn, pb; };
struct Gemm { const bf16_t* A; const bf16_t* Bt; int M, N, K; const int* inv = nullptr; };

struct StaticOrder {
    int nM, nN, nwg, G, c, lim;
    __host__ __device__ void init(int M, int N, int G_, int c_) { nM = M / BM; nN = N / BM; nwg = nM * nN; G = G_; c = c_; lim = nwg; }
    __host__ __device__ bool next(int i, Unit& u) const { const long L = (long)i * G + c; if (L >= lim) return false; return at(L, u); }
    __host__ __device__ bool at(long L, Unit& u) const {
        if (L >= nwg) return false;
        int wgid = (int)L; { const int q = nwg / NXCD, r = nwg % NXCD, xcd = wgid % NXCD, off = wgid / NXCD; wgid = (xcd < r ? xcd * (q + 1) : r * (q + 1) + (xcd - r) * q) + off; }
        const int nig = WGM * nN, gid = wgid / nig, fm = gid * WGM, gsz = (nM - fm) < WGM ? (nM - fm) : WGM;
        u.pm = fm + ((wgid % nig) % gsz); u.pn = (wgid % nig) / gsz; u.pb = u.pn; return true;
    }
    __device__ __forceinline__ void a_ready(const Unit&) const {}
    __device__ __forceinline__ void done(const Unit&) const {}
};

__device__ __forceinline__ unsigned cvt_pk_bf16(float lo, float hi) { unsigned r; asm volatile("v_cvt_pk_bf16_f32 %0, %1, %2" : "=v"(r) : "v"(lo), "v"(hi)); return r; }
typedef float f32x2 __attribute__((ext_vector_type(2)));
__device__ __forceinline__ f32x2 gelu_pk(f32x2 v) {
    const f32x2 av = __builtin_elementwise_abs(v), d = av * 0.2316418882f + 1.0f;
    f32x2 t; t.x = __builtin_amdgcn_rcpf(d.x); t.y = __builtin_amdgcn_rcpf(d.y);
    f32x2 q = t * 0.5307027145f + (-0.7265760135f); q = q * t + 0.7107068705f; q = q * t + (-0.142248368f); q = q * t + 0.127414796f; q = q * t;
    const f32x2 s = (v * v) * (-0.72134752044f);
    f32x2 e; e.x = __builtin_amdgcn_exp2f(s.x); e.y = __builtin_amdgcn_exp2f(s.y);
    const f32x2 m = v * (q * e), r = v - m;
    f32x2 o; o.x = v.x < 0.f ? m.x : r.x; o.y = v.y < 0.f ? m.y : r.y; return o;
}

template <int ACT  > struct EpiBf16 {
    static constexpr bool PERM = true, AFTER_DRAIN = false; static_assert(ACT == 0 || ACT == 1, "EpiBf16: ACT is 0 (none) or 1 (gelu_pk)");
    bf16_t* O; int ldc; const float* bias; int split_cols; size_t split_stride; float scale0;
    __device__ __forceinline__ void operator()(const f32x4 (&acc)[2][2][4][2], const Unit& u, int wr, int wc, int fr, int fq) const {
        const int row0 = u.pm * BM + wr * 64 + fr; int colt = u.pn * BM; bf16_t* base = O;
        float sc = 1.f; if (split_cols) { const int t = colt / split_cols; base += (size_t)t * split_stride; colt -= t * split_cols; if (t == 0) sc = scale0; }
        const int col0 = colt + wc * 32 + 8 * fq, bcol0 = u.pn * BM + wc * 32 + 8 * fq;
        f32x4 bv[2][2];
#pragma unroll
        for (int bj = 0; bj < 2; ++bj)
#pragma unroll
            for (int n = 0; n < 2; ++n) bv[bj][n] = bias ? *(const f32x4*)(bias + bcol0 + bj * HALF + 4 * n) : (f32x4){0.f, 0.f, 0.f, 0.f};
#pragma unroll
        for (int ai = 0; ai < 2; ++ai)
#pragma unroll
            for (int m = 0; m < 4; ++m) { bf16_t* rowp = base + (size_t)(row0 + ai * HALF + m * 16) * ldc + col0;
#pragma unroll
                for (int bj = 0; bj < 2; ++bj) { f32x4 v0 = acc[ai][bj][m][0] + bv[bj][0], v1 = acc[ai][bj][m][1] + bv[bj][1];
                    if (ACT == 1) { f32x2 a = gelu_pk((f32x2){v0[0], v0[1]}), b = gelu_pk((f32x2){v0[2], v0[3]}), c = gelu_pk((f32x2){v1[0], v1[1]}), d = gelu_pk((f32x2){v1[2], v1[3]});
                        v0 = (f32x4){a.x, a.y, b.x, b.y}; v1 = (f32x4){c.x, c.y, d.x, d.y}; }
                    v0 = v0 * sc; v1 = v1 * sc; u32x4 w; w.x = cvt_pk_bf16(v0[0], v0[1]); w.y = cvt_pk_bf16(v0[2], v0[3]); w.z = cvt_pk_bf16(v1[0], v1[1]); w.w = cvt_pk_bf16(v1[2], v1[3]);
                    *(u32x4*)(rowp + bj * HALF) = w; } }
    }
};
template <class Epi, class Sched, bool ALIGN_EPI = false, bool SP2 = false, bool GATHER = false>
__device__ __forceinline__ void gemm_phase(PG8_LAS unsigned char* lds, const Gemm g, const Sched& S, const Epi& E, const int tid) {
    const int wid = __builtin_amdgcn_readfirstlane(tid >> 6), lane = tid & 63, wr = wid >> 2, wc = wid & 3, fr = lane & 15, fq = lane >> 4;
    const int K = g.K, nt = K / BK;
    unsigned voffA[2], voffB[2];
#pragma unroll
    for (int i = 0; i < 2; ++i) { int R, C; stage_rc(tid * 16 + i * 8192, R, C); const int Rb = Epi::PERM ? ((R & ~31) + perm32(R & 31)) : R;
        voffA[i] = (unsigned)(R * K + C) * 2u; voffB[i] = (unsigned)(Rb * K + C) * 2u; }
    unsigned vA[2][2], vN[2][2]; int rawN[2][2]; int gR[2], gC[2];
#pragma unroll
    for (int i = 0; i < 2; ++i) { stage_rc(tid * 16 + i * 8192, gR[i], gC[i]); vA[0][i] = vA[1][i] = vN[0][i] = vN[1][i] = voffA[i]; rawN[0][i] = rawN[1][i] = 0; }
    const size_t kstep = (size_t)(BK * 2);
    const size_t hstep = (size_t)HALF * K * 2;
    const size_t hsA = GATHER ? (size_t)0 : hstep;
    const size_t tstep = 2 * hstep;
    const unsigned ldsw = (unsigned)wid * 1024u;
    const int aoff = lds_byte(wr * 64 + fr, fq * 8), boff = lds_byte(wc * 32 + fr, fq * 8);
#define PG8_SA(b, h) (((b) * 2 + (h)) * HTB)
#define PG8_SB(b, h) ((4 + (b) * 2 + (h)) * HTB)
#define PG8_STAGE(bufoff, gbase, voff) do { _Pragma("unroll") for (int _i = 0; _i < 2; ++_i) \
        __builtin_amdgcn_global_load_lds((const unsigned*)((const char*)(gbase) + (voff)[_i]), (PG8_LAS unsigned*)(lds + (bufoff) + ldsw + _i * 8192), 16, 0, 0); } while (0)
#define PG8_LDA(dst, b, h) do { _Pragma("unroll") for (int m = 0; m < 4; ++m) _Pragma("unroll") for (int k = 0; k < 2; ++k) dst[m][k] = *(const PG8_LAS bf16x8*)(lds + PG8_SA(b, h) + aoff + m * 2048 + k * 1024); } while (0)
#define PG8_LDB(dst, b, h) do { _Pragma("unroll") for (int n = 0; n < 2; ++n) _Pragma("unroll") for (int k = 0; k < 2; ++k) dst[n][k] = *(const PG8_LAS bf16x8*)(lds + PG8_SB(b, h) + boff + n * 2048 + k * 1024); } while (0)
#define PG8_MMA(ai, bj, At, Bt) do { __builtin_amdgcn_s_setprio(1); _Pragma("unroll") for (int m = 0; m < 4; ++m) _Pragma("unroll") for (int n = 0; n < 2; ++n) _Pragma("unroll") for (int k = 0; k < 2; ++k) \
        acc[ai][bj][m][n] = __builtin_amdgcn_mfma_f32_16x16x32_bf16(Bt[n][k], At[m][k], acc[ai][bj][m][n], 0, 0, 0); __builtin_amdgcn_s_setprio(0); } while (0)
#define PG8_WAIT_V(n) asm volatile("s_waitcnt vmcnt(" #n ")" ::: "memory")
#define PG8_WAIT_L(n) asm volatile("s_waitcnt lgkmcnt(" #n ")" ::: "memory")
#define PG8_BAR __builtin_amdgcn_s_barrier()
#define PG8_SCHED __builtin_amdgcn_sched_barrier(0)
    Unit cur, nxt; int ui = 0;
    if (!S.next(0, cur)) return;
    f32x4 acc[2][2][4][2];
#pragma unroll
    for (int a = 0; a < 2; ++a)
#pragma unroll
        for (int b = 0; b < 2; ++b)
#pragma unroll
            for (int m = 0; m < 4; ++m)
#pragma unroll
                for (int n = 0; n < 2; ++n) acc[a][b][m][n] = (f32x4){0.f, 0.f, 0.f, 0.f};
    bf16x8 At[4][2], B0[2][2], B1[2][2];
    const char* cA = GATHER ? (const char*)g.A : (const char*)g.A + (size_t)cur.pm * tstep; const char* cB = (const char*)g.Bt + (size_t)cur.pb * tstep;
    if constexpr (GATHER) {
#pragma unroll
        for (int h = 0; h < 2; ++h)
#pragma unroll
            for (int i = 0; i < 2; ++i) vA[h][i] = vN[h][i] = (unsigned)g.inv[cur.pm * BM + HALF * h + gR[i]] * (unsigned)(K * 2) + (unsigned)(gC[i] * 2);
    }
    S.a_ready(cur);
    if constexpr (SP2) {
        PG8_STAGE(PG8_SB(0, 0), cB, voffB); PG8_STAGE(PG8_SB(0, 1), cB + hstep, voffB); PG8_STAGE(PG8_SA(0, 0), cA, vA[0]); PG8_STAGE(PG8_SA(0, 1), cA + hsA, vA[1]);
        if (wr == 1) PG8_BAR;
        PG8_WAIT_V(2); PG8_BAR;
        PG8_STAGE(PG8_SB(1, 0), cB + kstep, voffB); PG8_STAGE(PG8_SA(1, 0), cA + kstep, vA[0]); PG8_STAGE(PG8_SB(1, 1), cB + hstep + kstep, voffB);
        PG8_WAIT_V(6); PG8_BAR;
    } else {
        PG8_STAGE(PG8_SB(0, 0), cB, voffB); PG8_STAGE(PG8_SA(0, 0), cA, vA[0]); PG8_STAGE(PG8_SB(0, 1), cB + hstep, voffB); PG8_STAGE(PG8_SA(0, 1), cA + hsA, vA[1]);
        if (wr == 1) PG8_BAR;
        PG8_WAIT_V(4); PG8_BAR;
        PG8_STAGE(PG8_SB(1, 0), cB + kstep, voffB); PG8_STAGE(PG8_SA(1, 0), cA + kstep, vA[0]); PG8_STAGE(PG8_SB(1, 1), cB + hstep + kstep, voffB);
        PG8_WAIT_V(6); PG8_BAR;
    }
    for (;;) {
        const bool has_next = S.next(ui + 1, nxt);
        if constexpr (GATHER) {
            if (has_next) {
#pragma unroll
                for (int h = 0; h < 2; ++h)
#pragma unroll
                    for (int i = 0; i < 2; ++i) asm volatile("global_load_dword %0, %1, off" : "=&v"(rawN[h][i]) : "v"(g.inv + nxt.pm * BM + HALF * h + gR[i]) : "memory");
            }
        }
        const char* nA = GATHER ? cA : (has_next ? (const char*)g.A + (size_t)nxt.pm * tstep : cA); const char* nB = has_next ? (const char*)g.Bt + (size_t)nxt.pb * tstep : cB;
        for (int t = 0; t < nt; t += 2) {
            const bool last = (t == nt - 2);
            const char* a1 = cA + (size_t)(t + 1) * kstep;
            const char* a2 = last ? nA : cA + (size_t)(t + 2) * kstep; const char* b2 = last ? nB : cB + (size_t)(t + 2) * kstep;
            const char* a3 = a2 + kstep; const char* b3 = b2 + kstep;
            if (last && has_next) S.a_ready(nxt);
            if constexpr (GATHER) {
                if (last) {
                    if (has_next) {
#pragma unroll
                        for (int h = 0; h < 2; ++h)
#pragma unroll
                            for (int i = 0; i < 2; ++i) { int tkn; asm volatile("v_mov_b32 %0, %1" : "=v"(tkn) : "v"(rawN[h][i])); vN[h][i] = (unsigned)tkn * (unsigned)(K * 2) + (unsigned)(gC[i] * 2); }
                    } else {
#pragma unroll
                        for (int h = 0; h < 2; ++h)
#pragma unroll
                            for (int i = 0; i < 2; ++i) vN[h][i] = vA[h][i];
                    }
                }
            }
            unsigned v2[2][2];
#pragma unroll
            for (int h = 0; h < 2; ++h)
#pragma unroll
                for (int i = 0; i < 2; ++i) v2[h][i] = last ? vN[h][i] : vA[h][i];
            if constexpr (SP2) {
            PG8_LDB(B0, 0, 0); PG8_LDB(B1, 0, 1); PG8_SCHED; PG8_LDA(At, 0, 0); PG8_STAGE(PG8_SA(1, 1), a1 + hsA, vA[1]);
            PG8_WAIT_V(8); PG8_WAIT_L(0); PG8_BAR; PG8_MMA(0, 0, At, B0); PG8_MMA(0, 1, At, B1); PG8_BAR; PG8_SCHED;
            PG8_LDA(At, 0, 1); PG8_STAGE(PG8_SB(0, 0), b2, voffB); PG8_STAGE(PG8_SB(0, 1), b2 + hstep, voffB); PG8_STAGE(PG8_SA(0, 0), a2, v2[0]);
            PG8_WAIT_V(8); PG8_WAIT_L(0); PG8_BAR; PG8_MMA(1, 0, At, B0); PG8_MMA(1, 1, At, B1); PG8_BAR; PG8_SCHED;
            PG8_LDB(B0, 1, 0); PG8_LDB(B1, 1, 1); PG8_SCHED; PG8_LDA(At, 1, 0); PG8_STAGE(PG8_SA(0, 1), a2 + hsA, v2[1]);
            PG8_WAIT_V(8); PG8_WAIT_L(0); PG8_BAR; PG8_MMA(0, 0, At, B0); PG8_MMA(0, 1, At, B1); PG8_BAR; PG8_SCHED;
            PG8_LDA(At, 1, 1); PG8_STAGE(PG8_SB(1, 0), b3, voffB); PG8_STAGE(PG8_SB(1, 1), b3 + hstep, voffB); PG8_STAGE(PG8_SA(1, 0), a3, v2[0]);
            PG8_WAIT_V(8); PG8_WAIT_L(0); PG8_BAR; PG8_MMA(1, 0, At, B0); PG8_MMA(1, 1, At, B1); PG8_BAR; PG8_SCHED;
            } else {
            PG8_LDB(B0, 0, 0); PG8_SCHED; PG8_LDA(At, 0, 0); PG8_STAGE(PG8_SA(1, 1), a1 + hsA, vA[1]);
            PG8_WAIT_L(8); PG8_BAR; PG8_WAIT_L(0); PG8_MMA(0, 0, At, B0); PG8_BAR; PG8_SCHED;
            PG8_LDB(B1, 0, 1); PG8_STAGE(PG8_SB(0, 0), b2, voffB);
            PG8_BAR; PG8_WAIT_L(0); PG8_MMA(0, 1, At, B1); PG8_BAR;
            PG8_LDA(At, 0, 1); PG8_STAGE(PG8_SA(0, 0), a2, v2[0]);
            PG8_BAR; PG8_WAIT_L(0); PG8_MMA(1, 0, At, B0); PG8_BAR; PG8_SCHED;
            PG8_STAGE(PG8_SB(0, 1), b2 + hstep, voffB);
            PG8_WAIT_V(6); PG8_BAR; PG8_MMA(1, 1, At, B1); PG8_BAR;
            PG8_LDB(B0, 1, 0); PG8_SCHED; PG8_LDA(At, 1, 0); PG8_STAGE(PG8_SA(0, 1), a2 + hsA, v2[1]);
            PG8_WAIT_L(8); PG8_BAR; PG8_WAIT_L(0); PG8_MMA(0, 0, At, B0); PG8_BAR; PG8_SCHED;
            PG8_LDB(B1, 1, 1); PG8_STAGE(PG8_SB(1, 0), b3, voffB);
            PG8_BAR; PG8_WAIT_L(0); PG8_MMA(0, 1, At, B1); PG8_BAR;
            PG8_LDA(At, 1, 1); PG8_STAGE(PG8_SA(1, 0), a3, v2[0]);
            PG8_BAR; PG8_WAIT_L(0); PG8_MMA(1, 0, At, B0); PG8_BAR; PG8_SCHED;
            PG8_STAGE(PG8_SB(1, 1), b3 + hstep, voffB);
            PG8_WAIT_V(6); PG8_BAR; PG8_MMA(1, 1, At, B1); PG8_BAR;
            }
        }
        if constexpr (ALIGN_EPI) { if (wr == 0) PG8_BAR; }
        if constexpr (!Epi::AFTER_DRAIN) { E(acc, cur, wr, wc, fr, fq); S.done(cur); }
        if (!has_next) break;
#pragma unroll
        for (int a = 0; a < 2; ++a)
#pragma unroll
            for (int b = 0; b < 2; ++b)
#pragma unroll
                for (int m = 0; m < 4; ++m)
#pragma unroll
                    for (int n = 0; n < 2; ++n) acc[a][b][m][n] = (f32x4){0.f, 0.f, 0.f, 0.f};
        cur = nxt; cA = nA; cB = nB; ++ui;
#pragma unroll
        for (int h = 0; h < 2; ++h)
#pragma unroll
            for (int i = 0; i < 2; ++i) vA[h][i] = vN[h][i];
        if constexpr (ALIGN_EPI) { if (wr == 1) PG8_BAR; }
    }
    PG8_WAIT_V(0);
    if constexpr (!ALIGN_EPI) { if (wr == 0) PG8_BAR; }
    PG8_BAR;
    if constexpr (Epi::AFTER_DRAIN) { E.fused(acc, cur, wr, wc, fr, fq, lds, wid, lane); S.done(cur); }
#undef PG8_SA
#undef PG8_SB
#undef PG8_STAGE
#undef PG8_LDA
#undef PG8_LDB
#undef PG8_MMA
#undef PG8_WAIT_V
#undef PG8_WAIT_L
#undef PG8_BAR
#undef PG8_SCHED
}
}
#define GAS __attribute__((address_space(1)))
#define LAS __attribute__((address_space(3)))
typedef unsigned short bf16;
typedef unsigned v4u __attribute__((ext_vector_type(4)));
typedef float f32x4 __attribute__((ext_vector_type(4)));
typedef short bf16x8 __attribute__((ext_vector_type(8)));
typedef GAS unsigned gu32;
typedef GAS unsigned long long gu64;
#define RLX_AGENT __ATOMIC_RELAXED, __HIP_MEMORY_SCOPE_AGENT
#define LDS_WAIT() asm volatile("s_waitcnt lgkmcnt(0)" ::: "memory")
#define VM_WAIT() asm volatile("s_waitcnt vmcnt(0)" ::: "memory")
#define LDS_BAR() do { asm volatile("s_waitcnt lgkmcnt(0)" ::: "memory"); __builtin_amdgcn_s_barrier(); asm volatile("" ::: "memory"); } while (0)
__device__ __forceinline__ unsigned long long rt() { return __builtin_amdgcn_s_memrealtime(); }
__device__ __forceinline__ unsigned f2bf(float f) { unsigned u = __builtin_bit_cast(unsigned, f); return (u + 0x7fffu + ((u >> 16) & 1u)) >> 16; }
__device__ __forceinline__ unsigned pk2(float lo, float hi) { typedef float f2_t __attribute__((ext_vector_type(2))); typedef __bf16 b2_t __attribute__((ext_vector_type(2))); f2_t v = {lo, hi}; b2_t b = __builtin_convertvector(v, b2_t); return __builtin_bit_cast(unsigned, b); }

#define XB_TMO      128
#define XB_XCNT(j)  (256  + 64 * (j))
#define XB_XSUB(j)  (1280 + 64 * (j))
#define XB_XGEN(j)  (2304 + 64 * (j))
#define XB_TOP      3328
#define XB_TOPGEN   3392
#define XCD_BAR_WORDS 3456
#define XB_SPIN_CAP (1u << 18)

__device__ __forceinline__ unsigned xb_ld(unsigned* p)              { return __hip_atomic_load(p, __ATOMIC_RELAXED, __HIP_MEMORY_SCOPE_AGENT); }
__device__ __forceinline__ unsigned xb_add(unsigned* p, unsigned v) { return __hip_atomic_fetch_add(p, v, __ATOMIC_RELAXED, __HIP_MEMORY_SCOPE_AGENT); }
__device__ __forceinline__ unsigned xb_xcc_id() { return (unsigned)__builtin_amdgcn_s_getreg((3 << 11) | 20) & 0xFu; }
#define XB_SPIN(cond, bar) do { unsigned _sp = 0; while (cond) { __builtin_amdgcn_s_sleep(1); \
    if ((++_sp & 255u) == 0u) { if (xb_ld(&(bar)[XB_TMO])) break; if (_sp > XB_SPIN_CAP) { atomicAdd(&(bar)[XB_TMO], 1u); break; } } } } while (0)

struct XcdBarrier {
    unsigned* bar; unsigned x;
    volatile LAS unsigned* st;
};

__device__ __forceinline__ XcdBarrier xcd_barrier_post(unsigned* bar, volatile LAS unsigned* st, const int tid) {
    XcdBarrier b; b.bar = bar; b.x = xb_xcc_id(); b.st = st;
    if (tid == 0) (void)xb_add(&bar[XB_XCNT(b.x)], 1u);
    return b;
}
__device__ __forceinline__ void xcd_barrier_complete(unsigned* bar, unsigned x, unsigned& nloc, unsigned& nx) {
    const unsigned G = gridDim.x * gridDim.y * gridDim.z;
    unsigned sum, cnt, mine, sp = 0u;
    for (;;) {
        sum = 0u; cnt = 0u; mine = 0u;
#pragma unroll 1
        for (unsigned j = 0; j < 16; ++j) { const unsigned c = xb_ld(&bar[XB_XCNT(j)]); sum += c; cnt += (c > 0u) ? 1u : 0u; mine = (j == x) ? c : mine; }
        if (sum == G) break;
        __builtin_amdgcn_s_sleep(1);
        if ((++sp & 255u) == 0u) { if (xb_ld(&bar[XB_TMO])) break; if (sp > XB_SPIN_CAP) { atomicAdd(&bar[XB_TMO], 1u); break; } }
    }
    nloc = mine > 0u ? mine : 1u; nx = cnt > 0u ? cnt : 1u;
}

__device__ __forceinline__ void xcd_barrier(const XcdBarrier& b, const int tid) {
    asm volatile("s_waitcnt vmcnt(0)" ::: "memory");
    __syncthreads();
    if (tid == 0) {
        unsigned* bar = b.bar;
        __builtin_amdgcn_s_waitcnt(0);
        unsigned nloc = b.st[0], nx = b.st[1];
        if (nloc == 0u) { xcd_barrier_complete(bar, b.x, nloc, nx); b.st[0] = nloc; b.st[1] = nx; }
        const unsigned old = xb_add(&bar[XB_XSUB(b.x)], 1u);
        const unsigned gen = old / nloc;
        if (old + 1u == (gen + 1u) * nloc) {
            __builtin_amdgcn_fence(__ATOMIC_RELEASE, "agent");
            asm volatile("s_waitcnt vmcnt(0)" ::: "memory");
            const unsigned og = xb_add(&bar[XB_TOP], 1u);
            const unsigned tg = og / nx;
            if (og + 1u == (tg + 1u) * nx) xb_add(&bar[XB_TOPGEN], 1u);
            else XB_SPIN(xb_ld(&bar[XB_TOPGEN]) == tg, bar);
            __builtin_amdgcn_fence(__ATOMIC_ACQUIRE, "agent");
            xb_add(&bar[XB_XGEN(b.x)], 1u);
            asm volatile("s_waitcnt vmcnt(0)" ::: "memory");
        } else {
            XB_SPIN(xb_ld(&bar[XB_XGEN(b.x)]) == gen, bar);
            __builtin_amdgcn_fence(__ATOMIC_ACQUIRE, "agent");
            asm volatile("s_waitcnt vmcnt(0)" ::: "memory");
        }
    }
    __syncthreads();
}

#include <hip/hip_bf16.h>
#include <cmath>
namespace dsa_body {
using bf16=__hip_bfloat16;
using bf16x8=__attribute__((ext_vector_type(8)))short;
using s16x4=__attribute__((ext_vector_type(4)))short;
using f32x16=__attribute__((ext_vector_type(16)))float;
using u32x4=__attribute__((ext_vector_type(4)))unsigned;
constexpr int SEQ=2048,D=64,DM=64,DMQ=2816,DMO=1024;
constexpr int NW=8,QBLK=32,QB=QBLK*NW,KVBLK=64,NQB=SEQ/QB;
__device__ __forceinline__ int crow(int r,int hi){return (r&3)+8*(r>>2)+4*hi;}
#define SBAR() __builtin_amdgcn_sched_barrier(0)
typedef unsigned u32x2 __attribute__((ext_vector_type(2)));
__device__ __forceinline__ void smask(f32x16&p0,f32x16&p1,u32x2 mk,int hi){
  const int m0=(int)(mk.x>>(4*hi)), m1=(int)(mk.y>>(4*hi));
  #pragma unroll
  for(int r=0;r<16;++r){ const int cb=(r&3)+8*(r>>2);
    const unsigned n0=(unsigned)__builtin_amdgcn_sbfe(m0,cb,1), n1=(unsigned)__builtin_amdgcn_sbfe(m1,cb,1);
    p0[r]=__uint_as_float((__float_as_uint(p0[r])&n0)|(~n0&0xff800000u)); p1[r]=__uint_as_float((__float_as_uint(p1[r])&n1)|(~n1&0xff800000u)); }
}
constexpr int NSLOT=3, SLOTB=8192;
constexpr int LDS_K=0, LDS_V=NSLOT*SLOTB, LDS_WS=2*NSLOT*SLOTB, LDS_OST=LDS_WS+NW*64*4, LDS_BYTES=LDS_OST+NW*4096;
constexpr float C2=0.125f*1.4426950408889634f;
__device__ __forceinline__ void glds16(const void*gsrc,unsigned lds_dst){unsigned keep;
  asm volatile("s_mov_b32 %0, m0\n\ts_mov_b32 m0, %2\n\ts_nop 0\n\tglobal_load_lds_dwordx4 %1, off\n\ts_mov_b32 m0, %0":"=&s"(keep):"v"(gsrc),"s"(lds_dst):"memory");}
__device__ __forceinline__ float max3f(float a,float b,float c){float r;asm("v_max3_f32 %0, %1, %2, %3":"=v"(r):"v"(a),"v"(b),"v"(c));return r;}
__device__ __forceinline__ float max2f(float a,float b){float r;asm("v_max_f32_e32 %0, %1, %2":"=v"(r):"v"(a),"v"(b));return r;}
__device__ __forceinline__ float fadd_s(float a,float b){float r;asm("v_add_f32_e32 %0, %1, %2":"=v"(r):"v"(a),"v"(b));return r;}
__device__ __forceinline__ float fsub_s(float a,float b){float r;asm("v_sub_f32_e32 %0, %1, %2":"=v"(r):"v"(a),"v"(b));return r;}
typedef float f32x2_t __attribute__((ext_vector_type(2))); typedef __bf16 bf16x2_t __attribute__((ext_vector_type(2)));
__device__ __forceinline__ unsigned cvtpk_s(float lo,float hi){f32x2_t v={lo,hi};bf16x2_t b=__builtin_convertvector(v,bf16x2_t);return __builtin_bit_cast(unsigned,b);}
#define WAIT_BAR(N) asm volatile("s_waitcnt vmcnt(" #N ") lgkmcnt(0)\n\ts_barrier":::"memory")

__device__ __forceinline__ void qkt(f32x16&p0,f32x16&p1,const char*Kslot,const bf16x8*qr,const f32x16&negm,int r32,int hi){
  const char*kb=Kslot+hi*1024+r32*16;
  #pragma unroll
  for(int d0=0;d0<4;++d0){
    const bf16x8 b0=*reinterpret_cast<const bf16x8*>(kb+d0*2048);
    const bf16x8 b1=*reinterpret_cast<const bf16x8*>(kb+d0*2048+512);
    if(d0==0){p0=__builtin_amdgcn_mfma_f32_32x32x16_bf16(b0,qr[0],negm,0,0,0);p1=__builtin_amdgcn_mfma_f32_32x32x16_bf16(b1,qr[0],negm,0,0,0);}
    else{p0=__builtin_amdgcn_mfma_f32_32x32x16_bf16(b0,qr[d0],p0,0,0,0);p1=__builtin_amdgcn_mfma_f32_32x32x16_bf16(b1,qr[d0],p1,0,0,0);}}
}
typedef __attribute__((address_space(3))) const char* lds_cptr;
typedef short v4i16_t __attribute__((ext_vector_type(4)));
__device__ __forceinline__ void kload8(bf16x8*kf,lds_cptr kp){
  kf[0]=*(const __attribute__((address_space(3))) bf16x8*)(kp);      kf[1]=*(const __attribute__((address_space(3))) bf16x8*)(kp+512);
  kf[2]=*(const __attribute__((address_space(3))) bf16x8*)(kp+2048); kf[3]=*(const __attribute__((address_space(3))) bf16x8*)(kp+2560);
  kf[4]=*(const __attribute__((address_space(3))) bf16x8*)(kp+4096); kf[5]=*(const __attribute__((address_space(3))) bf16x8*)(kp+4608);
  kf[6]=*(const __attribute__((address_space(3))) bf16x8*)(kp+6144); kf[7]=*(const __attribute__((address_space(3))) bf16x8*)(kp+6656);
}
__device__ __forceinline__ void kload2(bf16x8*kf,lds_cptr kp,int j){ kf[2*j]=*(const __attribute__((address_space(3))) bf16x8*)(kp+j*2048); kf[2*j+1]=*(const __attribute__((address_space(3))) bf16x8*)(kp+j*2048+512); }
__device__ __forceinline__ s16x4 vtr(lds_cptr p){ return __builtin_bit_cast(s16x4,__builtin_amdgcn_ds_read_tr16_b64_v4i16((__attribute__((address_space(3))) v4i16_t*)p)); }
__device__ __forceinline__ float rowmax(const f32x16&p0,const f32x16&p1){
  float a=max3f(p0[0],p0[1],p1[0]),b=max3f(p0[2],p0[3],p1[1]);a=max3f(a,p1[2],p1[3]);
  #pragma unroll
  for(int r=4;r<16;r+=4){a=max3f(a,p0[r],p0[r+1]);b=max3f(b,p0[r+2],p0[r+3]);a=max3f(a,p1[r],p1[r+1]);b=max3f(b,p1[r+2],p1[r+3]);}
  const float m=max2f(a,b);
  auto rr=__builtin_amdgcn_permlane32_swap(__float_as_uint(m),__float_as_uint(m),false,false);
  return max2f(__uint_as_float(rr[0]),__uint_as_float(rr[1]));
}
__device__ __forceinline__ void pv(f32x16*o,int vb,bf16x8 pa0,bf16x8 pa1,bf16x8 pa2,bf16x8 pa3){
  #pragma unroll
  for(int d0=0;d0<2;++d0){s16x4 lo[4],hi[4];
    #pragma unroll
    for(int ks=0;ks<4;++ks){
      asm volatile("ds_read_b64_tr_b16 %0,%1 offset:%c2":"=&v"(lo[ks]):"v"(vb),"i"(d0*4096+ks*1024):"memory");
      asm volatile("ds_read_b64_tr_b16 %0,%1 offset:%c2":"=&v"(hi[ks]):"v"(vb),"i"(d0*4096+ks*1024+512):"memory");}
    asm volatile("s_waitcnt lgkmcnt(0)":::"memory");SBAR();
    #define PK(k) (bf16x8){lo[k][0],lo[k][1],lo[k][2],lo[k][3],hi[k][0],hi[k][1],hi[k][2],hi[k][3]}
    o[d0]=__builtin_amdgcn_mfma_f32_32x32x16_bf16(pa0,PK(0),o[d0],0,0,0);
    o[d0]=__builtin_amdgcn_mfma_f32_32x32x16_bf16(pa1,PK(1),o[d0],0,0,0);
    o[d0]=__builtin_amdgcn_mfma_f32_32x32x16_bf16(pa2,PK(2),o[d0],0,0,0);
    o[d0]=__builtin_amdgcn_mfma_f32_32x32x16_bf16(pa3,PK(3),o[d0],0,0,0);
    #undef PK
  }
}

#ifndef ATTN_STORE16
#define ATTN_STORE16(p,v) (*(u32x4*)(p)=(v))
#endif
template<int THRL> __device__ __forceinline__ void dsa_unit(int b,int u,const bf16*Q,const bf16*__restrict__ K,const bf16*__restrict__ V,bf16*O,const unsigned*MASKW,char*shm,const int tid){
  const int lane=tid&63,r32=lane&31,hi=lane>>5; const int wid=__builtin_amdgcn_readfirstlane(tid>>6);
  const long rowbase=(long)b*SEQ; const int q0=u*32;
  const bf16*Qw=Q+(rowbase+q0+wid*4+(r32>>3))*DMQ+(r32&7)*64;
  const bf16*Kh=K+rowbase*DM,*Vh=V+rowbase*DM;
  const unsigned*mrow=MASKW+(rowbase+q0+wid*4+(r32>>3))*64;
  const unsigned lds0=(unsigned)(uintptr_t)shm;
  float*wsf=(float*)(shm+LDS_WS)+wid*64;
  const bf16*ksrc=Kh+(long)lane*DM+wid*8;
  const bf16*vsrc=Vh+(long)(16*(wid&3)+(lane>>2))*DM+(wid>>2)*32+(lane&3)*8;
  const unsigned kdst=lds0+LDS_K+wid*1024, vdst=lds0+LDS_V+wid*1024;
  #define DMA_K(t,slot) glds16(ksrc+(long)(t)*KVBLK*DM,(unsigned)__builtin_amdgcn_readfirstlane(kdst+(slot)))
  #define DMA_V(t,slot) glds16(vsrc+(long)(t)*KVBLK*DM,(unsigned)__builtin_amdgcn_readfirstlane(vdst+(slot)))
  const int vb0=(int)(lds0+LDS_V)+((lane>>4)&1)*32+(lane&3)*8+(4*hi+((lane&15)>>2))*64;
  const char*Kbase=shm+LDS_K; bf16x8 kf[8];
  const lds_cptr shm3=(lds_cptr)shm; const lds_cptr kp0=shm3+LDS_K+hi*1024+r32*16; const lds_cptr vp0=shm3+LDS_V+((lane>>4)&1)*32+(lane&3)*8+(4*hi+((lane&15)>>2))*64;
  int NT_=(((u>>1)+1)+1)&~1; if(NT_<4)NT_=4; const int NT=NT_;
  u32x2 mraw0,mkn,mkc;
  #define MLOAD(dst,t) asm volatile("global_load_dwordx2 %0, %1, off":"=&v"(dst):"v"(mrow+2*(t)):"memory")
  #define MCOPY(dst,src) asm volatile("v_mov_b32 %0, %2\n\tv_mov_b32 %1, %3":"=&v"(dst.x),"=&v"(dst.y):"v"(src.x),"v"(src.y))
  MLOAD(mraw0,0); MLOAD(mkn,1);
  DMA_K(0,0);DMA_V(0,0);DMA_K(1,SLOTB);
  bf16x8 qr[4];
  #pragma unroll
  for(int d0=0;d0<4;++d0)qr[d0]=*reinterpret_cast<const bf16x8*>(&Qw[d0*16+hi*8]);
  float mhat=0.f,l_reg=0.f;f32x16 o[2];o[0]=f32x16{};o[1]=f32x16{};const f32x16 negm=f32x16{};
  #define CMASK(P0,P1,t) smask(P0,P1,mkc,hi)
  bool resc=false;
  #define START(P0,P1) do{ const float rm=rowmax(P0,P1); resc=false; \
    { const float dl=__any(rm>(float)THRL)?__builtin_fmaxf(rm,0.f):0.f; mhat=fadd_s(mhat,dl); \
      _Pragma("unroll") for(int r=0;r<16;++r){P0[r]=fsub_s(P0[r],dl);P1[r]=fsub_s(P1[r],dl);} \
      } \
    _Pragma("unroll") for(int r=0;r<16;++r)P0[r]=__builtin_amdgcn_exp2f(P0[r]); }while(0)
  #define RESC() do{ if(resc){ asm volatile("s_waitcnt lgkmcnt(0)":::"memory"); \
      _Pragma("unroll") for(int d_=0;d_<2;++d_) _Pragma("unroll") for(int r=0;r<16;++r)o[d_][r]*=wsf[crow(r,hi)]; } }while(0)
  f32x16 pA0,pA1,pB0,pB1;
  int sl_prev=0,sl_cur=0,sl_next=SLOTB;
  #define ROT() do{sl_prev=sl_cur;sl_cur=sl_next;sl_next=(sl_next==(NSLOT-1)*SLOTB)?0:sl_next+SLOTB;}while(0)
  DMA_K(2,2*SLOTB);
  WAIT_BAR(3);
  MCOPY(mkc,mraw0);
  qkt(pA0,pA1,Kbase,qr,negm,r32,hi);asm volatile("s_nop 15\n\ts_nop 7":"+v"(pA0),"+v"(pA1));CMASK(pA0,pA1,0);
  START(pA0,pA1);
  _Pragma("unroll") for(int r=0;r<16;++r)pA1[r]=__builtin_amdgcn_exp2f(pA1[r]);
  WAIT_BAR(0);
  DMA_K(3,0);DMA_V(1,SLOTB);
  ROT();
  kload8(kf,kp0+sl_cur);
  WAIT_BAR(2);
  s16x4 vlo[8],vhi[8]; u32x4 pw0,pw1,pw2,pw3;
  #define PKW(P,B) cvtpk_s(P[B],P[B+1])
  #define PAF(k) __builtin_bit_cast(bf16x8,pw##k)
  #define VFR(i) (bf16x8){vlo[i][0],vlo[i][1],vlo[i][2],vlo[i][3],vhi[i][0],vhi[i][1],vhi[i][2],vhi[i][3]}
  #define PIN(x) asm volatile("":"+v"(x))
  #define MX3(a,b,c) __builtin_fmaxf(__builtin_fmaxf((a),(b)),(c))
  #define GAPA(MF,A0,A1,A2,A3,W0,W1,PW) do{ MF; sacc+=A0; sacc+=A1; sacc+=A2; sacc+=A3; PIN(sacc); W0; W1; PIN(PW); SBAR(); }while(0)
  #define EX(v) __builtin_amdgcn_exp2f(v)
  #define GAPB(MF,X,B) do{ MF; X[B]=EX(X[B]); X[B+1]=EX(X[B+1]); X[B+2]=EX(X[B+2]); X[B+3]=EX(X[B+3]); PIN(X); SBAR(); }while(0)
  #define VRD(i) do{ vlo[i]=vtr(vp_+(((i)>>2)*4096+((i)&3)*1024)); vhi[i]=vtr(vp_+(((i)>>2)*4096+((i)&3)*1024+512)); }while(0)
  #define KRD(G,j) do{ if(G){ kload2(kf,kp0+sl_next,j); SBAR(); } }while(0)
  #define STEP(C0,C1,P0,P1,t,GK,GV,GL) do{ SBAR(); MCOPY(mkc,mkn); if(GV){MLOAD(mkn,(t)+1);} \
    const lds_cptr vp_=vp0+sl_prev; \
    VRD(0); SBAR(); float sacc=(P0[0]+P0[1]); \
    GAPA(C0=__builtin_amdgcn_mfma_f32_32x32x16_bf16(kf[0],qr[0],negm,0,0,0), P0[2],P0[3],P0[4],P0[5],     pw0[0]=PKW(P0,0), pw0[1]=PKW(P0,2), pw0); \
    VRD(4); SBAR(); GAPA(C1=__builtin_amdgcn_mfma_f32_32x32x16_bf16(kf[1],qr[0],negm,0,0,0), P0[6],P0[7],P0[8],P0[9],     pw0[2]=PKW(P0,4), pw0[3]=PKW(P0,6), pw0); \
    VRD(1); SBAR(); GAPA(C0=__builtin_amdgcn_mfma_f32_32x32x16_bf16(kf[2],qr[1],C0,0,0,0),   P0[10],P0[11],P0[12],P0[13], pw1[0]=PKW(P0,8), pw1[1]=PKW(P0,10), pw1); \
    VRD(5); SBAR(); GAPA(C1=__builtin_amdgcn_mfma_f32_32x32x16_bf16(kf[3],qr[1],C1,0,0,0),   P0[14],P0[15],P1[0],P1[1],   pw1[2]=PKW(P0,12),pw1[3]=PKW(P0,14), pw1); \
    VRD(2); SBAR(); GAPA(C0=__builtin_amdgcn_mfma_f32_32x32x16_bf16(kf[4],qr[2],C0,0,0,0),   P1[2],P1[3],P1[4],P1[5],     pw2[0]=PKW(P1,0), pw2[1]=PKW(P1,2), pw2); \
    VRD(6); SBAR(); GAPA(C1=__builtin_amdgcn_mfma_f32_32x32x16_bf16(kf[5],qr[2],C1,0,0,0),   P1[6],P1[7],P1[8],P1[9],     pw2[2]=PKW(P1,4), pw2[3]=PKW(P1,6), pw2); \
    VRD(3); SBAR(); GAPA(C0=__builtin_amdgcn_mfma_f32_32x32x16_bf16(kf[6],qr[3],C0,0,0,0),   P1[10],P1[11],P1[12],P1[13], pw3[0]=PKW(P1,8), pw3[1]=PKW(P1,10), pw3); \
    VRD(7); SBAR(); GAPA(C1=__builtin_amdgcn_mfma_f32_32x32x16_bf16(kf[7],qr[3],C1,0,0,0),   P1[14],P1[15],0.f,0.f,       pw3[2]=PKW(P1,12),pw3[3]=PKW(P1,14), pw3); \
    l_reg+=sacc; \
    if(GK){DMA_K((t)+3,sl_cur);} if(GV){DMA_V((t)+1,sl_next);} \
    CMASK(C0,C1,t); \
    _Pragma("unroll") for(int r=0;r<16;++r){C0[r]-=mhat;C1[r]-=mhat;} \
    { float a=MX3(C0[0],C0[1],C1[0]),b=MX3(C0[2],C0[3],C1[1]); a=MX3(a,C1[2],C1[3]); \
      _Pragma("unroll") for(int r=4;r<16;r+=4){a=MX3(a,C0[r],C0[r+1]);b=MX3(b,C0[r+2],C0[r+3]);a=MX3(a,C1[r],C1[r+1]);b=MX3(b,C1[r+2],C1[r+3]);} \
      float rm=__builtin_fmaxf(a,b); { auto rr=__builtin_amdgcn_permlane32_swap(__float_as_uint(rm),__float_as_uint(rm),false,false); rm=__builtin_fmaxf(__uint_as_float(rr[0]),__uint_as_float(rr[1])); } \
      resc=false; \
      if(__builtin_expect(__any(rm>(float)THRL),0)){ const float dl=__builtin_fmaxf(rm,0.f); mhat+=dl; \
        _Pragma("unroll") for(int r=0;r<16;++r){C0[r]-=dl;C1[r]-=dl;} \
        const float f=__builtin_amdgcn_exp2f(-dl); l_reg*=f; if(hi==0)wsf[r32]=f; resc=true; } } \
    SBAR(); \
    GAPB(o[0]=__builtin_amdgcn_mfma_f32_32x32x16_bf16(PAF(0),VFR(0),o[0],0,0,0), C0,0); \
    GAPB(o[1]=__builtin_amdgcn_mfma_f32_32x32x16_bf16(PAF(0),VFR(4),o[1],0,0,0), C0,4); \
    KRD(GL,0); GAPB(o[0]=__builtin_amdgcn_mfma_f32_32x32x16_bf16(PAF(1),VFR(1),o[0],0,0,0), C0,8); \
    KRD(GL,1); GAPB(o[1]=__builtin_amdgcn_mfma_f32_32x32x16_bf16(PAF(1),VFR(5),o[1],0,0,0), C0,12); \
    KRD(GL,2); GAPB(o[0]=__builtin_amdgcn_mfma_f32_32x32x16_bf16(PAF(2),VFR(2),o[0],0,0,0), C1,0); \
    KRD(GL,3); GAPB(o[1]=__builtin_amdgcn_mfma_f32_32x32x16_bf16(PAF(2),VFR(6),o[1],0,0,0), C1,4); \
    GAPB(o[0]=__builtin_amdgcn_mfma_f32_32x32x16_bf16(PAF(3),VFR(3),o[0],0,0,0), C1,8); \
    GAPB(o[1]=__builtin_amdgcn_mfma_f32_32x32x16_bf16(PAF(3),VFR(7),o[1],0,0,0), C1,12); \
    }while(0)
  int t=1;
  for(;t+5<NT;t+=2){
    STEP(pB0,pB1,pA0,pA1,t,true,true,true);     WAIT_BAR(2); RESC(); ROT();
    STEP(pA0,pA1,pB0,pB1,t+1,true,true,true);   WAIT_BAR(2); RESC(); ROT();
  }
  #define ENDW(tt) do{ if((tt)+3<NT){WAIT_BAR(2);} else if((tt)+2<NT){WAIT_BAR(1);} else {WAIT_BAR(0);} }while(0)
  for(;t+1<NT;t+=2){
    STEP(pB0,pB1,pA0,pA1,t,(t+3<NT),(t+1<NT),(t+1<NT));       ENDW(t);   RESC(); ROT();
    STEP(pA0,pA1,pB0,pB1,t+1,(t+4<NT),(t+2<NT),(t+2<NT));     ENDW(t+1); RESC(); ROT();
  }
  STEP(pB0,pB1,pA0,pA1,NT-1,false,false,false); RESC();
  { float sacc=pB0[0]+pB0[1]; _Pragma("unroll") for(int r=2;r<16;++r)sacc+=pB0[r]; _Pragma("unroll") for(int r=0;r<16;++r)sacc+=pB1[r]; l_reg+=sacc;
    pw0=(u32x4){PKW(pB0,0),PKW(pB0,2),PKW(pB0,4),PKW(pB0,6)};pw1=(u32x4){PKW(pB0,8),PKW(pB0,10),PKW(pB0,12),PKW(pB0,14)};pw2=(u32x4){PKW(pB1,0),PKW(pB1,2),PKW(pB1,4),PKW(pB1,6)};pw3=(u32x4){PKW(pB1,8),PKW(pB1,10),PKW(pB1,12),PKW(pB1,14)};
    SBAR(); pv(o,vb0+sl_cur,PAF(0),PAF(1),PAF(2),PAF(3)); }
  #undef PKW
  #undef PAF
  #undef VFR
  #undef PIN
  #undef MX3
  #undef GAPA
  #undef GAPB
  #undef EX
  #undef VRD
  #undef KRD
  #undef STEP
  #undef ENDW
  {auto rr=__builtin_amdgcn_permlane32_swap(__float_as_uint(l_reg),__float_as_uint(l_reg),false,false);l_reg=__uint_as_float(rr[0])+__uint_as_float(rr[1]);}
  if(hi==0)wsf[32+r32]=l_reg;asm volatile("s_waitcnt lgkmcnt(0)":::"memory");
  float rli[16];
  #pragma unroll
  for(int r=0;r<16;++r)rli[r]=__builtin_amdgcn_rcpf(wsf[32+crow(r,hi)]);
  bf16*Ow=O+(rowbase+q0+wid*4)*DMO;
  { bf16*stg=(bf16*)(shm+LDS_OST)+wid*2048;
    #pragma unroll
    for(int r=0;r<16;++r){const int orow=crow(r,hi);
      #pragma unroll
      for(int d0=0;d0<2;++d0)stg[orow*64+d0*32+r32]=__float2bfloat16(o[d0][r]*rli[r]);}
    asm volatile("s_waitcnt lgkmcnt(0)":::"memory");
    #pragma unroll
    for(int i=0;i<4;++i){const int row=i*8+(lane>>3),ch=lane&7; const u32x4 v=*(const u32x4*)(stg+row*64+ch*8); ATTN_STORE16(Ow+(long)(row>>3)*DMO+(row&7)*64+ch*8,v);} }
  asm volatile("s_waitcnt lgkmcnt(0)\n\ts_barrier":::"memory");
  #undef DMA_K
  #undef DMA_V
  #undef CMASK
  #undef MLOAD
  #undef MCOPY
  #undef START
  #undef RESC
  #undef ROT
}
constexpr int ATTN_LDS_BYTES=LDS_BYTES;
template<int THRL=8> __device__ __forceinline__ void dsa_attn_phase(char*lds,const bf16*Pq,const bf16*KD,const bf16*VD,bf16*MIXp,const unsigned*MASKW,int vcu,int ncu,int tid){
  for(int v=vcu;v<16*16;v+=ncu){
    const int b=v>>4, s=v&15;
    #pragma unroll 1
    for(int i=0;i<4;++i){ const int u=(i==0)?s:(i==1)?63-s:(i==2)?31-s:32+s;
      dsa_unit<THRL>(b,u,Pq,KD,VD,MIXp,MASKW,lds,tid); }
  }
}
#undef SBAR
#undef WAIT_BAR
}

constexpr int NWAVES = 8, NTHR = 512;
constexpr int BATCH = 16, SEQ = 2048, D = 1024, M = BATCH * SEQ;
constexpr int EIN = 2776, EINP = 2816, FF = 2816, NEXP = 8;
constexpr int PC_AQ = 0, PC_CKV = 512, PC_QI = 640, PC_KI = 1152, PC_WI = 1216, PC_BQ = 1224, PC_BK = 1480, PC_BV = 1736, PC_BG = 2248, PC_BR = 2264;
constexpr float ALPHA = 1.6817928305074290f;
constexpr float LN_EPS = 1e-5f, RMS_EPS = 1e-6f;
constexpr float C2 = 0.125f * 1.4426950408889634f;
constexpr int MOE_ROWS = 2 * M + NEXP * 256;
constexpr int TOPK = 256;

constexpr size_t MiB = 1u << 20;
constexpr size_t WS_CTL = 0, CTL_ZERO_BYTES = 256 * 1024;
constexpr size_t WS_XSTAT = 1u << 20;
constexpr int CW_PANEL = 16384;
constexpr size_t WS_WB = 2 * MiB;
constexpr size_t WB_WIN = 0, WB_WOUT = 6 * MiB, WB_WGU = 8 * MiB, WB_WDN = 20 * MiB;
constexpr size_t WB_WQKV = 0, WB_MGU = 8 * MiB, WB_MDN = 96 * MiB;
constexpr size_t WS_XB = 146 * MiB;
constexpr size_t WS_P = 210 * MiB, WS_HID = 210 * MiB, WS_MIX = 386 * MiB;
constexpr size_t WS_KD = 450 * MiB, WS_VD = 454 * MiB, WS_KI = 458 * MiB, WS_MASK = 462 * MiB;
constexpr size_t WS_GST = 470 * MiB, WS_H_EVEN = 470 * MiB;
constexpr size_t WS_QT = 534 * MiB, WS_KT = 550 * MiB, WS_EBL = 582 * MiB, WS_SC = 584 * MiB;
constexpr size_t WS_QKV = 210 * MiB, WS_AO = 402 * MiB, WS_MIXO = 530 * MiB, WS_H_ODD = 594 * MiB;
constexpr size_t WS_XPERM = 210 * MiB, WS_HIDP = 342 * MiB;
constexpr size_t WS_ROUTE = 722 * MiB, WS_INV = 723 * MiB, WS_CNTT = 723 * MiB + 512 * 1024  , WS_END = 724 * MiB;
constexpr int CW_TMO = 0, CW_CNT = 64  , CW_BAR = 4096;

constexpr int RING_BYTES = 131072, LDSCTL_OFF = RING_BYTES, MISC_OFF = LDSCTL_OFF + 320, LDS_BYTES = 147456;
constexpr int XTRA_OFF = MISC_OFF + 128;

__device__ __forceinline__ float bf2f(unsigned short u) { return __uint_as_float((unsigned)u << 16); }
__device__ __forceinline__ float bflo(unsigned w) { return __uint_as_float(w << 16); }
__device__ __forceinline__ float bfhi(unsigned w) { return __uint_as_float(w & 0xffff0000u); }
__device__ __forceinline__ float wave_sum_fd(float v);
__device__ __forceinline__ float wave_sum(float v) { return wave_sum_fd(v); }
__device__ __forceinline__ float wave_sum_l(float v, int lane) {
#pragma unroll
    for (int o = 1; o < 64; o <<= 1) v += __int_as_float(__builtin_amdgcn_ds_bpermute((lane ^ o) << 2, __float_as_int(v)));
    return v;
}
__device__ __forceinline__ int hw_lane() { int ln; asm volatile("v_mbcnt_lo_u32_b32 %0, -1, 0\n\tv_mbcnt_hi_u32_b32 %0, -1, %0" : "=v"(ln)); return ln & 63; }
__device__ __forceinline__ float wave_sum_fd(float v) {
    v += __int_as_float(__builtin_amdgcn_mov_dpp(__float_as_int(v), 0xB1, 0xF, 0xF, true));
    v += __int_as_float(__builtin_amdgcn_mov_dpp(__float_as_int(v), 0x4E, 0xF, 0xF, true));
    v += __int_as_float(__builtin_amdgcn_mov_dpp(__float_as_int(v), 0x141, 0xF, 0xF, true));
    v += __int_as_float(__builtin_amdgcn_mov_dpp(__float_as_int(v), 0x140, 0xF, 0xF, true));
    const int b = __float_as_int(v);
    return (__int_as_float(__builtin_amdgcn_readlane(b, 0)) + __int_as_float(__builtin_amdgcn_readlane(b, 16))) + (__int_as_float(__builtin_amdgcn_readlane(b, 32)) + __int_as_float(__builtin_amdgcn_readlane(b, 48)));
}
__device__ __forceinline__ float wave_max(float v) {
#pragma unroll
    for (int o = 1; o < 64; o <<= 1) v = fmaxf(v, __shfl_xor(v, o));
    return v;
}
__device__ __forceinline__ int wave_sum_i(int v) {
#pragma unroll
    for (int o = 1; o < 64; o <<= 1) v += __shfl_xor(v, o);
    return v;
}
__device__ __forceinline__ int wave_incl_scan_i(int v, int lane) {
#pragma unroll
    for (int o = 1; o < 64; o <<= 1) { const int t = __shfl_up(v, o); if (lane >= o) v += t; }
    return v;
}
__device__ __forceinline__ void ld8bf(const bf16* p, float* f) {
    const v4u w = *(const v4u*)p;
    f[0] = bflo(w.x); f[1] = bfhi(w.x); f[2] = bflo(w.y); f[3] = bfhi(w.y); f[4] = bflo(w.z); f[5] = bfhi(w.z); f[6] = bflo(w.w); f[7] = bfhi(w.w);
}
__device__ __forceinline__ float silu_f(float x) { return x * __builtin_amdgcn_rcpf(1.0f + __builtin_amdgcn_exp2f(-1.4426950408889634f * x)); }

struct Frame {
    LAS unsigned char* lds;
    volatile LAS unsigned* MISC;
    gu32* ctl;
    int tid, lane, wave, G, gw, NGW, bx, wave0;
    unsigned char* ws;
    const __attribute__((address_space(4))) unsigned char* kp;
    __device__ __forceinline__ const float* inp(int i) const { typedef const float* cfp; return *(const __attribute__((address_space(4))) cfp*)(kp + 8 * i); }
    __device__ __forceinline__ float* outp() const { typedef float* fp; return *(const __attribute__((address_space(4))) fp*)(kp + 272); }
};

namespace pg8 {
struct EpiSwiGLU {
    static constexpr bool PERM = true, AFTER_DRAIN = false;
    bf16_t* O; int ldc;
    __device__ __forceinline__ void operator()(const f32x4 (&acc)[2][2][4][2], const Unit& u, int wr, int wc, int fr, int fq) const {
        const int row0 = u.pm * BM + wr * 64 + fr, col0 = u.pn * HALF + wc * 32 + 8 * fq;
#pragma unroll
        for (int ai = 0; ai < 2; ++ai)
#pragma unroll
            for (int m = 0; m < 4; ++m) {
                bf16_t* rowp = O + (size_t)(row0 + ai * HALF + m * 16) * ldc + col0;
                const f32x4 g0 = acc[ai][0][m][0], g1 = acc[ai][0][m][1], u0 = acc[ai][1][m][0], u1 = acc[ai][1][m][1];
                u32x4 w;
                w.x = cvt_pk_bf16(silu_f(g0[0]) * u0[0], silu_f(g0[1]) * u0[1]); w.y = cvt_pk_bf16(silu_f(g0[2]) * u0[2], silu_f(g0[3]) * u0[3]);
                w.z = cvt_pk_bf16(silu_f(g1[0]) * u1[0], silu_f(g1[1]) * u1[1]); w.w = cvt_pk_bf16(silu_f(g1[2]) * u1[2], silu_f(g1[3]) * u1[3]);
                *(u32x4*)rowp = w;
            }
    }
};
struct MoeOrder {
    StaticOrder so; int tb[NEXP + 1]; int nN;
    __device__ __forceinline__ void init(const unsigned* cnt, int nN_, int G, int c) {
        tb[0] = 0;
#pragma unroll
        for (int e = 0; e < NEXP; ++e) tb[e + 1] = tb[e] + (int)((__builtin_amdgcn_readfirstlane(cnt[e]) + 255u) >> 8);
        nN = nN_; so.nM = tb[NEXP]; so.nN = nN_; so.nwg = so.nM * nN_; so.G = G; so.c = c; so.lim = so.nwg;
    }
    __device__ __forceinline__ void cut_tail() { const int tail = so.nwg % so.G; if (tail * 16 <= 2 * so.G) so.lim = so.nwg - tail; }
    __device__ __forceinline__ bool next(int i, Unit& u) const {
        if (!so.next(i, u)) return false;
        int e = 0;
#pragma unroll
        for (int k = 1; k < NEXP; ++k) e += (u.pm >= tb[k]) ? 1 : 0;
        u.pb = e * nN + u.pn; return true;
    }
    __device__ __forceinline__ bool at(long L, Unit& u) const {
        if (!so.at(L, u)) return false;
        int e = 0;
#pragma unroll
        for (int k = 1; k < NEXP; ++k) e += (u.pm >= tb[k]) ? 1 : 0;
        u.pb = e * nN + u.pn; return true;
    }
    __device__ __forceinline__ void a_ready(const Unit&) const {}
    __device__ __forceinline__ void done(const Unit&) const {}
};
struct PanelOrder {
    int nM, c;
    __device__ __forceinline__ void init(int M, int c_) { nM = M / BM; c = c_; }
    __device__ __forceinline__ bool next(int i, Unit& u) const { const int j = c >> 3, pm = i * 64 + (c & 7) * 8 + (j >> 2); if (pm >= nM) return false; u.pm = pm; u.pn = j & 3; u.pb = u.pn; return true; }
    __device__ __forceinline__ void a_ready(const Unit&) const {}
    __device__ __forceinline__ void done(const Unit&) const {}
};
struct EpiLnFused {
    static constexpr bool PERM = true, AFTER_DRAIN = false;
    bf16_t* X; const float* g; const float* b; unsigned long long* xbuf; unsigned* cnt; unsigned* tmo; PG8_LAS unsigned char* tl;
    __device__ __forceinline__ void operator()(f32x4 (&acc)[2][2][4][2], const Unit& u, int wr, int wc, int fr, int fq) const {
        typedef float f32x2v __attribute__((ext_vector_type(2)));
        const int wid = wr * 4 + wc, lane = fq * 16 + fr;
        PG8_LAS f32x2v* P = (PG8_LAS f32x2v*)tl;
        PG8_LAS f32x2v* S = (PG8_LAS f32x2v*)(tl + 8192);
        bf16_t* xb0 = X + (size_t)(u.pm * BM + wr * 64 + fr) * 1024 + u.pn * BM + wc * 32 + 8 * fq;
        {
            u32x4 xw[2][4][2];
#pragma unroll
            for (int ai = 0; ai < 2; ++ai)
#pragma unroll
                for (int m = 0; m < 4; ++m)
#pragma unroll
                    for (int bj = 0; bj < 2; ++bj) xw[ai][m][bj] = *(const u32x4*)(xb0 + (size_t)(ai * HALF + m * 16) * 1024 + bj * HALF);
#pragma unroll
            for (int ai = 0; ai < 2; ++ai)
#pragma unroll
                for (int m = 0; m < 4; ++m)
#pragma unroll
                    for (int bj = 0; bj < 2; ++bj) { const u32x4 w = xw[ai][m][bj];
                        acc[ai][bj][m][0] += (f32x4){bflo(w.x), bfhi(w.x), bflo(w.y), bfhi(w.y)} * ALPHA; acc[ai][bj][m][1] += (f32x4){bflo(w.z), bfhi(w.z), bflo(w.w), bfhi(w.w)} * ALPHA; }
            asm volatile("" ::: "memory");
        }
#pragma unroll
        for (int ai = 0; ai < 2; ++ai)
#pragma unroll
            for (int m = 0; m < 4; ++m) {
                float s = 0.f;
#pragma unroll
                for (int bj = 0; bj < 2; ++bj)
#pragma unroll
                    for (int n = 0; n < 2; ++n) { const f32x4 x = acc[ai][bj][m][n]; s += (x[0] + x[1]) + (x[2] + x[3]); }
                s += __int_as_float(__builtin_amdgcn_ds_bpermute((lane ^ 16) << 2, __float_as_int(s))); s += __int_as_float(__builtin_amdgcn_ds_bpermute((lane ^ 32) << 2, __float_as_int(s)));
                const float mw = s * (1.0f / 64.0f); float q = 0.f;
#pragma unroll
                for (int bj = 0; bj < 2; ++bj)
#pragma unroll
                    for (int n = 0; n < 2; ++n) { const f32x4 d = acc[ai][bj][m][n] - mw; q += (d[0] * d[0] + d[1] * d[1]) + (d[2] * d[2] + d[3] * d[3]); }
                q += __int_as_float(__builtin_amdgcn_ds_bpermute((lane ^ 16) << 2, __float_as_int(q))); q += __int_as_float(__builtin_amdgcn_ds_bpermute((lane ^ 32) << 2, __float_as_int(q)));
                if (fq == 0) P[(ai * HALF + wr * 64 + m * 16 + fr) * 4 + wc] = (f32x2v){mw, q};
            }
        asm volatile("s_waitcnt lgkmcnt(0)" ::: "memory"); __builtin_amdgcn_s_barrier(); asm volatile("" ::: "memory");
        const int row = wid * 32 + (lane & 31);
        if (lane < 32) {
            const f32x2v a = P[row * 4 + 0], b2 = P[row * 4 + 1], c2 = P[row * 4 + 2], d = P[row * 4 + 3];
            const float mt = (a.x + b2.x + c2.x + d.x) * 0.25f;
            const float da = a.x - mt, db = b2.x - mt, dc = c2.x - mt, dd = d.x - mt;
            const float m2 = (a.y + b2.y) + (c2.y + d.y) + 64.0f * ((da * da + db * db) + (dc * dc + dd * dd));
            unsigned long long* slot = xbuf + ((size_t)(u.pm * BM + row) * 4 + u.pn);
            __hip_atomic_store(slot, ((unsigned long long)__float_as_uint(m2) << 32) | __float_as_uint(mt), __ATOMIC_RELAXED, __HIP_MEMORY_SCOPE_AGENT);
        }
        asm volatile("s_waitcnt vmcnt(0)" ::: "memory");
        if (lane == 0) __hip_atomic_fetch_add(cnt + 64 * u.pm, 1u, __ATOMIC_RELAXED, __HIP_MEMORY_SCOPE_AGENT);
        if (wid == 0) {
            unsigned sp = 0u;
            while ((unsigned)__builtin_amdgcn_readfirstlane(__hip_atomic_load(cnt + 64 * u.pm, __ATOMIC_RELAXED, __HIP_MEMORY_SCOPE_AGENT)) < 32u) {
                __builtin_amdgcn_s_sleep(2);
                if (++sp > (1u << 17)) { if (lane == 0) __hip_atomic_store(tmo, 1u, __ATOMIC_RELAXED, __HIP_MEMORY_SCOPE_AGENT); break; }
            }
            __builtin_amdgcn_fence(__ATOMIC_ACQUIRE, "agent");
        }
        asm volatile("s_waitcnt vmcnt(0) lgkmcnt(0)" ::: "memory"); __builtin_amdgcn_s_barrier(); asm volatile("" ::: "memory");
        if (lane < 32) {
            const unsigned long long* slot = xbuf + (size_t)(u.pm * BM + row) * 4; float mt[4], m2[4]; float ms = 0.f;
#pragma unroll
            for (int t = 0; t < 4; ++t) { const unsigned long long w = __hip_atomic_load(slot + t, __ATOMIC_RELAXED, __HIP_MEMORY_SCOPE_AGENT); mt[t] = __uint_as_float((unsigned)w); m2[t] = __uint_as_float((unsigned)(w >> 32)); ms += mt[t]; }
            const float mean = ms * 0.25f; float q = 0.f;
#pragma unroll
            for (int t = 0; t < 4; ++t) { const float dm = mt[t] - mean; q += m2[t] + 256.0f * dm * dm; }
            S[row] = (f32x2v){mean, 1.0f / sqrtf(q * (1.0f / 1024.0f) + LN_EPS)};
        }
        asm volatile("s_waitcnt lgkmcnt(0)" ::: "memory"); __builtin_amdgcn_s_barrier(); asm volatile("" ::: "memory");
        const int colg = u.pn * BM + wc * 32 + 8 * fq;
        f32x4 gv[2][2], bv[2][2];
#pragma unroll
        for (int bj = 0; bj < 2; ++bj)
#pragma unroll
            for (int n = 0; n < 2; ++n) { gv[bj][n] = *(const f32x4*)(g + colg + bj * HALF + 4 * n); bv[bj][n] = *(const f32x4*)(b + colg + bj * HALF + 4 * n); }
#pragma unroll
        for (int ai = 0; ai < 2; ++ai)
#pragma unroll
            for (int m = 0; m < 4; ++m) { const f32x2v sr = S[ai * HALF + wr * 64 + m * 16 + fr];
#pragma unroll
                for (int bj = 0; bj < 2; ++bj) {
                    const f32x4 v0 = (acc[ai][bj][m][0] - sr.x) * sr.y * gv[bj][0] + bv[bj][0], v1 = (acc[ai][bj][m][1] - sr.x) * sr.y * gv[bj][1] + bv[bj][1];
                    u32x4 w; w.x = cvt_pk_bf16(v0[0], v0[1]); w.y = cvt_pk_bf16(v0[2], v0[3]); w.z = cvt_pk_bf16(v1[0], v1[1]); w.w = cvt_pk_bf16(v1[2], v1[3]);
                    *(u32x4*)(xb0 + (size_t)(ai * HALF + m * 16) * 1024 + bj * HALF) = w; } }
    }
};
}

__device__ __forceinline__ void cvt_item(const float* W, int K, int N, bf16* WT, int mode, int rowbase, int item, int nblk, int lane) {
    const int kb = item / nblk, nb = item - kb * nblk, k0 = 32 * kb, n = 64 * nb + lane;
    const bool ok = n < N;
    const float* src = W + (size_t)k0 * N + (ok ? n : 0);
    float v[32];
#pragma unroll
    for (int i = 0; i < 32; ++i) v[i] = __builtin_nontemporal_load(src + (size_t)i * N);
    const int row = (mode == 0) ? n : ((n >> 7) * 256 + (n & 127) + (mode == 2 ? 128 : 0));
    bf16* dst = WT + (size_t)(rowbase + row) * K + k0;
#pragma unroll
    for (int g = 0; g < 4; ++g) { v4u o;
        o.x = ok ? pk2(v[8 * g], v[8 * g + 1]) : 0u; o.y = ok ? pk2(v[8 * g + 2], v[8 * g + 3]) : 0u; o.z = ok ? pk2(v[8 * g + 4], v[8 * g + 5]) : 0u; o.w = ok ? pk2(v[8 * g + 6], v[8 * g + 7]) : 0u;
        *(GAS v4u*)(dst + 8 * g) = o; }
}
__device__ __forceinline__ void cvt_even(Frame& F, int j) {
    bf16* wb = (bf16*)(F.ws + WS_WB);
    const float* w_in = F.inp(1) + (size_t)j * D * EIN; const float* w_out = F.inp(10) + (size_t)j * D * D;
    const float* w_g = F.inp(13) + (size_t)j * D * FF; const float* w_u = F.inp(14) + (size_t)j * D * FF; const float* w_d = F.inp(15) + (size_t)j * FF * D;
    constexpr int I_IN = 32 * 44, I_OUT = 32 * 16, I_G = 32 * 44, I_D = 88 * 16, TOT = I_IN + I_OUT + 2 * I_G + I_D;
    for (int it = F.gw; it < TOT; it += F.NGW) {
        int r = it;
        if (r < I_IN) { cvt_item(w_in, D, EIN, wb + WB_WIN / 2, 0, 0, r, 44, F.lane); continue; } r -= I_IN;
        if (r < I_OUT) { cvt_item(w_out, D, D, wb + WB_WOUT / 2, 0, 0, r, 16, F.lane); continue; } r -= I_OUT;
        if (r < I_G) { cvt_item(w_g, D, FF, wb + WB_WGU / 2, 1, 0, r, 44, F.lane); continue; } r -= I_G;
        if (r < I_G) { cvt_item(w_u, D, FF, wb + WB_WGU / 2, 2, 0, r, 44, F.lane); continue; } r -= I_G;
        cvt_item(w_d, FF, D, wb + WB_WDN / 2, 0, 0, r, 16, F.lane);
    }
}
__device__ __forceinline__ void cvt_odd(Frame& F, int j) {
    bf16* wb = (bf16*)(F.ws + WS_WB);
    const float* w_qkv = F.inp(18) + (size_t)j * D * 3072; const float* w_out = F.inp(24) + (size_t)j * D * D;
    const float* w_g = F.inp(29) + (size_t)j * NEXP * D * FF; const float* w_u = F.inp(30) + (size_t)j * NEXP * D * FF; const float* w_d = F.inp(31) + (size_t)j * NEXP * FF * D;
    constexpr int I_QKV = 32 * 48, I_OUT = 32 * 16, I_E = 1408, TOT = I_QKV + I_OUT + 24 * I_E;
    for (int it = F.gw; it < TOT; it += F.NGW) {
        int r = it;
        if (r < I_QKV) { cvt_item(w_qkv, D, 3072, wb + WB_WQKV / 2, 0, 0, r, 48, F.lane); continue; } r -= I_QKV;
        if (r < I_OUT) { cvt_item(w_out, D, D, wb + WB_WOUT / 2, 0, 0, r, 16, F.lane); continue; } r -= I_OUT;
        const int mat = r / I_E, item = r - mat * I_E, kind = mat >> 3, e = mat & 7;
        if (kind == 0) cvt_item(w_g + (size_t)e * D * FF, D, FF, wb + WB_MGU / 2, 1, e * 5632, item, 44, F.lane);
        else if (kind == 1) cvt_item(w_u + (size_t)e * D * FF, D, FF, wb + WB_MGU / 2, 2, e * 5632, item, 44, F.lane);
        else cvt_item(w_d + (size_t)e * FF * D, FF, D, wb + WB_MDN / 2, 0, e * 1024, item, 16, F.lane);
    }
}
__device__ __forceinline__ void xb_from_x(Frame& F) {
    const float* x = F.inp(0); bf16* xb = (bf16*)(F.ws + WS_XB);
    for (int m = F.gw; m < M; m += F.NGW) {
        const GAS f32x4* xr = (const GAS f32x4*)(x + (size_t)m * D) + F.lane;
        GAS unsigned long long* o8 = (GAS unsigned long long*)(xb + (size_t)m * D) + F.lane;
#pragma unroll
        for (int j = 0; j < 4; ++j) { const f32x4 v = xr[64 * j]; o8[64 * j] = (unsigned long long)pk2(v.x, v.y) | ((unsigned long long)pk2(v.z, v.w) << 32); }
    }
}

template <int MODE, bool XBF>
__device__ __forceinline__ void ln_load(f32x4 (&v)[4], int m, int lane, const float* xin, const bf16* xb, const bf16* Hb, const int* r_p, const float* r_g) {
    f32x4 xv4[4];
    if (XBF) { const GAS unsigned long long* xr8 = (const GAS unsigned long long*)(xb + (size_t)m * D) + lane;
#pragma unroll
        for (int j = 0; j < 4; ++j) { const unsigned long long xw = xr8[64 * j]; const unsigned lo = (unsigned)xw, hi = (unsigned)(xw >> 32); xv4[j] = (f32x4){bflo(lo), bfhi(lo), bflo(hi), bfhi(hi)}; } }
    else { const GAS f32x4* xr = (const GAS f32x4*)(xin + (size_t)m * D) + lane;
#pragma unroll
        for (int j = 0; j < 4; ++j) xv4[j] = xr[64 * j]; }
    if (MODE == 0) {
        const GAS unsigned long long* hr = (const GAS unsigned long long*)(Hb + (size_t)m * D) + lane;
#pragma unroll
        for (int j = 0; j < 4; ++j) { const f32x4 xv = xv4[j]; const unsigned long long hw = hr[64 * j]; const unsigned lo = (unsigned)hw, hi = (unsigned)(hw >> 32);
            v[j].x = ALPHA * xv.x + bflo(lo); v[j].y = ALPHA * xv.y + bfhi(lo); v[j].z = ALPHA * xv.z + bflo(hi); v[j].w = ALPHA * xv.w + bfhi(hi); }
    } else {
        const int p0 = r_p[2 * m], p1 = r_p[2 * m + 1]; const float g0 = r_g[2 * m], g1 = r_g[2 * m + 1];
        const GAS unsigned long long* h0 = (const GAS unsigned long long*)(Hb + (size_t)p0 * D) + lane;
        const GAS unsigned long long* h1 = (const GAS unsigned long long*)(Hb + (size_t)p1 * D) + lane;
#pragma unroll
        for (int j = 0; j < 4; ++j) { const f32x4 xv = xv4[j]; const unsigned long long a = h0[64 * j], c = h1[64 * j];
            const unsigned al = (unsigned)a, ah = (unsigned)(a >> 32), cl = (unsigned)c, ch = (unsigned)(c >> 32);
            v[j].x = ALPHA * xv.x + (g0 * bflo(al) + g1 * bflo(cl)); v[j].y = ALPHA * xv.y + (g0 * bfhi(al) + g1 * bfhi(cl));
            v[j].z = ALPHA * xv.z + (g0 * bflo(ah) + g1 * bflo(ch)); v[j].w = ALPHA * xv.w + (g0 * bfhi(ah) + g1 * bfhi(ch)); }
    }
}
template <int MODE, bool ROUTER, bool XBF  , bool WRITE_F32>
__device__ __forceinline__ void ln_phase(Frame& F, const float* xin, const bf16* Hb, const float* g, const float* b, float* xout, bf16* xb,
                                         const float* rw, const float* rb, int lslot) {
    int* r_e = (int*)(F.ws + WS_ROUTE); float* r_g = (float*)(F.ws + WS_ROUTE + 256 * 1024); int* r_i = (int*)(F.ws + WS_ROUTE + 512 * 1024); int* r_p = (int*)(F.ws + WS_ROUTE + 768 * 1024);
    LAS float* wr = (LAS float*)F.lds;
    LAS int* lcnt = (LAS int*)(F.lds + 32768);
    LAS int* lrk = (LAS int*)(F.lds + 32768 + 64);
    LAS int* lex = (LAS int*)(F.lds + 32768 + 64 + 4096);
    LAS int* wbase = (LAS int*)(F.lds + 32768 + 32);
    const int r0 = (int)((long)F.bx * M / F.G), r1 = (int)((long)(F.bx + 1) * M / F.G);
    if (ROUTER) {
        for (int i = F.tid; i < D * NEXP; i += NTHR) wr[i] = rw[i];
        if (F.tid < 8) lcnt[F.tid] = 0;
        __syncthreads();
    }
    f32x4 gg[4], bb[4];
#pragma unroll
    for (int j = 0; j < 4; ++j) { gg[j] = *((const GAS f32x4*)g + F.lane + 64 * j); bb[j] = *((const GAS f32x4*)b + F.lane + 64 * j); }
    f32x4 v[4], vn[4];
    int m = r0 + F.wave;
    if (m < r1) ln_load<MODE, XBF>(v, m, F.lane, xin, xb, Hb, r_p, r_g);
    for (; m < r1; m += NWAVES) {
        const bool more = m + NWAVES < r1;
        if (more) ln_load<MODE, XBF>(vn, m + NWAVES, F.lane, xin, xb, Hb, r_p, r_g);
        float s = 0.f;
#pragma unroll
        for (int j = 0; j < 4; ++j) s += (v[j].x + v[j].y) + (v[j].z + v[j].w);
        const float mean = wave_sum_fd(s) * (1.f / D); float s2 = 0.f;
#pragma unroll
        for (int j = 0; j < 4; ++j) { v[j] = v[j] - mean; s2 += (v[j].x * v[j].x + v[j].y * v[j].y) + (v[j].z * v[j].z + v[j].w * v[j].w); }
        const float rstd = 1.f / sqrtf(wave_sum_fd(s2) * (1.f / D) + LN_EPS);
        GAS f32x4* xo = (GAS f32x4*)(xout + (size_t)m * D) + F.lane;
        GAS unsigned long long* o8 = (GAS unsigned long long*)(xb + (size_t)m * D) + F.lane;
#pragma unroll
        for (int j = 0; j < 4; ++j) {
            v[j] = v[j] * rstd * gg[j] + bb[j]; if (WRITE_F32) xo[64 * j] = v[j];
            else o8[64 * j] = (unsigned long long)pk2(v[j].x, v[j].y) | ((unsigned long long)pk2(v[j].z, v[j].w) << 32);
        }
        if (ROUTER) {
            float pl[NEXP];
#pragma unroll
            for (int e = 0; e < NEXP; ++e) pl[e] = 0.f;
#pragma unroll
            for (int j = 0; j < 4; ++j)
#pragma unroll
                for (int c = 0; c < 4; ++c) { const float xv = v[j][c]; const LAS f32x4* w4 = (const LAS f32x4*)(wr + (size_t)(4 * F.lane + 256 * j + c) * NEXP); const f32x4 wa = w4[0], wb = w4[1];
                    pl[0] += xv * wa.x; pl[1] += xv * wa.y; pl[2] += xv * wa.z; pl[3] += xv * wa.w; pl[4] += xv * wb.x; pl[5] += xv * wb.y; pl[6] += xv * wb.z; pl[7] += xv * wb.w; }
            float best0 = -INFINITY, best1 = -INFINITY; int e0 = 0, e1 = 0;
#pragma unroll
            for (int e = 0; e < NEXP; ++e) { const float l = wave_sum_fd(pl[e]) + rb[e];
                if (l > best0) { best1 = best0; e1 = e0; best0 = l; e0 = e; } else if (l > best1) { best1 = l; e1 = e; } }
            const float ex = __expf(best1 - best0), g0 = 1.f / (1.f + ex), g1 = ex / (1.f + ex);
            if (F.lane == 0) {
                lex[2 * (m - r0)] = e0; lex[2 * (m - r0) + 1] = e1;
                r_g[2 * m] = g0; r_g[2 * m + 1] = g1;
            }
        }
        if (more) {
#pragma unroll
            for (int j = 0; j < 4; ++j) v[j] = vn[j];
        }
    }
    if (ROUTER) {
        __syncthreads();
        const int nent = 2 * (r1 - r0);
        const int e = (F.tid < nent) ? lex[F.tid] : -1; int inr = 0;
#pragma unroll
        for (int k = 0; k < NEXP; ++k) {
            const unsigned long long mk = __ballot(e == k);
            const int below = (int)__builtin_amdgcn_mbcnt_hi((unsigned)(mk >> 32), __builtin_amdgcn_mbcnt_lo((unsigned)mk, 0u));
            inr = (e == k) ? below : inr;
            if (F.lane == 0) lrk[F.wave * NEXP + k] = (int)__builtin_popcountll(mk);
        }
        __syncthreads();
        if (F.tid < nent) { int base = 0;
#pragma unroll
            for (int w = 0; w < NWAVES; ++w) base += (w < F.wave) ? lrk[w * NEXP + e] : 0;
            r_e[2 * r0 + F.tid] = e; r_i[2 * r0 + F.tid] = base + inr; }
        if (F.tid < NEXP) { int t = 0;
#pragma unroll
            for (int w = 0; w < NWAVES; ++w) t += lrk[w * NEXP + F.tid];
            ((int*)(F.ws + WS_CNTT))[F.bx * NEXP + F.tid] = t; }
        __syncthreads();
    }
    (void)lcnt; (void)wbase; (void)lslot;
}

__device__ __forceinline__ void moe_map(Frame& F, int lslot) {
    const int* r_e = (const int*)(F.ws + WS_ROUTE); const int* r_i = (const int*)(F.ws + WS_ROUTE + 512 * 1024); int* r_p = (int*)(F.ws + WS_ROUTE + 768 * 1024);
    int* inv = (int*)(F.ws + WS_INV);
    LAS int* tab = (LAS int*)F.lds; LAS int* pre = (LAS int*)(F.lds + 8192); LAS int* tot = (LAS int*)(F.lds + 16384);
    { const int* cntt = (const int*)(F.ws + WS_CNTT); for (int i = F.tid; i < F.G * NEXP; i += NTHR) tab[i] = cntt[i]; }
    __syncthreads();
    { const int e = F.wave, l4 = 4 * F.lane;
        const int c0 = tab[(l4 + 0) * NEXP + e], c1 = tab[(l4 + 1) * NEXP + e], c2 = tab[(l4 + 2) * NEXP + e], c3 = tab[(l4 + 3) * NEXP + e];
        const int sm = (c0 + c1) + (c2 + c3), inc = wave_incl_scan_i(sm, F.lane), ex = inc - sm;
        pre[(l4 + 0) * NEXP + e] = ex; pre[(l4 + 1) * NEXP + e] = ex + c0; pre[(l4 + 2) * NEXP + e] = ex + c0 + c1; pre[(l4 + 3) * NEXP + e] = ex + c0 + c1 + c2;
        if (F.lane == 63) tot[e] = inc; }
    __syncthreads();
    int sb[NEXP + 1]; unsigned cn[NEXP]; { int a = 0;
#pragma unroll
        for (int e = 0; e < NEXP; ++e) { cn[e] = (unsigned)tot[e]; sb[e] = a; a += (int)((cn[e] + 255u) & ~255u); } sb[NEXP] = a; }
    if (F.bx == 0 && F.tid < NEXP) F.ctl[CW_CNT + 16 * lslot + F.tid] = (unsigned)tot[F.tid];
    const int gt = F.bx * NTHR + F.tid, NG = F.G * NTHR;
    for (int ent = gt; ent < 2 * M; ent += NG) {
        const int e = r_e[ent], idx = r_i[ent] + pre[(ent >> 8) * NEXP + e]; int base = 0;
#pragma unroll
        for (int k = 0; k < NEXP; ++k) base = (e == k) ? sb[k] : base;
        const int pos = base + idx; r_p[ent] = pos; inv[pos] = ent >> 1;
    }
    for (int p = gt; p < NEXP * 256; p += NG) { const int e = p >> 8, k = p & 255; int b0 = 0, b1 = 0; unsigned c = 0;
#pragma unroll
        for (int q = 0; q < NEXP; ++q) { if (e == q) { b0 = sb[q]; b1 = sb[q + 1]; c = cn[q]; } }
        const int pos = b0 + (int)c + k; if (pos < b1) inv[pos] = 0; }
    __syncthreads();
}

typedef float f32x4_t __attribute__((ext_vector_type(4)));
typedef short bf16x8_t __attribute__((ext_vector_type(8)));
typedef unsigned u32x4_t __attribute__((ext_vector_type(4)));
typedef float f32x16_t __attribute__((ext_vector_type(16)));
typedef unsigned u32x2_t __attribute__((ext_vector_type(2)));
constexpr int GLA_RT = 72;
__device__ __forceinline__ void gla_put_vt(LAS bf16* sVt, int tid, v4u w0, v4u w1) {
    const int t = tid & 63, ec = tid >> 6;
#pragma unroll
    for (int it = 0; it < 2; ++it) { const v4u w = it ? w1 : w0; LAS bf16* d = sVt + 8 * (ec + 8 * it) * GLA_RT + t;
        d[0 * GLA_RT] = (bf16)(w.x & 0xffffu); d[1 * GLA_RT] = (bf16)(w.x >> 16); d[2 * GLA_RT] = (bf16)(w.y & 0xffffu); d[3 * GLA_RT] = (bf16)(w.y >> 16);
        d[4 * GLA_RT] = (bf16)(w.z & 0xffffu); d[5 * GLA_RT] = (bf16)(w.z >> 16); d[6 * GLA_RT] = (bf16)(w.w & 0xffffu); d[7 * GLA_RT] = (bf16)(w.w >> 16); }
}
__device__ __forceinline__ void unpk8(v4u w, float* f) { f[0] = bflo(w.x); f[1] = bfhi(w.x); f[2] = bflo(w.y); f[3] = bfhi(w.y); f[4] = bflo(w.z); f[5] = bfhi(w.z); f[6] = bflo(w.w); f[7] = bfhi(w.w); }
__device__ __forceinline__ void dsa_prep(Frame& F, int j) {
    const bf16* P = (const bf16*)(F.ws + WS_P); bf16* KD = (bf16*)(F.ws + WS_KD); bf16* VD = (bf16*)(F.ws + WS_VD); bf16* KI = (bf16*)(F.ws + WS_KI);
    const float* kvg = F.inp(2) + j * 128; const float* wuk = F.inp(3) + (size_t)j * 128 * 64; const float* wuv = F.inp(4) + (size_t)j * 128 * 64;
    const float* kg = F.inp(5) + j * 64; const float* kb = F.inp(6) + j * 64;
    constexpr int WT_RS = 136;
    LAS bf16* sWt = (LAS bf16*)F.lds;
    for (int i = F.tid; i < 128 * 128; i += NTHR) {
        const int c = i >> 7, f = i & 127; const float w = (f < 64) ? wuk[c * 64 + f] * C2 : wuv[c * 64 + (f - 64)];
        sWt[f * WT_RS + c] = (bf16)f2bf(w * kvg[c]); }
    __syncthreads();
    const int lane = F.lane, t16 = lane & 15, quad = lane >> 4;
    bf16x8_t af[8][4];
#pragma unroll
    for (int ft = 0; ft < 8; ++ft)
#pragma unroll
        for (int ks = 0; ks < 4; ++ks) af[ft][ks] = *(const LAS bf16x8_t*)(sWt + (16 * ft + t16) * WT_RS + 32 * ks + 8 * quad);
    float kgl[16], kbl[16];
#pragma unroll
    for (int k = 0; k < 16; ++k) { kgl[k] = kg[16 * quad + k]; kbl[k] = kb[16 * quad + k]; }
    for (int m0 = F.gw * 16; m0 < M; m0 += F.NGW * 16) {
        const bf16* pr = P + (size_t)(m0 + t16) * EINP;
        bf16x8_t cf[4]; float ss = 0.f;
#pragma unroll
        for (int ks = 0; ks < 4; ++ks) { const v4u w = *(const v4u*)(pr + PC_CKV + 32 * ks + 8 * quad); cf[ks] = __builtin_bit_cast(bf16x8_t, w);
            float f8[8]; unpk8(w, f8);
#pragma unroll
            for (int k = 0; k < 8; ++k) ss += f8[k] * f8[k]; }
        ss += __int_as_float(__builtin_amdgcn_ds_bpermute((lane ^ 16) << 2, __float_as_int(ss))); ss += __int_as_float(__builtin_amdgcn_ds_bpermute((lane ^ 32) << 2, __float_as_int(ss)));
        const float rs = 1.f / sqrtf(ss * (1.f / 128.f) + RMS_EPS);
#pragma unroll
        for (int ft = 0; ft < 8; ++ft) {
            f32x4_t c = {0.f, 0.f, 0.f, 0.f};
#pragma unroll
            for (int ks = 0; ks < 4; ++ks) c = __builtin_amdgcn_mfma_f32_16x16x32_bf16(af[ft][ks], cf[ks], c, 0, 0, 0);
            u32x2_t o; o.x = pk2(c[0] * rs, c[1] * rs); o.y = pk2(c[2] * rs, c[3] * rs);
            bf16* dst = (ft < 4 ? KD : VD) + (size_t)(m0 + t16) * 64 + 16 * (ft & 3) + 4 * quad;
            *(u32x2_t*)dst = o;
        }
        {
            float x[16]; const v4u w0 = *(const v4u*)(pr + PC_KI + 16 * quad), w1 = *(const v4u*)(pr + PC_KI + 16 * quad + 8); unpk8(w0, x); unpk8(w1, x + 8);
            float s = 0.f;
#pragma unroll
            for (int k = 0; k < 16; ++k) s += x[k];
            s += __int_as_float(__builtin_amdgcn_ds_bpermute((lane ^ 16) << 2, __float_as_int(s))); s += __int_as_float(__builtin_amdgcn_ds_bpermute((lane ^ 32) << 2, __float_as_int(s)));
            const float mean = s * (1.f / 64.f); float q = 0.f;
#pragma unroll
            for (int k = 0; k < 16; ++k) { x[k] -= mean; q += x[k] * x[k]; }
            q += __int_as_float(__builtin_amdgcn_ds_bpermute((lane ^ 16) << 2, __float_as_int(q))); q += __int_as_float(__builtin_amdgcn_ds_bpermute((lane ^ 32) << 2, __float_as_int(q)));
            const float rstd = 1.f / sqrtf(q * (1.f / 64.f) + LN_EPS);
            v4u o0, o1;
            o0.x = pk2(x[0] * rstd * kgl[0] + kbl[0], x[1] * rstd * kgl[1] + kbl[1]); o0.y = pk2(x[2] * rstd * kgl[2] + kbl[2], x[3] * rstd * kgl[3] + kbl[3]);
            o0.z = pk2(x[4] * rstd * kgl[4] + kbl[4], x[5] * rstd * kgl[5] + kbl[5]); o0.w = pk2(x[6] * rstd * kgl[6] + kbl[6], x[7] * rstd * kgl[7] + kbl[7]);
            o1.x = pk2(x[8] * rstd * kgl[8] + kbl[8], x[9] * rstd * kgl[9] + kbl[9]); o1.y = pk2(x[10] * rstd * kgl[10] + kbl[10], x[11] * rstd * kgl[11] + kbl[11]);
            o1.z = pk2(x[12] * rstd * kgl[12] + kbl[12], x[13] * rstd * kgl[13] + kbl[13]); o1.w = pk2(x[14] * rstd * kgl[14] + kbl[14], x[15] * rstd * kgl[15] + kbl[15]);
            bf16* kd = KI + (size_t)(m0 + t16) * 64 + 16 * quad; *(v4u*)kd = o0; *(v4u*)(kd + 8) = o1;
        }
    }
    __syncthreads();
}

struct GlaPrepIn { v4u v0, v1, g0, g1, q, k; };
__device__ __forceinline__ GlaPrepIn gla_prep_load(const bf16* P, int unit, int tid) {
    const int h = unit & 3, tok0 = (unit >> 2) * 64; GlaPrepIn r;
    { const int t = tid & 63, ec = tid >> 6; const bf16* p = P + (size_t)(tok0 + t) * EINP + PC_BV + h * 128 + 8 * ec; r.v0 = *(const v4u*)p; r.v1 = *(const v4u*)(p + 64); }
    { const int t = tid >> 3, dg = tid & 7; const bf16* p = P + (size_t)(tok0 + t) * EINP;
      r.g0 = *(const v4u*)(p + PC_BG); r.g1 = *(const v4u*)(p + PC_BG + 8); r.q = *(const v4u*)(p + PC_BQ + h * 64 + 8 * dg); r.k = *(const v4u*)(p + PC_BK + h * 64 + 8 * dg); }
    return r;
}
__device__ __forceinline__ void gla_prep(Frame& F, int j) {
    const bf16* P = (const bf16*)(F.ws + WS_P); bf16* QT = (bf16*)(F.ws + WS_QT); bf16* KT = (bf16*)(F.ws + WS_KT);
    float* EBL = (float*)(F.ws + WS_EBL); float* GST = (float*)(F.ws + WS_GST);
    const float* wg2 = F.inp(7) + (size_t)j * 16 * 256; const float* bgb = F.inp(8) + j * 256;
    LAS float* sG = (LAS float*)F.lds;
    LAS float* sSeg = sG + 4096;
    LAS bf16* sKHt = (LAS bf16*)(F.lds + 18432);
    LAS bf16* sVt = (LAS bf16*)(F.lds + 27648);
    LAS float* sW = (LAS float*)(F.lds + 46080);
    const int tid = F.tid, lane = F.lane, hi = lane >> 5, r32 = lane & 31;
    const int NU = BATCH * 32 * 4;
    int hw = -1;
    GlaPrepIn cur; if (F.bx < NU) cur = gla_prep_load(P, F.bx, tid);
    for (int unit = F.bx; unit < NU; unit += F.G) {
        const int h = unit & 3, bc = unit >> 2, tok0 = bc * 64;
        GlaPrepIn nxt = cur; if (unit + F.G < NU) nxt = gla_prep_load(P, unit + F.G, tid);
        if (h != hw) { for (int i = tid; i < 1024; i += NTHR) sW[i] = wg2[(i >> 6) * 256 + h * 64 + (i & 63)]; if (tid < 64) sW[1024 + tid] = bgb[h * 64 + tid]; hw = h; }
        gla_put_vt(sVt, tid, cur.v0, cur.v1);
        LDS_BAR();
        const int t8 = tid >> 3, dg = tid & 7;
        {
            float bg[16]; unpk8(cur.g0, bg); unpk8(cur.g1, bg + 8);
#pragma unroll
            for (int k = 0; k < 8; ++k) { const int d = 8 * dg + k; float z = sW[1024 + d];
#pragma unroll
                for (int r = 0; r < 16; ++r) z += bg[r] * sW[r * 64 + d];
                sG[t8 * 64 + d] = (fminf(z, 0.f) - __logf(1.f + __expf(-fabsf(z)))) * (1.f / 16.f); }
        }
        LDS_BAR();
        {
            const int d = tid & 63, seg = tid >> 6; float pre[8], run = 0.f;
#pragma unroll
            for (int k = 0; k < 8; ++k) { run += sG[(8 * seg + k) * 64 + d]; pre[k] = run; }
            sSeg[seg * 64 + d] = run;
            LDS_BAR();
            float off = 0.f;
#pragma unroll
            for (int s2 = 0; s2 < 7; ++s2) off += (s2 < seg) ? sSeg[s2 * 64 + d] : 0.f;
#pragma unroll
            for (int k = 0; k < 8; ++k) sG[(8 * seg + k) * 64 + d] = off + pre[k];
        }
        LDS_BAR();
        {
            float q[8], kk[8]; unpk8(cur.q, q); unpk8(cur.k, kk);
            const f32x4 b0 = *(const LAS f32x4*)(sG + t8 * 64 + 8 * dg), b1 = *(const LAS f32x4*)(sG + t8 * 64 + 8 * dg + 4);
            const f32x4 l0 = *(const LAS f32x4*)(sG + 63 * 64 + 8 * dg), l1 = *(const LAS f32x4*)(sG + 63 * 64 + 8 * dg + 4);
            const float bb[8] = {b0.x, b0.y, b0.z, b0.w, b1.x, b1.y, b1.z, b1.w}, bl[8] = {l0.x, l0.y, l0.z, l0.w, l1.x, l1.y, l1.z, l1.w};
            float qo[8], ko[8];
#pragma unroll
            for (int k = 0; k < 8; ++k) { qo[k] = q[k] * 0.125f * __expf(bb[k]); ko[k] = kk[k] * __expf(-bb[k]); sKHt[(8 * dg + k) * GLA_RT + t8] = (bf16)f2bf(kk[k] * __expf(bl[k] - bb[k])); }
            v4u wq, wk; wq.x = pk2(qo[0], qo[1]); wq.y = pk2(qo[2], qo[3]); wq.z = pk2(qo[4], qo[5]); wq.w = pk2(qo[6], qo[7]); wk.x = pk2(ko[0], ko[1]); wk.y = pk2(ko[2], ko[3]); wk.z = pk2(ko[4], ko[5]); wk.w = pk2(ko[6], ko[7]);
            { const size_t fo = (size_t)unit * 4096 + (size_t)((((t8 >> 5) * 4 + (dg >> 1)) * 64 + (t8 & 31) + 32 * (dg & 1)) * 8);
              *(v4u*)(QT + fo) = wq; *(v4u*)(KT + fo) = wk; }
            if (t8 == 63) {
#pragma unroll
                for (int k = 0; k < 8; ++k) EBL[(size_t)bc * 256 + h * 64 + 8 * dg + k] = __expf(bl[k]); }
        }
        LDS_BAR();
        {
            const int db = F.wave >> 2, eb = F.wave & 3; f32x16_t acc = {};
#pragma unroll
            for (int ks = 0; ks < 4; ++ks) {
                const bf16x8_t a = *(const LAS bf16x8_t*)(sKHt + (32 * db + r32) * GLA_RT + 16 * ks + 8 * hi);
                const bf16x8_t bfr = *(const LAS bf16x8_t*)(sVt + (32 * eb + r32) * GLA_RT + 16 * ks + 8 * hi);
                acc = __builtin_amdgcn_mfma_f32_32x32x16_bf16(a, bfr, acc, 0, 0, 0); }
            float* g = GST + (size_t)unit * 8192 + 4 * hi;
#pragma unroll
            for (int rg = 0; rg < 4; ++rg) *(f32x4_t*)(g + (((eb * 4 + 2 * db + (rg >> 1)) * 64 + r32 + 32 * (rg & 1)) * 8)) = (f32x4_t){acc[4 * rg], acc[4 * rg + 1], acc[4 * rg + 2], acc[4 * rg + 3]};
        }
        LDS_BAR();
        cur = nxt;
    }
}
__device__ __forceinline__ void gla_scan(Frame& F) {
    float* GST = (float*)(F.ws + WS_GST); const float* EBL = (const float*)(F.ws + WS_EBL);
    const int gt = F.bx * NTHR + F.tid, NG = F.G * NTHR;
    for (int idx = gt; idx < BATCH * 4 * 8192; idx += NG) {
        const int de = idx & 8191, h = (idx >> 13) & 3, b = idx >> 15, d = 16 * ((de >> 9) & 3) + 8 * ((de >> 8) & 1) + (de & 7);
        float S = 0.f;
#pragma unroll 8
        for (int c = 0; c < 32; ++c) { const size_t off = (size_t)(((b * 32 + c) << 2) + h) * 8192 + de; const float a = GST[off]; GST[off] = S; S = EBL[(size_t)(b * 32 + c) * 256 + h * 64 + d] * S + a; }
    }
}
struct GlaOutIn { v4u v0, v1; bf16x8_t qf[4], kf[2][4]; f32x4_t st[8]; unsigned rw[8]; };
__device__ __forceinline__ GlaOutIn gla_out_load(const bf16* P, const bf16* QT, const bf16* KT, const float* GST, int unit, int tid, int wave, int lane) {
    const int h = unit & 3, tok0 = (unit >> 2) * 64, hi = lane >> 5, r32 = lane & 31, ib = wave & 1, eb = wave >> 1; GlaOutIn r;
    { const int t = tid & 63, ec = tid >> 6; const bf16* p = P + (size_t)(tok0 + t) * EINP + PC_BV + h * 128 + 8 * ec; r.v0 = *(const v4u*)p; r.v1 = *(const v4u*)(p + 64); }
#pragma unroll
    for (int ks = 0; ks < 4; ++ks) { r.qf[ks] = *(const bf16x8_t*)(QT + (size_t)unit * 4096 + ((ib * 4 + ks) * 64 + lane) * 8);
        r.kf[0][ks] = *(const bf16x8_t*)(KT + (size_t)unit * 4096 + ((0 * 4 + ks) * 64 + lane) * 8);
        r.kf[1][ks] = *(const bf16x8_t*)(KT + (size_t)unit * 4096 + ((1 * 4 + ks) * 64 + lane) * 8); }
    const float* sr = GST + (size_t)unit * 8192;
#pragma unroll
    for (int ks = 0; ks < 4; ++ks) { r.st[2 * ks] = *(const f32x4_t*)(sr + ((eb * 4 + ks) * 64 + lane) * 8); r.st[2 * ks + 1] = *(const f32x4_t*)(sr + ((eb * 4 + ks) * 64 + lane) * 8 + 4); }
#pragma unroll
    for (int i = 0; i < 8; ++i) r.rw[i] = *(const unsigned*)(P + (size_t)(tok0 + wave + 8 * i) * EINP + PC_BR + h * 128 + 2 * lane);
    return r;
}
__device__ __forceinline__ void gla_out(Frame& F, int j) {
    const bf16* P = (const bf16*)(F.ws + WS_P); const bf16* QT = (const bf16*)(F.ws + WS_QT); const bf16* KT = (const bf16*)(F.ws + WS_KT);
    const float* GST = (const float*)(F.ws + WS_GST); bf16* MIX = (bf16*)(F.ws + WS_MIX); const float* ng = F.inp(9) + j * 512;
    LAS bf16* sVt = (LAS bf16*)F.lds;
    LAS float* sO = (LAS float*)(F.lds + 18432);
    const int tid = F.tid, lane = F.lane, hi = lane >> 5, r32 = lane & 31;
    const int ib = F.wave & 1, eb = F.wave >> 1;
    const int NU = BATCH * 32 * 4;
    GlaOutIn cur; if (F.bx < NU) cur = gla_out_load(P, QT, KT, GST, F.bx, tid, F.wave, lane);
    for (int unit = F.bx; unit < NU; unit += F.G) {
        const int h = unit & 3, bc = unit >> 2, tok0 = bc * 64;
        GlaOutIn nxt = cur; if (unit + F.G < NU) nxt = gla_out_load(P, QT, KT, GST, unit + F.G, tid, F.wave, lane);
        gla_put_vt(sVt, tid, cur.v0, cur.v1);
        LDS_BAR();
        f32x16_t acc = {};
#pragma unroll
        for (int jb = 0; jb < 2; ++jb) {
            if (jb <= ib) {
                f32x16_t X = {};
#pragma unroll
                for (int ks = 0; ks < 4; ++ks) X = __builtin_amdgcn_mfma_f32_32x32x16_bf16(cur.kf[jb][ks], cur.qf[ks], X, 0, 0, 0);
                if (jb == ib) {
#pragma unroll
                    for (int r = 0; r < 16; ++r) { const int jr = (r & 3) + 8 * (r >> 2) + 4 * hi; if (jr > r32) X[r] = 0.f; }
                }
#pragma unroll
                for (int s2 = 0; s2 < 2; ++s2) {
                    u32x4_t xw; xw.x = pk2(X[8 * s2], X[8 * s2 + 1]); xw.y = pk2(X[8 * s2 + 2], X[8 * s2 + 3]); xw.z = pk2(X[8 * s2 + 4], X[8 * s2 + 5]); xw.w = pk2(X[8 * s2 + 6], X[8 * s2 + 7]);
                    const LAS bf16* vr = sVt + (32 * eb + r32) * GLA_RT + 32 * jb + 16 * s2 + 4 * hi;
                    const u32x2_t a0 = *(const LAS u32x2_t*)vr, a1 = *(const LAS u32x2_t*)(vr + 8);
                    u32x4_t aw; aw.x = a0.x; aw.y = a0.y; aw.z = a1.x; aw.w = a1.y;
                    acc = __builtin_amdgcn_mfma_f32_32x32x16_bf16(__builtin_bit_cast(bf16x8_t, aw), __builtin_bit_cast(bf16x8_t, xw), acc, 0, 0, 0);
                }
            }
        }
#pragma unroll
        for (int ks = 0; ks < 4; ++ks) { const f32x4_t s0 = cur.st[2 * ks], s1 = cur.st[2 * ks + 1];
            u32x4_t aw; aw.x = pk2(s0[0], s0[1]); aw.y = pk2(s0[2], s0[3]); aw.z = pk2(s1[0], s1[1]); aw.w = pk2(s1[2], s1[3]);
            acc = __builtin_amdgcn_mfma_f32_32x32x16_bf16(__builtin_bit_cast(bf16x8_t, aw), cur.qf[ks], acc, 0, 0, 0); }
#pragma unroll
        for (int r = 0; r < 16; ++r) sO[(32 * ib + r32) * 129 + 32 * eb + (r & 3) + 8 * (r >> 2) + 4 * hi] = acc[r];
        LDS_BAR();
        const float n0 = ng[h * 128 + 2 * lane], n1 = ng[h * 128 + 2 * lane + 1];
#pragma unroll
        for (int i8 = 0; i8 < 8; ++i8) { const int i = F.wave + 8 * i8;
            const float o0 = sO[i * 129 + 2 * lane], o1 = sO[i * 129 + 2 * lane + 1];
            const float rs = 1.f / sqrtf(wave_sum(o0 * o0 + o1 * o1) * (1.f / 128.f) + RMS_EPS);
            const unsigned rw = cur.rw[i8];
            *(unsigned*)(MIX + (size_t)(tok0 + i) * D + 512 + h * 128 + 2 * lane) = pk2(o0 * rs * n0 * silu_f(bflo(rw)), o1 * rs * n1 * silu_f(bfhi(rw)));
        }
        LDS_BAR();
        cur = nxt;
    }
}

__device__ __forceinline__ int wave_sum_dpp(int v) {
    v += __builtin_amdgcn_mov_dpp(v, 0xB1, 0xF, 0xF, true);
    v += __builtin_amdgcn_mov_dpp(v, 0x4E, 0xF, 0xF, true);
    v += __builtin_amdgcn_mov_dpp(v, 0x141, 0xF, 0xF, true);
    v += __builtin_amdgcn_mov_dpp(v, 0x140, 0xF, 0xF, true);
    v += __builtin_amdgcn_update_dpp(0, v, 0x142, 0xA, 0xF, false);
    v += __builtin_amdgcn_update_dpp(0, v, 0x143, 0xC, 0xF, false);
    return __builtin_amdgcn_readlane(v, 63);
}
__device__ __forceinline__ unsigned mono_key(float f) { const unsigned u = __float_as_uint(f); return (u & 0x80000000u) ? ~u : (u | 0x80000000u); }
__device__ __forceinline__ float relu1(float x) { const int b = __float_as_int(x); return __int_as_float(b > 0 ? b : 0); }
__device__ __forceinline__ void dsa_index(Frame& F) {
    const bf16* P = (const bf16*)(F.ws + WS_P); const bf16* KI = (const bf16*)(F.ws + WS_KI);
    unsigned* MASK = (unsigned*)(F.ws + WS_MASK);
    LAS unsigned char* scl = F.lds;
    const int nu = 2 * ((BATCH * 64 - F.bx + F.G - 1) / F.G);
#define IDX_UNIT(u, b_, blk_) do { const int v_ = F.bx + ((u) >> 1) * F.G; b_ = (v_ >> 6) & 15; const int s_ = ((v_ & 63) + 16 * (v_ >> 8)) & 63; blk_ = ((u) & 1) ? 127 - s_ : s_; } while (0)
#define IDX_QLOAD(b_, blk_) do { int ln_ = F.lane; asm volatile("" : "+v"(ln_)); const bf16* qr_ = P + (size_t)((b_) * SEQ + (blk_) * 16 + (ln_ & 15)) * EINP; \
        _Pragma("unroll") for (int h = 0; h < 8; ++h) { qfn[h][0] = *(const bf16x8_t*)(qr_ + PC_QI + h * 64 + 8 * (ln_ >> 4)); qfn[h][1] = *(const bf16x8_t*)(qr_ + PC_QI + h * 64 + 32 + 8 * (ln_ >> 4)); } \
        wnq = *(const v4u*)(qr_ + PC_WI); } while (0)
    bf16x8_t qfn[8][2]; v4u wnq = (v4u){0u, 0u, 0u, 0u};
    { int b0_, blk0_; IDX_UNIT(0, b0_, blk0_); if (blk0_ > 15) IDX_QLOAD(b0_, blk0_); }
#pragma unroll 1
    for (int u = 0; u < nu; ++u) {
        {
            int b, blk; IDX_UNIT(u, b, blk);
            const int q0 = blk * 16, ntk = (q0 >> 6) + 1;
            if (blk > 15) {
                int lane = F.lane; asm volatile("" : "+v"(lane)); const int c16 = lane & 15, quad = lane >> 4;
                bf16x8_t qf[8][2]; float w[8];
#pragma unroll
                for (int h = 0; h < 8; ++h) { qf[h][0] = qfn[h][0]; qf[h][1] = qfn[h][1]; }
                { float f[8]; unpk8(wnq, f);
#pragma unroll
                    for (int h = 0; h < 8; ++h) w[h] = f[h]; }
                const bf16* kbase = KI + (size_t)(b * SEQ + c16) * 64 + 8 * quad;
                LAS unsigned char* wrow = scl + c16 * 8192;
                const int nit = 4 * ntk;
                bf16x8_t afq[4][2];
#pragma unroll
                for (int j = 0; j < 4; ++j) { const int itj = F.wave + NWAVES * j;
                    if (itj < nit) { afq[j][0] = *(const bf16x8_t*)(kbase + (size_t)(16 * itj) * 64); afq[j][1] = *(const bf16x8_t*)(kbase + (size_t)(16 * itj) * 64 + 32); } }
#pragma unroll 1
                for (int base = F.wave; base < nit; base += 4 * NWAVES) {
#pragma unroll
                    for (int j = 0; j < 4; ++j) { const int it = base + NWAVES * j;
                        if (it < nit) {
                            const bf16x8_t af0 = afq[j][0], af1 = afq[j][1];
                            if (it + 4 * NWAVES < nit) { afq[j][0] = *(const bf16x8_t*)(kbase + (size_t)(16 * (it + 4 * NWAVES)) * 64); afq[j][1] = *(const bf16x8_t*)(kbase + (size_t)(16 * (it + 4 * NWAVES)) * 64 + 32); }
                            f32x4_t sc = {0.f, 0.f, 0.f, 0.f};
#pragma unroll
                            for (int h = 0; h < 8; ++h) {
                                f32x4_t c = {0.f, 0.f, 0.f, 0.f};
                                c = __builtin_amdgcn_mfma_f32_16x16x32_bf16(af0, qf[h][0], c, 0, 0, 0);
                                c = __builtin_amdgcn_mfma_f32_16x16x32_bf16(af1, qf[h][1], c, 0, 0, 0);
                                sc[0] += w[h] * relu1(c[0]); sc[1] += w[h] * relu1(c[1]); sc[2] += w[h] * relu1(c[2]); sc[3] += w[h] * relu1(c[3]);
                            }
                            const int ch = 4 * it + quad;
                            *(LAS f32x4_t*)(wrow + ((ch & ~15) | ((ch ^ (ch >> 4) ^ c16) & 15)) * 16) = sc;
                        }
                    }
                }
            }
            if (u + 1 < nu) { int b2_, blk2_; IDX_UNIT(u + 1, b2_, blk2_); if (blk2_ > 15) IDX_QLOAD(b2_, blk2_); }
            LDS_BAR();
            int lane = F.lane; asm volatile("" : "+v"(lane));
            {
                const int ra = 2 * F.wave, ia = q0 + ra, ib = ia + 1;
                unsigned ma, mb;
                if (ib < TOPK) {
                    const int na = ia - 32 * lane + 1, nb = ib - 32 * lane + 1;
                    ma = na <= 0 ? 0u : (na >= 32 ? 0xffffffffu : ((1u << na) - 1u)); mb = nb <= 0 ? 0u : (nb >= 32 ? 0xffffffffu : ((1u << nb) - 1u));
                } else {
                    unsigned ua[32], ub[32];
#pragma unroll
                    for (int k = 0; k < 8; ++k) { const int ch = 8 * lane + k;
                        const f32x4_t xa = *(const LAS f32x4_t*)(scl + ra * 8192 + ((ch & ~15) | ((ch ^ (ch >> 4) ^ ra) & 15)) * 16);
                        const f32x4_t xb = *(const LAS f32x4_t*)(scl + (ra + 1) * 8192 + ((ch & ~15) | ((ch ^ (ch >> 4) ^ (ra + 1)) & 15)) * 16);
#pragma unroll
                        for (int e = 0; e < 4; ++e) { ua[4 * k + e] = __float_as_uint(xa[e]); ub[4 * k + e] = __float_as_uint(xb[e]); } }
#pragma unroll
                    for (int st = 0; st < 5; ++st) { const int j = 16 >> st; const unsigned m = (st == 0) ? 0x0000FFFFu : (st == 1) ? 0x00FF00FFu : (st == 2) ? 0x0F0F0F0Fu : (st == 3) ? 0x33333333u : 0x55555555u;
#pragma unroll
                        for (int k = 0; k < 32; ++k) if ((k & j) == 0) {
                            { const unsigned hi = ua[k], lo = ua[k + j]; ua[k + j] = (lo & ~m) | ((hi >> j) & m); ua[k] = (hi & ~(m << j)) | ((lo << j) & (m << j)); }
                            { const unsigned hi = ub[k], lo = ub[k + j]; ub[k + j] = (lo & ~m) | ((hi >> j) & m); ub[k] = (hi & ~(m << j)) | ((lo << j) & (m << j)); } }
                        __builtin_amdgcn_sched_barrier(0); }
                    const int nva = ia - 32 * lane + 1, nvb = ib - 32 * lane + 1;
                    unsigned Ga = 0u, Ea = nva <= 0 ? 0u : (nva >= 32 ? 0xffffffffu : ((1u << nva) - 1u)), Gb = 0u, Eb = nvb <= 0 ? 0u : (nvb >= 32 ? 0xffffffffu : ((1u << nvb) - 1u));
                    const unsigned sa = ua[31], sb = ub[31];
#pragma unroll
                    for (int bit = 17; bit >= 0; --bit) {
                        const unsigned pa_ = (bit == 17) ? ~sa : (ua[14 + bit] ^ sa), pb_ = (bit == 17) ? ~sb : (ub[14 + bit] ^ sb);
                        const unsigned ca = Ea & pa_, cb = Eb & pb_;
                        const int tot = wave_sum_dpp(__builtin_popcount(Ga | ca) + (__builtin_popcount(Gb | cb) << 16));
                        if ((tot & 0xffff) >= TOPK) Ea = ca; else { Ga |= ca; Ea ^= ca; }
                        if ((tot >> 16) >= TOPK) Eb = cb; else { Gb |= cb; Eb ^= cb; }
                    }
                    const int ea = __builtin_popcount(Ea), eb = __builtin_popcount(Eb);
                    const int totg = wave_sum_dpp(__builtin_popcount(Ga) + (__builtin_popcount(Gb) << 16));
                    const int tiet = wave_sum_dpp(ea + (eb << 16));
                    const int needa = TOPK - (totg & 0xffff), needb = TOPK - (totg >> 16);
                    if (needa == (tiet & 0xffff) && needb == (tiet >> 16)) { ma = Ga | Ea; mb = Gb | Eb; }
                    else {
                        int pa = wave_incl_scan_i(ea, lane) - ea, pb2 = wave_incl_scan_i(eb, lane) - eb; ma = Ga; mb = Gb;
#pragma unroll
                        for (int r = 0; r < 32; ++r) {
                            const unsigned ba = (Ea >> r) & 1u, bb = (Eb >> r) & 1u;
                            ma |= (ba & (pa < needa ? 1u : 0u)) << r; pa += (int)ba;
                            mb |= (bb & (pb2 < needb ? 1u : 0u)) << r; pb2 += (int)bb;
                        }
                    }
                }
                MASK[(size_t)(b * SEQ + ia) * 64 + lane] = ma; MASK[(size_t)(b * SEQ + ib) * 64 + lane] = mb;
            }
            LDS_BAR();
        }
    }
#undef IDX_UNIT
#undef IDX_QLOAD
}

typedef float f32x16_d __attribute__((ext_vector_type(16)));
typedef short v4i16_d __attribute__((ext_vector_type(4)));
constexpr int DT_RSK = 72, DT_RSV = 160;
constexpr int DT_BUF = 64 * DT_RSK * 2 + 64 * DT_RSV * 2;
__device__ __forceinline__ void frame_refresh(Frame& F);
__device__ __forceinline__ void diff_attn_t(Frame& F, unsigned char* ldsg, int j, const float lam_init) {
    const bf16* QKV = (const bf16*)(F.ws + WS_QKV); bf16* MIXO = (bf16*)(F.ws + WS_MIXO);
    LAS unsigned char* lds = F.lds;
    LAS unsigned* sO0 = (LAS unsigned*)(lds + 2 * DT_BUF) + F.wave * 2048;
    LAS float* sG = (LAS float*)(lds + 2 * DT_BUF + 65536);
    const int wave = F.wave;
    float lam;
    { const int tid = F.tid, lane = F.lane;
    if (tid < 128) sG[tid] = F.inp(23)[j * 128 + tid] * (1.f - lam_init);
    { const float a = wave_sum_l(F.inp(19)[j * 64 + lane] * F.inp(20)[j * 64 + lane], lane), c = wave_sum_l(F.inp(21)[j * 64 + lane] * F.inp(22)[j * 64 + lane], lane); lam = __expf(a) - __expf(c) + lam_init; } }
    __syncthreads();
    const int vcu = (F.G % 8 == 0) ? (F.bx % 8) * (F.G / 8) + F.bx / 8 : F.bx;
    for (int v = vcu; v < BATCH * 8 * 2; v += F.G) {
        const int bh = v >> 1, p = v & 1, b = bh >> 3, h = bh & 7;
#pragma unroll 1
        for (int qi = 0; qi < 4; ++qi) {
            const int qb = (qi == 0) ? p : (qi == 1) ? 7 - p : (qi == 2) ? 2 + p : 5 - p;
            const int lane = hw_lane(), tid = wave * 64 + lane, r32 = lane & 31, hi = lane >> 5;
            const int krow = tid >> 3, kch = tid & 7, vrow = tid >> 4, vch = tid & 15;
            const int vtr = (4 * hi + ((lane & 15) >> 2)) * (DT_RSV * 2) + ((lane >> 4) & 1) * 32 + (lane & 3) * 8;
            const int nt = 4 * (qb + 1), qpos = 256 * qb + 32 * wave + r32, wmin = 256 * qb + 32 * wave;
            const size_t tokq = (size_t)b * SEQ + qpos;
#pragma unroll 1
            for (int m = 0; m < 2; ++m) {
                bf16x8_t qf[4];
#pragma unroll
                for (int ks = 0; ks < 4; ++ks) qf[ks] = *(const bf16x8_t*)(QKV + tokq * 3072 + h * 128 + m * 64 + 16 * ks + 8 * hi);
                f32x16_d O[4];
#pragma unroll
                for (int db = 0; db < 4; ++db) O[db] = f32x16_d{};
                float mrun = 0.f, lsum = 0.f; f32x16_d negm = f32x16_d{};
                const bf16* kg = QKV + ((size_t)b * SEQ + krow) * 3072 + 1024 + h * 128 + m * 64 + kch * 8;
                const bf16* vg = QKV + ((size_t)b * SEQ + vrow) * 3072 + 2048 + h * 128 + vch * 8;
                v4u sk[2], sv0[2], sv1[2];
                sk[0] = *(const v4u*)kg; sv0[0] = *(const v4u*)vg; sv1[0] = *(const v4u*)(vg + (size_t)32 * 3072);
                { const size_t ko = (size_t)64 * 3072; sk[1] = *(const v4u*)(kg + ko); sv0[1] = *(const v4u*)(vg + ko); sv1[1] = *(const v4u*)(vg + ko + (size_t)32 * 3072); }
                *(LAS v4u*)(lds + krow * (DT_RSK * 2) + kch * 16) = sk[0];
                *(LAS v4u*)(lds + 64 * DT_RSK * 2 + vrow * (DT_RSV * 2) + vch * 16) = sv0[0]; *(LAS v4u*)(lds + 64 * DT_RSK * 2 + (vrow + 32) * (DT_RSV * 2) + vch * 16) = sv1[0];
                __syncthreads();
#pragma unroll 1
                for (int t2 = 0; t2 < nt; t2 += 2) {
#pragma unroll
                  for (int tp = 0; tp < 2; ++tp) {
                    const int t = t2 + tp;
                    const int buf = tp * DT_BUF;
                    if (t + 2 < nt) { const size_t ko = (size_t)(t + 2) * 64 * 3072; sk[tp] = *(const v4u*)(kg + ko); sv0[tp] = *(const v4u*)(vg + ko); sv1[tp] = *(const v4u*)(vg + ko + (size_t)32 * 3072); }
                    if (64 * t <= wmin + 31) {
                        LAS unsigned char* kb_ = lds + buf; LAS unsigned char* vb_ = lds + buf + 64 * DT_RSK * 2;
                        f32x16_d S[2];
#pragma unroll
                        for (int kb = 0; kb < 2; ++kb) {
#pragma unroll
                            for (int ks = 0; ks < 4; ++ks) { const bf16x8_t kf = *(const LAS bf16x8_t*)(kb_ + (32 * kb + r32) * (DT_RSK * 2) + (16 * ks + 8 * hi) * 2);
                                S[kb] = __builtin_amdgcn_mfma_f32_32x32x16_bf16(kf, qf[ks], ks == 0 ? negm : S[kb], 0, 0, 0); } }
                        if (64 * t + 63 > wmin) {
#pragma unroll
                            for (int kb = 0; kb < 2; ++kb)
#pragma unroll
                                for (int r = 0; r < 16; ++r) { const int key = 64 * t + 32 * kb + (r & 3) + 8 * (r >> 2) + 4 * hi; if (key > qpos) S[kb][r] = -INFINITY; }
                        }
                        float mx = S[0][0];
#pragma unroll
                        for (int r = 1; r < 16; ++r) mx = fmaxf(mx, S[0][r]);
#pragma unroll
                        for (int r = 0; r < 16; ++r) mx = fmaxf(mx, S[1][r]);
                        { auto rr = __builtin_amdgcn_permlane32_swap(__float_as_uint(mx), __float_as_uint(mx), false, false); mx = fmaxf(__uint_as_float(rr[0]), __uint_as_float(rr[1])); }
                        if (__builtin_expect(__any(mx > 8.f), 0)) {
                            const float dl = fmaxf(mx, 0.f), alpha = __builtin_amdgcn_exp2f(-dl); mrun += dl; lsum *= alpha;
#pragma unroll
                            for (int kb = 0; kb < 2; ++kb)
#pragma unroll
                                for (int r = 0; r < 16; ++r) S[kb][r] -= dl;
#pragma unroll
                            for (int r = 0; r < 16; ++r) negm[r] = -mrun;
#pragma unroll
                            for (int db = 0; db < 4; ++db)
#pragma unroll
                                for (int r = 0; r < 16; ++r) O[db][r] *= alpha;
                        }
                        float ps = 0.f;
#pragma unroll
                        for (int kb = 0; kb < 2; ++kb)
#pragma unroll
                            for (int r = 0; r < 16; ++r) { const float pv = __builtin_amdgcn_exp2f(S[kb][r]); S[kb][r] = pv; ps += pv; }
                        lsum += ps;
#pragma unroll
                        for (int kb = 0; kb < 2; ++kb)
#pragma unroll
                            for (int s2 = 0; s2 < 2; ++s2) {
                                u32x4_t pw; pw.x = pk2(S[kb][8 * s2], S[kb][8 * s2 + 1]); pw.y = pk2(S[kb][8 * s2 + 2], S[kb][8 * s2 + 3]); pw.z = pk2(S[kb][8 * s2 + 4], S[kb][8 * s2 + 5]); pw.w = pk2(S[kb][8 * s2 + 6], S[kb][8 * s2 + 7]);
                                const bf16x8_t pf = __builtin_bit_cast(bf16x8_t, pw);
#pragma unroll
                                for (int db = 0; db < 4; ++db) {
                                    LAS unsigned char* va = vb_ + vtr + (32 * kb + 16 * s2) * (DT_RSV * 2) + db * 64;
                                    const v4i16_d lo = __builtin_amdgcn_ds_read_tr16_b64_v4i16((LAS v4i16_d*)va), hi4 = __builtin_amdgcn_ds_read_tr16_b64_v4i16((LAS v4i16_d*)(va + 8 * (DT_RSV * 2)));
                                    const bf16x8_t vf = (bf16x8_t){lo[0], lo[1], lo[2], lo[3], hi4[0], hi4[1], hi4[2], hi4[3]};
                                    O[db] = __builtin_amdgcn_mfma_f32_32x32x16_bf16(vf, pf, O[db], 0, 0, 0);
                                }
                            }
                    }
                    if (t + 1 < nt) { const int nb = (tp ^ 1) * DT_BUF;
                        *(LAS v4u*)(lds + nb + krow * (DT_RSK * 2) + kch * 16) = sk[tp ^ 1];
                        *(LAS v4u*)(lds + nb + 64 * DT_RSK * 2 + vrow * (DT_RSV * 2) + vch * 16) = sv0[tp ^ 1]; *(LAS v4u*)(lds + nb + 64 * DT_RSK * 2 + (vrow + 32) * (DT_RSV * 2) + vch * 16) = sv1[tp ^ 1]; }
                    LDS_BAR();
                  }
                }
                lsum += __int_as_float(__builtin_amdgcn_ds_bpermute((lane ^ 32) << 2, __float_as_int(lsum)));
                const float linv = 1.f / lsum;
                if (m == 0) {
#pragma unroll
                    for (int db = 0; db < 4; ++db)
#pragma unroll
                        for (int r = 0; r < 16; r += 2) sO0[(db * 8 + (r >> 1)) * 64 + lane] = pk2(O[db][r] * linv, O[db][r + 1] * linv);
                } else {
                    float ss = 0.f;
#pragma unroll
                    for (int db = 0; db < 4; ++db)
#pragma unroll
                        for (int r = 0; r < 16; r += 2) { const unsigned w0 = sO0[(db * 8 + (r >> 1)) * 64 + lane];
                            const float o0 = bflo(w0) - lam * (O[db][r] * linv), o1 = bfhi(w0) - lam * (O[db][r + 1] * linv); O[db][r] = o0; O[db][r + 1] = o1; ss += o0 * o0 + o1 * o1; }
                    ss += __int_as_float(__builtin_amdgcn_ds_bpermute((lane ^ 32) << 2, __float_as_int(ss)));
                    const float rs = 1.f / sqrtf(ss * (1.f / 128.f) + RMS_EPS);
                    bf16* orow = MIXO + tokq * D + h * 128 + 4 * hi;
#pragma unroll
                    for (int db = 0; db < 4; ++db)
#pragma unroll
                        for (int rg = 0; rg < 4; ++rg) { const int d0 = 32 * db + 8 * rg + 4 * hi; const f32x4 g4 = *(const LAS f32x4*)(sG + d0);
                            u32x2_t w; w.x = pk2(O[db][4 * rg] * rs * g4.x, O[db][4 * rg + 1] * rs * g4.y); w.y = pk2(O[db][4 * rg + 2] * rs * g4.z, O[db][4 * rg + 3] * rs * g4.w);
                            *(u32x2_t*)(orow + 32 * db + 8 * rg) = w; }
                }
            }
        }
    }
    __syncthreads();
}

__device__ __forceinline__ void moe_tail_down(Frame& F, int lslot) {
    pg8::MoeOrder S; S.init((const unsigned*)(F.ctl + CW_CNT + 16 * lslot), 4, F.G, F.bx); S.cut_tail();
    const int ntail = S.so.nwg - S.so.lim;
    if (ntail <= 0) return;
    const bf16* A = (const bf16*)(F.ws + WS_HIDP); const bf16* Bt = (const bf16*)(F.ws + WS_WB + WB_MDN); bf16* O = (bf16*)(F.ws + WS_XPERM);
    int lane = F.lane; asm volatile("" : "+v"(lane)); const int fr = lane & 15, fq = lane >> 4;
    LAS unsigned char* red = F.lds;
    for (int rr = 0; rr * 16 < ntail; ++rr) {
        const int j = F.bx >> 3, t = (F.bx & 7) + 8 * ((j >> 4) + 2 * rr), p = j & 15;
        if (t >= ntail) continue;
        pg8::Unit u; S.at((long)S.so.lim + t, u);
        const int sr = (p >> 2) & 3, sc = p & 3;
        const bf16* ap = A + (size_t)(u.pm * 256 + 64 * sr + fr) * FF + 352 * F.wave + 8 * fq;
        const bf16* bp = Bt + (size_t)(u.pb * 256 + 64 * sc + fr) * FF + 352 * F.wave + 8 * fq;
        f32x4_t acc[4][4];
#pragma unroll
        for (int m = 0; m < 4; ++m)
#pragma unroll
            for (int n = 0; n < 4; ++n) acc[m][n] = (f32x4_t){0.f, 0.f, 0.f, 0.f};
        bf16x8_t fa[3][4], fb[3][4];
#define TL_LOAD(st, s) do { _Pragma("unroll") for (int g = 0; g < 4; ++g) { fa[st][g] = *(const bf16x8_t*)(ap + (size_t)(16 * g) * FF + 32 * (s)); fb[st][g] = *(const bf16x8_t*)(bp + (size_t)(16 * g) * FF + 32 * (s)); } } while (0)
        TL_LOAD(0, 0); TL_LOAD(1, 1);
#pragma unroll
        for (int s = 0; s < 11; ++s) {
            if (s + 2 < 11) TL_LOAD((s + 2) % 3, s + 2);
            __builtin_amdgcn_sched_barrier(0);
#pragma unroll
            for (int m = 0; m < 4; ++m)
#pragma unroll
                for (int n = 0; n < 4; ++n) acc[m][n] = __builtin_amdgcn_mfma_f32_16x16x32_bf16(fb[s % 3][n], fa[s % 3][m], acc[m][n], 0, 0, 0);
            __builtin_amdgcn_sched_barrier(0);
        }
#undef TL_LOAD
#pragma unroll
        for (int m = 0; m < 4; ++m)
#pragma unroll
            for (int n = 0; n < 4; ++n) *(LAS f32x4_t*)(red + ((size_t)((F.wave * 16 + m * 4 + n) * 64 + lane)) * 16) = acc[m][n];
        __syncthreads();
#pragma unroll
        for (int q2 = 0; q2 < 2; ++q2) {
            const int q = 2 * F.wave + q2, m = q >> 2, n = q & 3;
            f32x4_t t = *(const LAS f32x4_t*)(red + ((size_t)(q * 64 + lane)) * 16);
#pragma unroll
            for (int v = 1; v < 8; ++v) t += *(const LAS f32x4_t*)(red + ((size_t)((v * 16 + q) * 64 + lane)) * 16);
            bf16* op = O + (size_t)(u.pm * 256 + 64 * sr + 16 * m + fr) * D + u.pn * 256 + 64 * sc + 16 * n + 4 * fq;
            *(GAS unsigned long long*)op = (unsigned long long)pk2(t[0], t[1]) | ((unsigned long long)pk2(t[2], t[3]) << 32);
        }
        __syncthreads();
    }
}

struct Args { const float* in[34]; float* out; unsigned char* ws; int lo, hi; };
constexpr int PH_PER_PAIR = 17, NPHASE = 1 + 2 * PH_PER_PAIR;
#ifndef PHMASK
#define PHMASK 0x3FFFFu
#endif
#define PHON(k) (((PHMASK) >> (k)) & 1u)

__device__ __forceinline__ void frame_refresh(Frame& F) {
    int wv = F.wave0; asm volatile("" : "+s"(wv));
    int ln; asm volatile("v_mbcnt_lo_u32_b32 %0, -1, 0\n\tv_mbcnt_hi_u32_b32 %0, -1, %0" : "=v"(ln));
    ln &= 63; wv &= 7; const int t = wv * 64 + ln;
    int bx = blockIdx.x; asm volatile("" : "+s"(bx));
    const __attribute__((address_space(4))) unsigned char* kp = (const __attribute__((address_space(4))) unsigned char*)__builtin_amdgcn_kernarg_segment_ptr(); asm volatile("" : "+s"(kp));
    typedef unsigned char* ucp; unsigned char* w = *(const __attribute__((address_space(4))) ucp*)(kp + 280);
    F.kp = kp; F.tid = t; F.lane = t & 63; F.wave = wv;
    F.bx = bx; F.gw = bx * NWAVES + F.wave; F.ws = w; F.ctl = (gu32*)(w + WS_CTL);
}

#define IN(k) (lo <= (k) && (k) < hi)
#define SEAM(k) do { if (IN((k) + 1)) xcd_barrier(bar, F.tid); } while (0)
#define WSB(off) ((bf16*)(F.ws + (off)))
template <int lp> __device__ __forceinline__ void layer_pair(Frame& F, const int lo, const int hi, const XcdBarrier& bar, unsigned char* lds) {
        const int pb = 1 + PH_PER_PAIR * lp;
        if (PHON(1) && IN(pb + 0)) {
            frame_refresh(F);
            pg8::Gemm g{WSB(WS_XB), WSB(WS_WB + WB_WIN), M, EINP, D}; pg8::StaticOrder S; S.init(M, EINP, F.G, F.bx);
            pg8::EpiBf16<0> E{WSB(WS_P), EINP, nullptr, 0, 0, 1.f};
            pg8::gemm_phase<pg8::EpiBf16<0>, pg8::StaticOrder, true, true>(F.lds, g, S, E, F.tid);
            SEAM(pb + 0);
        }
        if (PHON(2) && IN(pb + 1)) { frame_refresh(F); dsa_prep(F, lp); gla_prep(F, lp); SEAM(pb + 1); }
        if (PHON(3) && IN(pb + 2)) { frame_refresh(F); dsa_index(F); frame_refresh(F); gla_scan(F); SEAM(pb + 2); }
        if (PHON(4) && IN(pb + 3)) { frame_refresh(F);
            dsa_body::dsa_attn_phase<8>((char*)lds, (const dsa_body::bf16*)(F.ws + WS_P) + PC_AQ, (const dsa_body::bf16*)(F.ws + WS_KD), (const dsa_body::bf16*)(F.ws + WS_VD), (dsa_body::bf16*)(F.ws + WS_MIX), (const unsigned*)(F.ws + WS_MASK), F.bx, F.G, F.tid);
            __syncthreads(); gla_out(F, lp); SEAM(pb + 3); }
        if (PHON(5) && IN(pb + 4)) {
            frame_refresh(F);
            pg8::Gemm g{WSB(WS_MIX), WSB(WS_WB + WB_WOUT), M, D, D}; pg8::PanelOrder S; S.init(M, F.bx);
            pg8::EpiLnFused E{WSB(WS_XB), F.inp(11) + lp * D, F.inp(12) + lp * D, (unsigned long long*)(F.ws + WS_XSTAT), (unsigned*)(F.ctl + CW_PANEL + 8192 * (2 * lp)), (unsigned*)(F.ctl + CW_TMO), F.lds + XTRA_OFF};
            pg8::gemm_phase<pg8::EpiLnFused, pg8::PanelOrder, true, true>(F.lds, g, S, E, F.tid);
            SEAM(pb + 4);
        }
        if (PHON(7) && IN(pb + 6)) {
            frame_refresh(F);
            pg8::Gemm g{WSB(WS_XB), WSB(WS_WB + WB_WGU), M, 2 * FF, D}; pg8::StaticOrder S; S.init(M, 2 * FF, F.G, F.bx);
            pg8::EpiSwiGLU E{WSB(WS_HID), FF};
            pg8::gemm_phase<pg8::EpiSwiGLU, pg8::StaticOrder, true, true>(F.lds, g, S, E, F.tid);
            SEAM(pb + 6);
        }
        if (PHON(8) && IN(pb + 7)) {
            frame_refresh(F);
            pg8::Gemm g{WSB(WS_HID), WSB(WS_WB + WB_WDN), M, D, FF}; pg8::PanelOrder S; S.init(M, F.bx);
            pg8::EpiLnFused E{WSB(WS_XB), F.inp(16) + lp * D, F.inp(17) + lp * D, (unsigned long long*)(F.ws + WS_XSTAT), (unsigned*)(F.ctl + CW_PANEL + 8192 * (2 * lp + 1)), (unsigned*)(F.ctl + CW_TMO), F.lds + XTRA_OFF};
            pg8::gemm_phase<pg8::EpiLnFused, pg8::PanelOrder, true, true>(F.lds, g, S, E, F.tid);
            SEAM(pb + 7);
        }
        if (PHON(9) && IN(pb + 8)) { frame_refresh(F); cvt_odd(F, lp); SEAM(pb + 8); }
        if (PHON(10) && IN(pb + 9)) {
            frame_refresh(F);
            pg8::Gemm g{WSB(WS_XB), WSB(WS_WB + WB_WQKV), M, 3072, D}; pg8::StaticOrder S; S.init(M, 3072, F.G, F.bx);
            pg8::EpiBf16<0> E{WSB(WS_QKV), 3072, nullptr, 1024, 1024, C2};
            pg8::gemm_phase<pg8::EpiBf16<0>, pg8::StaticOrder, true, true>(F.lds, g, S, E, F.tid);
            SEAM(pb + 9);
        }
        if (PHON(11) && IN(pb + 10)) {
            frame_refresh(F);
            constexpr float lam_init = (lp == 0) ? 0.355509068f : 0.556058204f;
            diff_attn_t(F, lds, lp, lam_init);
            SEAM(pb + 10);
        }
        if (PHON(12) && IN(pb + 11)) {
            frame_refresh(F);
            pg8::Gemm g{WSB(WS_MIXO), WSB(WS_WB + WB_WOUT), M, D, D}; pg8::StaticOrder S; S.init(M, D, F.G, F.bx);
            pg8::EpiBf16<0> E{WSB(WS_H_ODD), D, nullptr, 0, 0, 1.f};
            pg8::gemm_phase<pg8::EpiBf16<0>, pg8::StaticOrder, true, true>(F.lds, g, S, E, F.tid);
            SEAM(pb + 11);
        }
        if (PHON(13) && IN(pb + 12)) { frame_refresh(F);
            ln_phase<0, true, true, false>(F, (const float*)F.outp(), WSB(WS_H_ODD), F.inp(25) + lp * D, F.inp(26) + lp * D, F.outp(), WSB(WS_XB), F.inp(27) + (size_t)lp * D * NEXP, F.inp(28) + lp * NEXP, lp); SEAM(pb + 12); }
        if (PHON(14) && IN(pb + 13)) { frame_refresh(F); moe_map(F, lp); SEAM(pb + 13); }
        if (PHON(15) && IN(pb + 14)) {
            frame_refresh(F);
            pg8::MoeOrder S; S.init((const unsigned*)(F.ctl + CW_CNT + 16 * lp), 22, F.G, F.bx);
            pg8::Gemm g{WSB(WS_XB), WSB(WS_WB + WB_MGU), S.so.nM * 256, 2 * FF, D, (const int*)(F.ws + WS_INV)};
            pg8::EpiSwiGLU E{WSB(WS_HIDP), FF};
            pg8::gemm_phase<pg8::EpiSwiGLU, pg8::MoeOrder, true, true, true>(F.lds, g, S, E, F.tid);
            SEAM(pb + 14);
        }
        if (PHON(16) && IN(pb + 15)) {
            frame_refresh(F);
            pg8::MoeOrder S; S.init((const unsigned*)(F.ctl + CW_CNT + 16 * lp), 4, F.G, F.bx); S.cut_tail();
            pg8::Gemm g{WSB(WS_HIDP), WSB(WS_WB + WB_MDN), S.so.nM * 256, D, FF};
            pg8::EpiBf16<0> E{WSB(WS_XPERM), D, nullptr, 0, 0, 1.f};
            pg8::gemm_phase<pg8::EpiBf16<0>, pg8::MoeOrder, true, true>(F.lds, g, S, E, F.tid);
            frame_refresh(F); moe_tail_down(F, lp);
            SEAM(pb + 15);
        }
        if (PHON(17) && IN(pb + 16)) {
            frame_refresh(F);
            ln_phase<1, false, true, lp == 1>(F, (const float*)F.outp(), WSB(WS_XPERM), F.inp(32) + lp * D, F.inp(33) + lp * D, F.outp(), WSB(WS_XB), nullptr, nullptr, 0);
            if (lp == 0) { __syncthreads(); cvt_even(F, 1); SEAM(pb + 16); }
        }
    }

__global__ void __launch_bounds__(NTHR, 2) mega_fwd(Args args) {
    extern __shared__ __attribute__((aligned(16))) unsigned char lds[];
    Frame F;
    F.lds = (LAS unsigned char*)lds; F.MISC = (volatile LAS unsigned*)(F.lds + MISC_OFF);
    F.G = gridDim.x; F.NGW = F.G * NWAVES; F.wave0 = __builtin_amdgcn_readfirstlane((int)threadIdx.x >> 6);
    frame_refresh(F);
    for (int u = F.tid; u < (LDS_BYTES - LDSCTL_OFF) / 4; u += NTHR) ((LAS unsigned*)(F.lds + LDSCTL_OFF))[u] = 0u;
    __syncthreads();
    const int lo = args.lo, hi = args.hi;
    const bool use_bar = (hi - lo) > 1;
    XcdBarrier bar; bar.bar = (unsigned*)(F.ctl + CW_BAR); bar.x = 0; bar.st = nullptr;
    if (use_bar) bar = xcd_barrier_post((unsigned*)(F.ctl + CW_BAR), F.MISC + 8, F.tid);

    if (PHON(0) && IN(0)) { frame_refresh(F); cvt_even(F, 0); xb_from_x(F); SEAM(0); }

    layer_pair<0>(F, lo, hi, bar, lds);
    layer_pair<1>(F, lo, hi, bar, lds);
#undef IN
#undef SEAM
}

#ifndef MK_SINGLE
#define MK_SINGLE 1
#endif
extern "C" void kernel_launch(void* const* d_in, const int* in_sizes, int n_in, void* d_out, int out_size, void* d_ws, size_t ws_size, hipStream_t stream) {
    static int grid = 0;
    if (grid == 0) {
        if (n_in != 34 || in_sizes[0] != M * D || out_size != M * D || ws_size < WS_END) { fprintf(stderr, "kernel_launch: unexpected shapes or workspace (n_in %d, ws %zu)\n", n_in, ws_size); grid = -1; return; }
        int dev = 0, cus = 0, per_cu = 0;
        if (hipGetDevice(&dev) != hipSuccess || hipDeviceGetAttribute(&cus, hipDeviceAttributeMultiprocessorCount, dev) != hipSuccess) { grid = -1; return; }
        if (hipFuncSetAttribute((const void*)mega_fwd, hipFuncAttributeMaxDynamicSharedMemorySize, LDS_BYTES) != hipSuccess) { grid = -1; return; }
        if (hipOccupancyMaxActiveBlocksPerMultiprocessor(&per_cu, (const void*)mega_fwd, NTHR, LDS_BYTES) != hipSuccess || per_cu < 1) fprintf(stderr, "kernel_launch: occupancy query says %d\n", per_cu);
        (void)hipGetLastError();
        if (cus != 256) { fprintf(stderr, "kernel_launch: this kernel is laid out for 256 CUs (got %d)\n", cus); grid = -1; return; }
        grid = cus;
    }
    if (grid < 0) return;
    (void)hipMemsetAsync((char*)d_ws + WS_CTL, 0, CTL_ZERO_BYTES, stream);
    Args a{};
    for (int i = 0; i < 34; ++i) a.in[i] = (const float*)d_in[i];
    a.out = (float*)d_out; a.ws = (unsigned char*)d_ws;
    a.lo = 0; a.hi = NPHASE;
    hipLaunchKernelGGL(mega_fwd, dim3(grid), dim3(NTHR), LDS_BYTES, stream, a);
}
```

```cpp
#include <hip/hip_runtime.h>
#include <cstdio>
#include <cstdint>
#include <cmath>
namespace pg8 {
#define PG8_LAS __attribute__((address_space(3)))
typedef unsigned short bf16_t;
typedef short bf16x8 __attribute__((ext_vector_type(8)));
typedef float f32x4 __attribute__((ext_vector_type(4)));
typedef unsigned u32x4 __attribute__((ext_vector_type(4)));
constexpr int BM = 256, BK = 64, HALF = 128, HTB = HALF * BK * 2  , STAGE_BYTES = 8 * HTB, NXCD = 8, WGM = 5;

__host__ __device__ __forceinline__ int lds_byte(int r, int c) { const int st = (r >> 4) * 2 + (c >> 5), rr = r & 15, cc = c & 31, ob = rr * 64 + cc * 2; return st * 1024 + (ob ^ (((ob >> 9) & 1) << 5)); }
__host__ __device__ __forceinline__ void stage_rc(int b, int& R, int& C) { const int st = b / 1024, sb = b % 1024, swz = sb ^ (((sb >> 9) & 1) << 5); R = (st >> 1) * 16 + swz / 64; C = (st & 1) * 32 + (swz % 64) / 2; }
__host__ __device__ __forceinline__ int perm32(int rho) { const int n = rho >> 4, i = rho & 15; return 8 * (i >> 2) + 4 * n + (i & 3); }

struct Unit { int pm, pn, pb; };
struct Gemm { const bf16_t* A; const bf16_t* Bt; int M, N, K; const int* inv = nullptr; };

struct StaticOrder {
    int nM, nN, nwg, G, c, lim;
    __host__ __device__ void init(int M, int N, int G_, int c_) { nM = M / BM; nN = N / BM; nwg = nM * nN; G = G_; c = c_; lim = nwg; }
    __host__ __device__ bool next(int i, Unit& u) const { const long L = (long)i * G + c; if (L >= lim) return false; return at(L, u); }
    __host__ __device__ bool at(long L, Unit& u) const {
        if (L >= nwg) return false;
        int wgid = (int)L; { const int q = nwg / NXCD, r = nwg % NXCD, xcd = wgid % NXCD, off = wgid / NXCD; wgid = (xcd < r ? xcd * (q + 1) : r * (q + 1) + (xcd - r) * q) + off; }
        const int nig = WGM * nN, gid = wgid / nig, fm = gid * WGM, gsz = (nM - fm) < WGM ? (nM - fm) : WGM;
        u.pm = fm + ((wgid % nig) % gsz); u.pn = (wgid % nig) / gsz; u.pb = u.pn; return true;
    }
    __device__ __forceinline__ void a_ready(const Unit&) const {}
    __device__ __forceinline__ void done(const Unit&) const {}
};

__device__ __forceinline__ unsigned cvt_pk_bf16(float lo, float hi) { unsigned r; asm volatile("v_cvt_pk_bf16_f32 %0, %1, %2" : "=v"(r) : "v"(lo), "v"(hi)); return r; }
typedef float f32x2 __attribute__((ext_vector_type(2)));
__device__ __forceinline__ f32x2 gelu_pk(f32x2 v) {
    const f32x2 av = __builtin_elementwise_abs(v), d = av * 0.2316418882f + 1.0f;
    f32x2 t; t.x = __builtin_amdgcn_rcpf(d.x); t.y = __builtin_amdgcn_rcpf(d.y);
    f32x2 q = t * 0.5307027145f + (-0.7265760135f); q = q * t + 0.7107068705f; q = q * t + (-0.142248368f); q = q * t + 0.127414796f; q = q * t;
    const f32x2 s = (v * v) * (-0.72134752044f);
    f32x2 e; e.x = __builtin_amdgcn_exp2f(s.x); e.y = __builtin_amdgcn_exp2f(s.y);
    const f32x2 m = v * (q * e), r = v - m;
    f32x2 o; o.x = v.x < 0.f ? m.x : r.x; o.y = v.y < 0.f ? m.y : r.y; return o;
}

template <int ACT  > struct EpiBf16 {
    static constexpr bool PERM = true, AFTER_DRAIN = false; static_assert(ACT == 0 || ACT == 1, "EpiBf16: ACT is 0 (none) or 1 (gelu_pk)");
    bf16_t* O; int ldc; const float* bias; int split_cols; size_t split_stride; float scale0;
    __device__ __forceinline__ void operator()(const f32x4 (&acc)[2][2][4][2], const Unit& u, int wr, int wc, int fr, int fq) const {
        const int row0 = u.pm * BM + wr * 64 + fr; int colt = u.pn * BM; bf16_t* base = O;
        float sc = 1.f; if (split_cols) { const int t = colt / split_cols; base += (size_t)t * split_stride; colt -= t * split_cols; if (t == 0) sc = scale0; }
        const int col0 = colt + wc * 32 + 8 * fq, bcol0 = u.pn * BM + wc * 32 + 8 * fq;
        f32x4 bv[2][2];
#pragma unroll
        for (int bj = 0; bj < 2; ++bj)
#pragma unroll
            for (int n = 0; n < 2; ++n) bv[bj][n] = bias ? *(const f32x4*)(bias + bcol0 + bj * HALF + 4 * n) : (f32x4){0.f, 0.f, 0.f, 0.f};
#pragma unroll
        for (int ai = 0; ai < 2; ++ai)
#pragma unroll
            for (int m = 0; m < 4; ++m) { bf16_t* rowp = base + (size_t)(row0 + ai * HALF + m * 16) * ldc + col0;
#pragma unroll
                for (int bj = 0; bj < 2; ++bj) { f32x4 v0 = acc[ai][bj][m][0] + bv[bj][0], v1 = acc[ai][bj][m][1] + bv[bj][1];
                    if (ACT == 1) { f32x2 a = gelu_pk((f32x2){v0[0], v0[1]}), b = gelu_pk((f32x2){v0[2], v0[3]}), c = gelu_pk((f32x2){v1[0], v1[1]}), d = gelu_pk((f32x2){v1[2], v1[3]});
                        v0 = (f32x4){a.x, a.y, b.x, b.y}; v1 = (f32x4){c.x, c.y, d.x, d.y}; }
                    v0 = v0 * sc; v1 = v1 * sc; u32x4 w; w.x = cvt_pk_bf16(v0[0], v0[1]); w.y = cvt_pk_bf16(v0[2], v0[3]); w.z = cvt_pk_bf16(v1[0], v1[1]); w.w = cvt_pk_bf16(v1[2], v1[3]);
                    *(u32x4*)(rowp + bj * HALF) = w; } }
    }
};
template <class Epi, class Sched, bool ALIGN_EPI = false, bool SP2 = false, bool GATHER = false>
__device__ __forceinline__ void gemm_phase(PG8_LAS unsigned char* lds, const Gemm g, const Sched& S, const Epi& E, const int tid) {
    const int wid = __builtin_amdgcn_readfirstlane(tid >> 6), lane = tid & 63, wr = wid >> 2, wc = wid & 3, fr = lane & 15, fq = lane >> 4;
    const int K = g.K, nt = K / BK;
    unsigned voffA[2], voffB[2];
#pragma unroll
    for (int i = 0; i < 2; ++i) { int R, C; stage_rc(tid * 16 + i * 8192, R, C); const int Rb = Epi::PERM ? ((R & ~31) + perm32(R & 31)) : R;
        voffA[i] = (unsigned)(R * K + C) * 2u; voffB[i] = (unsigned)(Rb * K + C) * 2u; }
    unsigned vA[2][2], vN[2][2]; int rawN[2][2]; int gR[2], gC[2];
#pragma unroll
    for (int i = 0; i < 2; ++i) { stage_rc(tid * 16 + i * 8192, gR[i], gC[i]); vA[0][i] = vA[1][i] = vN[0][i] = vN[1][i] = voffA[i]; rawN[0][i] = rawN[1][i] = 0; }
    const size_t kstep = (size_t)(BK * 2);
    const size_t hstep = (size_t)HALF * K * 2;
    const size_t hsA = GATHER ? (size_t)0 : hstep;
    const size_t tstep = 2 * hstep;
    const unsigned ldsw = (unsigned)wid * 1024u;
    const int aoff = lds_byte(wr * 64 + fr, fq * 8), boff = lds_byte(wc * 32 + fr, fq * 8);
#define PG8_SA(b, h) (((b) * 2 + (h)) * HTB)
#define PG8_SB(b, h) ((4 + (b) * 2 + (h)) * HTB)
#define PG8_STAGE(bufoff, gbase, voff) do { _Pragma("unroll") for (int _i = 0; _i < 2; ++_i) \
        __builtin_amdgcn_global_load_lds((const unsigned*)((const char*)(gbase) + (voff)[_i]), (PG8_LAS unsigned*)(lds + (bufoff) + ldsw + _i * 8192), 16, 0, 0); } while (0)
#define PG8_LDA(dst, b, h) do { _Pragma("unroll") for (int m = 0; m < 4; ++m) _Pragma("unroll") for (int k = 0; k < 2; ++k) dst[m][k] = *(const PG8_LAS bf16x8*)(lds + PG8_SA(b, h) + aoff + m * 2048 + k * 1024); } while (0)
#define PG8_LDB(dst, b, h) do { _Pragma("unroll") for (int n = 0; n < 2; ++n) _Pragma("unroll") for (int k = 0; k < 2; ++k) dst[n][k] = *(const PG8_LAS bf16x8*)(lds + PG8_SB(b, h) + boff + n * 2048 + k * 1024); } while (0)
#define PG8_MMA(ai, bj, At, Bt) do { __builtin_amdgcn_s_setprio(1); _Pragma("unroll") for (int m = 0; m < 4; ++m) _Pragma("unroll") for (int n = 0; n < 2; ++n) _Pragma("unroll") for (int k = 0; k < 2; ++k) \
        acc[ai][bj][m][n] = __builtin_amdgcn_mfma_f32_16x16x32_bf16(Bt[n][k], At[m][k], acc[ai][bj][m][n], 0, 0, 0); __builtin_amdgcn_s_setprio(0); } while (0)
#define PG8_WAIT_V(n) asm volatile("s_waitcnt vmcnt(" #n ")" ::: "memory")
#define PG8_WAIT_L(n) asm volatile("s_waitcnt lgkmcnt(" #n ")" ::: "memory")
#define PG8_BAR __builtin_amdgcn_s_barrier()
#define PG8_SCHED __builtin_amdgcn_sched_barrier(0)
    Unit cur, nxt; int ui = 0;
    if (!S.next(0, cur)) return;
    f32x4 acc[2][2][4][2];
#pragma unroll
    for (int a = 0; a < 2; ++a)
#pragma unroll
        for (int b = 0; b < 2; ++b)
#pragma unroll
            for (int m = 0; m < 4; ++m)
#pragma unroll
                for (int n = 0; n < 2; ++n) acc[a][b][m][n] = (f32x4){0.f, 0.f, 0.f, 0.f};
    bf16x8 At[4][2], B0[2][2], B1[2][2];
    const char* cA = GATHER ? (const char*)g.A : (const char*)g.A + (size_t)cur.pm * tstep; const char* cB = (const char*)g.Bt + (size_t)cur.pb * tstep;
    if constexpr (GATHER) {
#pragma unroll
        for (int h = 0; h < 2; ++h)
#pragma unroll
            for (int i = 0; i < 2; ++i) vA[h][i] = vN[h][i] = (unsigned)g.inv[cur.pm * BM + HALF * h + gR[i]] * (unsigned)(K * 2) + (unsigned)(gC[i] * 2);
    }
    S.a_ready(cur);
    if constexpr (SP2) {
        PG8_STAGE(PG8_SB(0, 0), cB, voffB); PG8_STAGE(PG8_SB(0, 1), cB + hstep, voffB); PG8_STAGE(PG8_SA(0, 0), cA, vA[0]); PG8_STAGE(PG8_SA(0, 1), cA + hsA, vA[1]);
        if (wr == 1) PG8_BAR;
        PG8_WAIT_V(2); PG8_BAR;
        PG8_STAGE(PG8_SB(1, 0), cB + kstep, voffB); PG8_STAGE(PG8_SA(1, 0), cA + kstep, vA[0]); PG8_STAGE(PG8_SB(1, 1), cB + hstep + kstep, voffB);
        PG8_WAIT_V(6); PG8_BAR;
    } else {
        PG8_STAGE(PG8_SB(0, 0), cB, voffB); PG8_STAGE(PG8_SA(0, 0), cA, vA[0]); PG8_STAGE(PG8_SB(0, 1), cB + hstep, voffB); PG8_STAGE(PG8_SA(0, 1), cA + hsA, vA[1]);
        if (wr == 1) PG8_BAR;
        PG8_WAIT_V(4); PG8_BAR;
        PG8_STAGE(PG8_SB(1, 0), cB + kstep, voffB); PG8_STAGE(PG8_SA(1, 0), cA + kstep, vA[0]); PG8_STAGE(PG8_SB(1, 1), cB + hstep + kstep, voffB);
        PG8_WAIT_V(6); PG8_BAR;
    }
    for (;;) {
        const bool has_next = S.next(ui + 1, nxt);
        if constexpr (GATHER) {
            if (has_next) {
#pragma unroll
                for (int h = 0; h < 2; ++h)
#pragma unroll
                    for (int i = 0; i < 2; ++i) asm volatile("global_load_dword %0, %1, off" : "=&v"(rawN[h][i]) : "v"(g.inv + nxt.pm * BM + HALF * h + gR[i]) : "memory");
            }
        }
        const char* nA = GATHER ? cA : (has_next ? (const char*)g.A + (size_t)nxt.pm * tstep : cA); const char* nB = has_next ? (const char*)g.Bt + (size_t)nxt.pb * tstep : cB;
        for (int t = 0; t < nt; t += 2) {
            const bool last = (t == nt - 2);
            const char* a1 = cA + (size_t)(t + 1) * kstep;
            const char* a2 = last ? nA : cA + (size_t)(t + 2) * kstep; const char* b2 = last ? nB : cB + (size_t)(t + 2) * kstep;
            const char* a3 = a2 + kstep; const char* b3 = b2 + kstep;
            if (last && has_next) S.a_ready(nxt);
            if constexpr (GATHER) {
                if (last) {
                    if (has_next) {
#pragma unroll
                        for (int h = 0; h < 2; ++h)
#pragma unroll
                            for (int i = 0; i < 2; ++i) { int tkn; asm volatile("v_mov_b32 %0, %1" : "=v"(tkn) : "v"(rawN[h][i])); vN[h][i] = (unsigned)tkn * (unsigned)(K * 2) + (unsigned)(gC[i] * 2); }
                    } else {
#pragma unroll
                        for (int h = 0; h < 2; ++h)
#pragma unroll
                            for (int i = 0; i < 2; ++i) vN[h][i] = vA[h][i];
                    }
                }
            }
            unsigned v2[2][2];
#pragma unroll
            for (int h = 0; h < 2; ++h)
#pragma unroll
                for (int i = 0; i < 2; ++i) v2[h][i] = last ? vN[h][i] : vA[h][i];
            if constexpr (SP2) {
            PG8_LDB(B0, 0, 0); PG8_LDB(B1, 0, 1); PG8_SCHED; PG8_LDA(At, 0, 0); PG8_STAGE(PG8_SA(1, 1), a1 + hsA, vA[1]);
            PG8_WAIT_V(8); PG8_WAIT_L(0); PG8_BAR; PG8_MMA(0, 0, At, B0); PG8_MMA(0, 1, At, B1); PG8_BAR; PG8_SCHED;
            PG8_LDA(At, 0, 1); PG8_STAGE(PG8_SB(0, 0), b2, voffB); PG8_STAGE(PG8_SB(0, 1), b2 + hstep, voffB); PG8_STAGE(PG8_SA(0, 0), a2, v2[0]);
            PG8_WAIT_V(8); PG8_WAIT_L(0); PG8_BAR; PG8_MMA(1, 0, At, B0); PG8_MMA(1, 1, At, B1); PG8_BAR; PG8_SCHED;
            PG8_LDB(B0, 1, 0); PG8_LDB(B1, 1, 1); PG8_SCHED; PG8_LDA(At, 1, 0); PG8_STAGE(PG8_SA(0, 1), a2 + hsA, v2[1]);
            PG8_WAIT_V(8); PG8_WAIT_L(0); PG8_BAR; PG8_MMA(0, 0, At, B0); PG8_MMA(0, 1, At, B1); PG8_BAR; PG8_SCHED;
            PG8_LDA(At, 1, 1); PG8_STAGE(PG8_SB(1, 0), b3, voffB); PG8_STAGE(PG8_SB(1, 1), b3 + hstep, voffB); PG8_STAGE(PG8_SA(1, 0), a3, v2[0]);
            PG8_WAIT_V(8); PG8_WAIT_L(0); PG8_BAR; PG8_MMA(1, 0, At, B0); PG8_MMA(1, 1, At, B1); PG8_BAR; PG8_SCHED;
            } else {
            PG8_LDB(B0, 0, 0); PG8_SCHED; PG8_LDA(At, 0, 0); PG8_STAGE(PG8_SA(1, 1), a1 + hsA, vA[1]);
            PG8_WAIT_L(8); PG8_BAR; PG8_WAIT_L(0); PG8_MMA(0, 0, At, B0); PG8_BAR; PG8_SCHED;
            PG8_LDB(B1, 0, 1); PG8_STAGE(PG8_SB(0, 0), b2, voffB);
            PG8_BAR; PG8_WAIT_L(0); PG8_MMA(0, 1, At, B1); PG8_BAR;
            PG8_LDA(At, 0, 1); PG8_STAGE(PG8_SA(0, 0), a2, v2[0]);
            PG8_BAR; PG8_WAIT_L(0); PG8_MMA(1, 0, At, B0); PG8_BAR; PG8_SCHED;
            PG8_STAGE(PG8_SB(0, 1), b2 + hstep, voffB);
            PG8_WAIT_V(6); PG8_BAR; PG8_MMA(1, 1, At, B1); PG8_BAR;
            PG8_LDB(B0, 1, 0); PG8_SCHED; PG8_LDA(At, 1, 0); PG8_STAGE(PG8_SA(0, 1), a2 + hsA, v2[1]);
            PG8_WAIT_L(8); PG8_BAR; PG8_WAIT_L(0); PG8_MMA(0, 0, At, B0); PG8_BAR; PG8_SCHED;
            PG8_LDB(B1, 1, 1); PG8_STAGE(PG8_SB(1, 0), b3, voffB);
            PG8_BAR; PG8_WAIT_L(0); PG8_MMA(0, 1, At, B1); PG8_BAR;
            PG8_LDA(At, 1, 1); PG8_STAGE(PG8_SA(1, 0), a3, v2[0]);
            PG8_BAR; PG8_WAIT_L(0); PG8_MMA(1, 0, At, B0); PG8_BAR; PG8_SCHED;
            PG8_STAGE(PG8_SB(1, 1), b3 + hstep, voffB);
            PG8_WAIT_V(6); PG8_BAR; PG8_MMA(1, 1, At, B1); PG8_BAR;
            }
        }
        if constexpr (ALIGN_EPI) { if (wr == 0) PG8_BAR; }
        if constexpr (!Epi::AFTER_DRAIN) { E(acc, cur, wr, wc, fr, fq); S.done(cur); }
        if (!has_next) break;
#pragma unroll
        for (int a = 0; a < 2; ++a)
#pragma unroll
            for (int b = 0; b < 2; ++b)
#pragma unroll
                for (int m = 0; m < 4; ++m)
#pragma unroll
                    for (int n = 0; n < 2; ++n) acc[a][b][m][n] = (f32x4){0.f, 0.f, 0.f, 0.f};
        cur = nxt; cA = nA; cB = nB; ++ui;
#pragma unroll
        for (int h = 0; h < 2; ++h)
#pragma unroll
            for (int i = 0; i < 2; ++i) vA[h][i] = vN[h][i];
        if constexpr (ALIGN_EPI) { if (wr == 1) PG8_BAR; }
    }
    PG8_WAIT_V(0);
    if constexpr (!ALIGN_EPI) { if (wr == 0) PG8_BAR; }
    PG8_BAR;
    if constexpr (Epi::AFTER_DRAIN) { E.fused(acc, cur, wr, wc, fr, fq, lds, wid, lane); S.done(cur); }
#undef PG8_SA
#undef PG8_SB
#undef PG8_STAGE
#undef PG8_LDA
#undef PG8_LDB
#undef PG8_MMA
#undef PG8_WAIT_V
#undef PG8_WAIT_L
#undef PG8_BAR
#undef PG8_SCHED
}
}
#define GAS __attribute__((address_space(1)))
#define LAS __attribute__((address_space(3)))
typedef unsigned short bf16;
typedef unsigned v4u __attribute__((ext_vector_type(4)));
typedef float f32x4 __attribute__((ext_vector_type(4)));
typedef short bf16x8 __attribute__((ext_vector_type(8)));
typedef GAS unsigned gu32;
typedef GAS unsigned long long gu64;
#define RLX_AGENT __ATOMIC_RELAXED, __HIP_MEMORY_SCOPE_AGENT
#define LDS_WAIT() asm volatile("s_waitcnt lgkmcnt(0)" ::: "memory")
#define VM_WAIT() asm volatile("s_waitcnt vmcnt(0)" ::: "memory")
#define LDS_BAR() do { asm volatile("s_waitcnt lgkmcnt(0)" ::: "memory"); __builtin_amdgcn_s_barrier(); asm volatile("" ::: "memory"); } while (0)
__device__ __forceinline__ unsigned long long rt() { return __builtin_amdgcn_s_memrealtime(); }
__device__ __forceinline__ unsigned f2bf(float f) { unsigned u = __builtin_bit_cast(unsigned, f); return (u + 0x7fffu + ((u >> 16) & 1u)) >> 16; }
__device__ __forceinline__ unsigned pk2(float lo, float hi) { typedef float f2_t __attribute__((ext_vector_type(2))); typedef __bf16 b2_t __attribute__((ext_vector_type(2))); f2_t v = {lo, hi}; b2_t b = __builtin_convertvector(v, b2_t); return __builtin_bit_cast(unsigned, b); }

#define XB_TMO      128
#define XB_XCNT(j)  (256  + 64 * (j))
#define XB_XSUB(j)  (1280 + 64 * (j))
#define XB_XGEN(j)  (2304 + 64 * (j))
#define XB_TOP      3328
#define XB_TOPGEN   3392
#define XCD_BAR_WORDS 3456
#define XB_SPIN_CAP (1u << 18)

__device__ __forceinline__ unsigned xb_ld(unsigned* p)              { return __hip_atomic_load(p, __ATOMIC_RELAXED, __HIP_MEMORY_SCOPE_AGENT); }
__device__ __forceinline__ unsigned xb_add(unsigned* p, unsigned v) { return __hip_atomic_fetch_add(p, v, __ATOMIC_RELAXED, __HIP_MEMORY_SCOPE_AGENT); }
__device__ __forceinline__ unsigned xb_xcc_id() { return (unsigned)__builtin_amdgcn_s_getreg((3 << 11) | 20) & 0xFu; }
#define XB_SPIN(cond, bar) do { unsigned _sp = 0; while (cond) { __builtin_amdgcn_s_sleep(1); \
    if ((++_sp & 255u) == 0u) { if (xb_ld(&(bar)[XB_TMO])) break; if (_sp > XB_SPIN_CAP) { atomicAdd(&(bar)[XB_TMO], 1u); break; } } } } while (0)

struct XcdBarrier {
    unsigned* bar; unsigned x;
    volatile LAS unsigned* st;
};

__device__ __forceinline__ XcdBarrier xcd_barrier_post(unsigned* bar, volatile LAS unsigned* st, const int tid) {
    XcdBarrier b; b.bar = bar; b.x = xb_xcc_id(); b.st = st;
    if (tid == 0) (void)xb_add(&bar[XB_XCNT(b.x)], 1u);
    return b;
}
__device__ __forceinline__ void xcd_barrier_complete(unsigned* bar, unsigned x, unsigned& nloc, unsigned& nx) {
    const unsigned G = gridDim.x * gridDim.y * gridDim.z;
    unsigned sum, cnt, mine, sp = 0u;
    for (;;) {
        sum = 0u; cnt = 0u; mine = 0u;
#pragma unroll 1
        for (unsigned j = 0; j < 16; ++j) { const unsigned c = xb_ld(&bar[XB_XCNT(j)]); sum += c; cnt += (c > 0u) ? 1u : 0u; mine = (j == x) ? c : mine; }
        if (sum == G) break;
        __builtin_amdgcn_s_sleep(1);
        if ((++sp & 255u) == 0u) { if (xb_ld(&bar[XB_TMO])) break; if (sp > XB_SPIN_CAP) { atomicAdd(&bar[XB_TMO], 1u); break; } }
    }
    nloc = mine > 0u ? mine : 1u; nx = cnt > 0u ? cnt : 1u;
}

__device__ __forceinline__ void xcd_barrier(const XcdBarrier& b, const int tid) {
    asm volatile("s_waitcnt vmcnt(0)" ::: "memory");
    __syncthreads();
    if (tid == 0) {
        unsigned* bar = b.bar;
        __builtin_amdgcn_s_waitcnt(0);
        unsigned nloc = b.st[0], nx = b.st[1];
        if (nloc == 0u) { xcd_barrier_complete(bar, b.x, nloc, nx); b.st[0] = nloc; b.st[1] = nx; }
        const unsigned old = xb_add(&bar[XB_XSUB(b.x)], 1u);
        const unsigned gen = old / nloc;
        if (old + 1u == (gen + 1u) * nloc) {
            __builtin_amdgcn_fence(__ATOMIC_RELEASE, "agent");
            asm volatile("s_waitcnt vmcnt(0)" ::: "memory");
            const unsigned og = xb_add(&bar[XB_TOP], 1u);
            const unsigned tg = og / nx;
            if (og + 1u == (tg + 1u) * nx) xb_add(&bar[XB_TOPGEN], 1u);
            else XB_SPIN(xb_ld(&bar[XB_TOPGEN]) == tg, bar);
            __builtin_amdgcn_fence(__ATOMIC_ACQUIRE, "agent");
            xb_add(&bar[XB_XGEN(b.x)], 1u);
            asm volatile("s_waitcnt vmcnt(0)" ::: "memory");
        } else {
            XB_SPIN(xb_ld(&bar[XB_XGEN(b.x)]) == gen, bar);
            __builtin_amdgcn_fence(__ATOMIC_ACQUIRE, "agent");
            asm volatile("s_waitcnt vmcnt(0)" ::: "memory");
        }
    }
    __syncthreads();
}

#include <hip/hip_bf16.h>
#include <cmath>
namespace dsa_body {
using bf16=__hip_bfloat16;
using bf16x8=__attribute__((ext_vector_type(8)))short;
using s16x4=__attribute__((ext_vector_type(4)))short;
using f32x16=__attribute__((ext_vector_type(16)))float;
using u32x4=__attribute__((ext_vector_type(4)))unsigned;
constexpr int SEQ=2048,D=64,DM=64,DMQ=2816,DMO=1024;
constexpr int NW=8,QBLK=32,QB=QBLK*NW,KVBLK=64,NQB=SEQ/QB;
__device__ __forceinline__ int crow(int r,int hi){return (r&3)+8*(r>>2)+4*hi;}
#define SBAR() __builtin_amdgcn_sched_barrier(0)
typedef unsigned u32x2 __attribute__((ext_vector_type(2)));
__device__ __forceinline__ void smask(f32x16&p0,f32x16&p1,u32x2 mk,int hi){
  const int m0=(int)(mk.x>>(4*hi)), m1=(int)(mk.y>>(4*hi));
  #pragma unroll
  for(int r=0;r<16;++r){ const int cb=(r&3)+8*(r>>2);
    const unsigned n0=(unsigned)__builtin_amdgcn_sbfe(m0,cb,1), n1=(unsigned)__builtin_amdgcn_sbfe(m1,cb,1);
    p0[r]=__uint_as_float((__float_as_uint(p0[r])&n0)|(~n0&0xff800000u)); p1[r]=__uint_as_float((__float_as_uint(p1[r])&n1)|(~n1&0xff800000u)); }
}
constexpr int NSLOT=3, SLOTB=8192;
constexpr int LDS_K=0, LDS_V=NSLOT*SLOTB, LDS_WS=2*NSLOT*SLOTB, LDS_OST=LDS_WS+NW*64*4, LDS_BYTES=LDS_OST+NW*4096;
constexpr float C2=0.125f*1.4426950408889634f;
__device__ __forceinline__ void glds16(const void*gsrc,unsigned lds_dst){unsigned keep;
  asm volatile("s_mov_b32 %0, m0\n\ts_mov_b32 m0, %2\n\ts_nop 0\n\tglobal_load_lds_dwordx4 %1, off\n\ts_mov_b32 m0, %0":"=&s"(keep):"v"(gsrc),"s"(lds_dst):"memory");}
__device__ __forceinline__ float max3f(float a,float b,float c){float r;asm("v_max3_f32 %0, %1, %2, %3":"=v"(r):"v"(a),"v"(b),"v"(c));return r;}
__device__ __forceinline__ float max2f(float a,float b){float r;asm("v_max_f32_e32 %0, %1, %2":"=v"(r):"v"(a),"v"(b));return r;}
__device__ __forceinline__ float fadd_s(float a,float b){float r;asm("v_add_f32_e32 %0, %1, %2":"=v"(r):"v"(a),"v"(b));return r;}
__device__ __forceinline__ float fsub_s(float a,float b){float r;asm("v_sub_f32_e32 %0, %1, %2":"=v"(r):"v"(a),"v"(b));return r;}
typedef float f32x2_t __attribute__((ext_vector_type(2))); typedef __bf16 bf16x2_t __attribute__((ext_vector_type(2)));
__device__ __forceinline__ unsigned cvtpk_s(float lo,float hi){f32x2_t v={lo,hi};bf16x2_t b=__builtin_convertvector(v,bf16x2_t);return __builtin_bit_cast(unsigned,b);}
#define WAIT_BAR(N) asm volatile("s_waitcnt vmcnt(" #N ") lgkmcnt(0)\n\ts_barrier":::"memory")

__device__ __forceinline__ void qkt(f32x16&p0,f32x16&p1,const char*Kslot,const bf16x8*qr,const f32x16&negm,int r32,int hi){
  const char*kb=Kslot+hi*1024+r32*16;
  #pragma unroll
  for(int d0=0;d0<4;++d0){
    const bf16x8 b0=*reinterpret_cast<const bf16x8*>(kb+d0*2048);
    const bf16x8 b1=*reinterpret_cast<const bf16x8*>(kb+d0*2048+512);
    if(d0==0){p0=__builtin_amdgcn_mfma_f32_32x32x16_bf16(b0,qr[0],negm,0,0,0);p1=__builtin_amdgcn_mfma_f32_32x32x16_bf16(b1,qr[0],negm,0,0,0);}
    else{p0=__builtin_amdgcn_mfma_f32_32x32x16_bf16(b0,qr[d0],p0,0,0,0);p1=__builtin_amdgcn_mfma_f32_32x32x16_bf16(b1,qr[d0],p1,0,0,0);}}
}
typedef __attribute__((address_space(3))) const char* lds_cptr;
typedef short v4i16_t __attribute__((ext_vector_type(4)));
__device__ __forceinline__ void kload8(bf16x8*kf,lds_cptr kp){
  kf[0]=*(const __attribute__((address_space(3))) bf16x8*)(kp);      kf[1]=*(const __attribute__((address_space(3))) bf16x8*)(kp+512);
  kf[2]=*(const __attribute__((address_space(3))) bf16x8*)(kp+2048); kf[3]=*(const __attribute__((address_space(3))) bf16x8*)(kp+2560);
  kf[4]=*(const __attribute__((address_space(3))) bf16x8*)(kp+4096); kf[5]=*(const __attribute__((address_space(3))) bf16x8*)(kp+4608);
  kf[6]=*(const __attribute__((address_space(3))) bf16x8*)(kp+6144); kf[7]=*(const __attribute__((address_space(3))) bf16x8*)(kp+6656);
}
__device__ __forceinline__ void kload2(bf16x8*kf,lds_cptr kp,int j){ kf[2*j]=*(const __attribute__((address_space(3))) bf16x8*)(kp+j*2048); kf[2*j+1]=*(const __attribute__((address_space(3))) bf16x8*)(kp+j*2048+512); }
__device__ __forceinline__ s16x4 vtr(lds_cptr p){ return __builtin_bit_cast(s16x4,__builtin_amdgcn_ds_read_tr16_b64_v4i16((__attribute__((address_space(3))) v4i16_t*)p)); }
__device__ __forceinline__ float rowmax(const f32x16&p0,const f32x16&p1){
  float a=max3f(p0[0],p0[1],p1[0]),b=max3f(p0[2],p0[3],p1[1]);a=max3f(a,p1[2],p1[3]);
  #pragma unroll
  for(int r=4;r<16;r+=4){a=max3f(a,p0[r],p0[r+1]);b=max3f(b,p0[r+2],p0[r+3]);a=max3f(a,p1[r],p1[r+1]);b=max3f(b,p1[r+2],p1[r+3]);}
  const float m=max2f(a,b);
  auto rr=__builtin_amdgcn_permlane32_swap(__float_as_uint(m),__float_as_uint(m),false,false);
  return max2f(__uint_as_float(rr[0]),__uint_as_float(rr[1]));
}
__device__ __forceinline__ void pv(f32x16*o,int vb,bf16x8 pa0,bf16x8 pa1,bf16x8 pa2,bf16x8 pa3){
  #pragma unroll
  for(int d0=0;d0<2;++d0){s16x4 lo[4],hi[4];
    #pragma unroll
    for(int ks=0;ks<4;++ks){
      asm volatile("ds_read_b64_tr_b16 %0,%1 offset:%c2":"=&v"(lo[ks]):"v"(vb),"i"(d0*4096+ks*1024):"memory");
      asm volatile("ds_read_b64_tr_b16 %0,%1 offset:%c2":"=&v"(hi[ks]):"v"(vb),"i"(d0*4096+ks*1024+512):"memory");}
    asm volatile("s_waitcnt lgkmcnt(0)":::"memory");SBAR();
    #define PK(k) (bf16x8){lo[k][0],lo[k][1],lo[k][2],lo[k][3],hi[k][0],hi[k][1],hi[k][2],hi[k][3]}
    o[d0]=__builtin_amdgcn_mfma_f32_32x32x16_bf16(pa0,PK(0),o[d0],0,0,0);
    o[d0]=__builtin_amdgcn_mfma_f32_32x32x16_bf16(pa1,PK(1),o[d0],0,0,0);
    o[d0]=__builtin_amdgcn_mfma_f32_32x32x16_bf16(pa2,PK(2),o[d0],0,0,0);
    o[d0]=__builtin_amdgcn_mfma_f32_32x32x16_bf16(pa3,PK(3),o[d0],0,0,0);
    #undef PK
  }
}

#ifndef ATTN_STORE16
#define ATTN_STORE16(p,v) (*(u32x4*)(p)=(v))
#endif
template<int THRL> __device__ __forceinline__ void dsa_unit(int b,int u,const bf16*Q,const bf16*__restrict__ K,const bf16*__restrict__ V,bf16*O,const unsigned*MASKW,char*shm,const int tid){
  const int lane=tid&63,r32=lane&31,hi=lane>>5; const int wid=__builtin_amdgcn_readfirstlane(tid>>6);
  const long rowbase=(long)b*SEQ; const int q0=u*32;
  const bf16*Qw=Q+(rowbase+q0+wid*4+(r32>>3))*DMQ+(r32&7)*64;
  const bf16*Kh=K+rowbase*DM,*Vh=V+rowbase*DM;
  const unsigned*mrow=MASKW+(rowbase+q0+wid*4+(r32>>3))*64;
  const unsigned lds0=(unsigned)(uintptr_t)shm;
  float*wsf=(float*)(shm+LDS_WS)+wid*64;
  const bf16*ksrc=Kh+(long)lane*DM+wid*8;
  const bf16*vsrc=Vh+(long)(16*(wid&3)+(lane>>2))*DM+(wid>>2)*32+(lane&3)*8;
  const unsigned kdst=lds0+LDS_K+wid*1024, vdst=lds0+LDS_V+wid*1024;
  #define DMA_K(t,slot) glds16(ksrc+(long)(t)*KVBLK*DM,(unsigned)__builtin_amdgcn_readfirstlane(kdst+(slot)))
  #define DMA_V(t,slot) glds16(vsrc+(long)(t)*KVBLK*DM,(unsigned)__builtin_amdgcn_readfirstlane(vdst+(slot)))
  const int vb0=(int)(lds0+LDS_V)+((lane>>4)&1)*32+(lane&3)*8+(4*hi+((lane&15)>>2))*64;
  const char*Kbase=shm+LDS_K; bf16x8 kf[8];
  const lds_cptr shm3=(lds_cptr)shm; const lds_cptr kp0=shm3+LDS_K+hi*1024+r32*16; const lds_cptr vp0=shm3+LDS_V+((lane>>4)&1)*32+(lane&3)*8+(4*hi+((lane&15)>>2))*64;
  int NT_=(((u>>1)+1)+1)&~1; if(NT_<4)NT_=4; const int NT=NT_;
  u32x2 mraw0,mkn,mkc;
  #define MLOAD(dst,t) asm volatile("global_load_dwordx2 %0, %1, off":"=&v"(dst):"v"(mrow+2*(t)):"memory")
  #define MCOPY(dst,src) asm volatile("v_mov_b32 %0, %2\n\tv_mov_b32 %1, %3":"=&v"(dst.x),"=&v"(dst.y):"v"(src.x),"v"(src.y))
  MLOAD(mraw0,0); MLOAD(mkn,1);
  DMA_K(0,0);DMA_V(0,0);DMA_K(1,SLOTB);
  bf16x8 qr[4];
  #pragma unroll
  for(int d0=0;d0<4;++d0)qr[d0]=*reinterpret_cast<const bf16x8*>(&Qw[d0*16+hi*8]);
  float mhat=0.f,l_reg=0.f;f32x16 o[2];o[0]=f32x16{};o[1]=f32x16{};const f32x16 negm=f32x16{};
  #define CMASK(P0,P1,t) smask(P0,P1,mkc,hi)
  bool resc=false;
  #define START(P0,P1) do{ const float rm=rowmax(P0,P1); resc=false; \
    { const float dl=__any(rm>(float)THRL)?__builtin_fmaxf(rm,0.f):0.f; mhat=fadd_s(mhat,dl); \
      _Pragma("unroll") for(int r=0;r<16;++r){P0[r]=fsub_s(P0[r],dl);P1[r]=fsub_s(P1[r],dl);} \
      } \
    _Pragma("unroll") for(int r=0;r<16;++r)P0[r]=__builtin_amdgcn_exp2f(P0[r]); }while(0)
  #define RESC() do{ if(resc){ asm volatile("s_waitcnt lgkmcnt(0)":::"memory"); \
      _Pragma("unroll") for(int d_=0;d_<2;++d_) _Pragma("unroll") for(int r=0;r<16;++r)o[d_][r]*=wsf[crow(r,hi)]; } }while(0)
  f32x16 pA0,pA1,pB0,pB1;
  int sl_prev=0,sl_cur=0,sl_next=SLOTB;
  #define ROT() do{sl_prev=sl_cur;sl_cur=sl_next;sl_next=(sl_next==(NSLOT-1)*SLOTB)?0:sl_next+SLOTB;}while(0)
  DMA_K(2,2*SLOTB);
  WAIT_BAR(3);
  MCOPY(mkc,mraw0);
  qkt(pA0,pA1,Kbase,qr,negm,r32,hi);asm volatile("s_nop 15\n\ts_nop 7":"+v"(pA0),"+v"(pA1));CMASK(pA0,pA1,0);
  START(pA0,pA1);
  _Pragma("unroll") for(int r=0;r<16;++r)pA1[r]=__builtin_amdgcn_exp2f(pA1[r]);
  WAIT_BAR(0);
  DMA_K(3,0);DMA_V(1,SLOTB);
  ROT();
  kload8(kf,kp0+sl_cur);
  WAIT_BAR(2);
  s16x4 vlo[8],vhi[8]; u32x4 pw0,pw1,pw2,pw3;
  #define PKW(P,B) cvtpk_s(P[B],P[B+1])
  #define PAF(k) __builtin_bit_cast(bf16x8,pw##k)
  #define VFR(i) (bf16x8){vlo[i][0],vlo[i][1],vlo[i][2],vlo[i][3],vhi[i][0],vhi[i][1],vhi[i][2],vhi[i][3]}
  #define PIN(x) asm volatile("":"+v"(x))
  #define MX3(a,b,c) __builtin_fmaxf(__builtin_fmaxf((a),(b)),(c))
  #define GAPA(MF,A0,A1,A2,A3,W0,W1,PW) do{ MF; sacc+=A0; sacc+=A1; sacc+=A2; sacc+=A3; PIN(sacc); W0; W1; PIN(PW); SBAR(); }while(0)
  #define EX(v) __builtin_amdgcn_exp2f(v)
  #define GAPB(MF,X,B) do{ MF; X[B]=EX(X[B]); X[B+1]=EX(X[B+1]); X[B+2]=EX(X[B+2]); X[B+3]=EX(X[B+3]); PIN(X); SBAR(); }while(0)
  #define VRD(i) do{ vlo[i]=vtr(vp_+(((i)>>2)*4096+((i)&3)*1024)); vhi[i]=vtr(vp_+(((i)>>2)*4096+((i)&3)*1024+512)); }while(0)
  #define KRD(G,j) do{ if(G){ kload2(kf,kp0+sl_next,j); SBAR(); } }while(0)
  #define STEP(C0,C1,P0,P1,t,GK,GV,GL) do{ SBAR(); MCOPY(mkc,mkn); if(GV){MLOAD(mkn,(t)+1);} \
    const lds_cptr vp_=vp0+sl_prev; \
    VRD(0); SBAR(); float sacc=(P0[0]+P0[1]); \
    GAPA(C0=__builtin_amdgcn_mfma_f32_32x32x16_bf16(kf[0],qr[0],negm,0,0,0), P0[2],P0[3],P0[4],P0[5],     pw0[0]=PKW(P0,0), pw0[1]=PKW(P0,2), pw0); \
    VRD(4); SBAR(); GAPA(C1=__builtin_amdgcn_mfma_f32_32x32x16_bf16(kf[1],qr[0],negm,0,0,0), P0[6],P0[7],P0[8],P0[9],     pw0[2]=PKW(P0,4), pw0[3]=PKW(P0,6), pw0); \
    VRD(1); SBAR(); GAPA(C0=__builtin_amdgcn_mfma_f32_32x32x16_bf16(kf[2],qr[1],C0,0,0,0),   P0[10],P0[11],P0[12],P0[13], pw1[0]=PKW(P0,8), pw1[1]=PKW(P0,10), pw1); \
    VRD(5); SBAR(); GAPA(C1=__builtin_amdgcn_mfma_f32_32x32x16_bf16(kf[3],qr[1],C1,0,0,0),   P0[14],P0[15],P1[0],P1[1],   pw1[2]=PKW(P0,12),pw1[3]=PKW(P0,14), pw1); \
    VRD(2); SBAR(); GAPA(C0=__builtin_amdgcn_mfma_f32_32x32x16_bf16(kf[4],qr[2],C0,0,0,0),   P1[2],P1[3],P1[4],P1[5],     pw2[0]=PKW(P1,0), pw2[1]=PKW(P1,2), pw2); \
    VRD(6); SBAR(); GAPA(C1=__builtin_amdgcn_mfma_f32_32x32x16_bf16(kf[5],qr[2],C1,0,0,0),   P1[6],P1[7],P1[8],P1[9],     pw2[2]=PKW(P1,4), pw2[3]=PKW(P1,6), pw2); \
    VRD(3); SBAR(); GAPA(C0=__builtin_amdgcn_mfma_f32_32x32x16_bf16(kf[6],qr[3],C0,0,0,0),   P1[10],P1[11],P1[12],P1[13], pw3[0]=PKW(P1,8), pw3[1]=PKW(P1,10), pw3); \
    VRD(7); SBAR(); GAPA(C1=__builtin_amdgcn_mfma_f32_32x32x16_bf16(kf[7],qr[3],C1,0,0,0),   P1[14],P1[15],0.f,0.f,       pw3[2]=PKW(P1,12),pw3[3]=PKW(P1,14), pw3); \
    l_reg+=sacc; \
    if(GK){DMA_K((t)+3,sl_cur);} if(GV){DMA_V((t)+1,sl_next);} \
    CMASK(C0,C1,t); \
    _Pragma("unroll") for(int r=0;r<16;++r){C0[r]-=mhat;C1[r]-=mhat;} \
    { float a=MX3(C0[0],C0[1],C1[0]),b=MX3(C0[2],C0[3],C1[1]); a=MX3(a,C1[2],C1[3]); \
      _Pragma("unroll") for(int r=4;r<16;r+=4){a=MX3(a,C0[r],C0[r+1]);b=MX3(b,C0[r+2],C0[r+3]);a=MX3(a,C1[r],C1[r+1]);b=MX3(b,C1[r+2],C1[r+3]);} \
      float rm=__builtin_fmaxf(a,b); { auto rr=__builtin_amdgcn_permlane32_swap(__float_as_uint(rm),__float_as_uint(rm),false,false); rm=__builtin_fmaxf(__uint_as_float(rr[0]),__uint_as_float(rr[1])); } \
      resc=false; \
      if(__builtin_expect(__any(rm>(float)THRL),0)){ const float dl=__builtin_fmaxf(rm,0.f); mhat+=dl; \
        _Pragma("unroll") for(int r=0;r<16;++r){C0[r]-=dl;C1[r]-=dl;} \
        const float f=__builtin_amdgcn_exp2f(-dl); l_reg*=f; if(hi==0)wsf[r32]=f; resc=true; } } \
    SBAR(); \
    GAPB(o[0]=__builtin_amdgcn_mfma_f32_32x32x16_bf16(PAF(0),VFR(0),o[0],0,0,0), C0,0); \
    GAPB(o[1]=__builtin_amdgcn_mfma_f32_32x32x16_bf16(PAF(0),VFR(4),o[1],0,0,0), C0,4); \
    KRD(GL,0); GAPB(o[0]=__builtin_amdgcn_mfma_f32_32x32x16_bf16(PAF(1),VFR(1),o[0],0,0,0), C0,8); \
    KRD(GL,1); GAPB(o[1]=__builtin_amdgcn_mfma_f32_32x32x16_bf16(PAF(1),VFR(5),o[1],0,0,0), C0,12); \
    KRD(GL,2); GAPB(o[0]=__builtin_amdgcn_mfma_f32_32x32x16_bf16(PAF(2),VFR(2),o[0],0,0,0), C1,0); \
    KRD(GL,3); GAPB(o[1]=__builtin_amdgcn_mfma_f32_32x32x16_bf16(PAF(2),VFR(6),o[1],0,0,0), C1,4); \
    GAPB(o[0]=__builtin_amdgcn_mfma_f32_32x32x16_bf16(PAF(3),VFR(3),o[0],0,0,0), C1,8); \
    GAPB(o[1]=__builtin_amdgcn_mfma_f32_32x32x16_bf16(PAF(3),VFR(7),o[1],0,0,0), C1,12); \
    }while(0)
  int t=1;
  for(;t+5<NT;t+=2){
    STEP(pB0,pB1,pA0,pA1,t,true,true,true);     WAIT_BAR(2); RESC(); ROT();
    STEP(pA0,pA1,pB0,pB1,t+1,true,true,true);   WAIT_BAR(2); RESC(); ROT();
  }
  #define ENDW(tt) do{ if((tt)+3<NT){WAIT_BAR(2);} else if((tt)+2<NT){WAIT_BAR(1);} else {WAIT_BAR(0);} }while(0)
  for(;t+1<NT;t+=2){
    STEP(pB0,pB1,pA0,pA1,t,(t+3<NT),(t+1<NT),(t+1<NT));       ENDW(t);   RESC(); ROT();
    STEP(pA0,pA1,pB0,pB1,t+1,(t+4<NT),(t+2<NT),(t+2<NT));     ENDW(t+1); RESC(); ROT();
  }
  STEP(pB0,pB1,pA0,pA1,NT-1,false,false,false); RESC();
  { float sacc=pB0[0]+pB0[1]; _Pragma("unroll") for(int r=2;r<16;++r)sacc+=pB0[r]; _Pragma("unroll") for(int r=0;r<16;++r)sacc+=pB1[r]; l_reg+=sacc;
    pw0=(u32x4){PKW(pB0,0),PKW(pB0,2),PKW(pB0,4),PKW(pB0,6)};pw1=(u32x4){PKW(pB0,8),PKW(pB0,10),PKW(pB0,12),PKW(pB0,14)};pw2=(u32x4){PKW(pB1,0),PKW(pB1,2),PKW(pB1,4),PKW(pB1,6)};pw3=(u32x4){PKW(pB1,8),PKW(pB1,10),PKW(pB1,12),PKW(pB1,14)};
    SBAR(); pv(o,vb0+sl_cur,PAF(0),PAF(1),PAF(2),PAF(3)); }
  #undef PKW
  #undef PAF
  #undef VFR
  #undef PIN
  #undef MX3
  #undef GAPA
  #undef GAPB
  #undef EX
  #undef VRD
  #undef KRD
  #undef STEP
  #undef ENDW
  {auto rr=__builtin_amdgcn_permlane32_swap(__float_as_uint(l_reg),__float_as_uint(l_reg),false,false);l_reg=__uint_as_float(rr[0])+__uint_as_float(rr[1]);}
  if(hi==0)wsf[32+r32]=l_reg;asm volatile("s_waitcnt lgkmcnt(0)":::"memory");
  float rli[16];
  #pragma unroll
  for(int r=0;r<16;++r)rli[r]=__builtin_amdgcn_rcpf(wsf[32+crow(r,hi)]);
  bf16*Ow=O+(rowbase+q0+wid*4)*DMO;
  { bf16*stg=(bf16*)(shm+LDS_OST)+wid*2048;
    #pragma unroll
    for(int r=0;r<16;++r){const int orow=crow(r,hi);
      #pragma unroll
      for(int d0=0;d0<2;++d0)stg[orow*64+d0*32+r32]=__float2bfloat16(o[d0][r]*rli[r]);}
    asm volatile("s_waitcnt lgkmcnt(0)":::"memory");
    #pragma unroll
    for(int i=0;i<4;++i){const int row=i*8+(lane>>3),ch=lane&7; const u32x4 v=*(const u32x4*)(stg+row*64+ch*8); ATTN_STORE16(Ow+(long)(row>>3)*DMO+(row&7)*64+ch*8,v);} }
  asm volatile("s_waitcnt lgkmcnt(0)\n\ts_barrier":::"memory");
  #undef DMA_K
  #undef DMA_V
  #undef CMASK
  #undef MLOAD
  #undef MCOPY
  #undef START
  #undef RESC
  #undef ROT
}
constexpr int ATTN_LDS_BYTES=LDS_BYTES;
template<int THRL=8> __device__ __forceinline__ void dsa_attn_phase(char*lds,const bf16*Pq,const bf16*KD,const bf16*VD,bf16*MIXp,const unsigned*MASKW,int vcu,int ncu,int tid){
  for(int v=vcu;v<16*16;v+=ncu){
    const int b=v>>4, s=v&15;
    #pragma unroll 1
    for(int i=0;i<4;++i){ const int u=(i==0)?s:(i==1)?63-s:(i==2)?31-s:32+s;
      dsa_unit<THRL>(b,u,Pq,KD,VD,MIXp,MASKW,lds,tid); }
  }
}
#undef SBAR
#undef WAIT_BAR
}

constexpr int NWAVES = 8, NTHR = 512;
constexpr int BATCH = 16, SEQ = 2048, D = 1024, M = BATCH * SEQ;
constexpr int EIN = 2776, EINP = 2816, FF = 2816, NEXP = 8;
constexpr int PC_AQ = 0, PC_CKV = 512, PC_QI = 640, PC_KI = 1152, PC_WI = 1216, PC_BQ = 1224, PC_BK = 1480, PC_BV = 1736, PC_BG = 2248, PC_BR = 2264;
constexpr float ALPHA = 1.6817928305074290f;
constexpr float LN_EPS = 1e-5f, RMS_EPS = 1e-6f;
constexpr float C2 = 0.125f * 1.4426950408889634f;
constexpr int MOE_ROWS = 2 * M + NEXP * 256;
constexpr int TOPK = 256;

constexpr size_t MiB = 1u << 20;
constexpr size_t WS_CTL = 0, CTL_ZERO_BYTES = 256 * 1024;
constexpr size_t WS_XSTAT = 1u << 20;
constexpr int CW_PANEL = 16384;
constexpr size_t WS_WB = 2 * MiB;
constexpr size_t WB_WIN = 0, WB_WOUT = 6 * MiB, WB_WGU = 8 * MiB, WB_WDN = 20 * MiB;
constexpr size_t WB_WQKV = 0, WB_MGU = 8 * MiB, WB_MDN = 96 * MiB;
constexpr size_t WS_XB = 146 * MiB;
constexpr size_t WS_P = 210 * MiB, WS_HID = 210 * MiB, WS_MIX = 386 * MiB;
constexpr size_t WS_KD = 450 * MiB, WS_VD = 454 * MiB, WS_KI = 458 * MiB, WS_MASK = 462 * MiB;
constexpr size_t WS_GST = 470 * MiB, WS_H_EVEN = 470 * MiB, WS_GSB = 584 * MiB;
constexpr size_t WS_QT = 534 * MiB, WS_KT = 550 * MiB, WS_EBL = 582 * MiB, WS_SC = 584 * MiB;
constexpr size_t WS_QKV = 210 * MiB, WS_AO = 402 * MiB, WS_MIXO = 530 * MiB, WS_H_ODD = 594 * MiB;
constexpr size_t WS_XPERM = 210 * MiB, WS_HIDP = 342 * MiB;
constexpr size_t WS_ROUTE = 722 * MiB, WS_INV = 723 * MiB, WS_CNTT = 723 * MiB + 512 * 1024  , WS_END = 724 * MiB;
constexpr int CW_TMO = 0, CW_CNT = 64  , CW_BAR = 4096;

constexpr int RING_BYTES = 131072, LDSCTL_OFF = RING_BYTES, MISC_OFF = LDSCTL_OFF + 320, LDS_BYTES = 147456;
constexpr int XTRA_OFF = MISC_OFF + 128;

__device__ __forceinline__ float bf2f(unsigned short u) { return __uint_as_float((unsigned)u << 16); }
__device__ __forceinline__ float bflo(unsigned w) { return __uint_as_float(w << 16); }
__device__ __forceinline__ float bfhi(unsigned w) { return __uint_as_float(w & 0xffff0000u); }
__device__ __forceinline__ float wave_sum_fd(float v);
__device__ __forceinline__ float wave_sum(float v) { return wave_sum_fd(v); }
__device__ __forceinline__ float wave_sum_l(float v, int lane) {
#pragma unroll
    for (int o = 1; o < 64; o <<= 1) v += __int_as_float(__builtin_amdgcn_ds_bpermute((lane ^ o) << 2, __float_as_int(v)));
    return v;
}
__device__ __forceinline__ int hw_lane() { int ln; asm volatile("v_mbcnt_lo_u32_b32 %0, -1, 0\n\tv_mbcnt_hi_u32_b32 %0, -1, %0" : "=v"(ln)); return ln & 63; }
__device__ __forceinline__ float wave_sum_fd(float v) {
    v += __int_as_float(__builtin_amdgcn_mov_dpp(__float_as_int(v), 0xB1, 0xF, 0xF, true));
    v += __int_as_float(__builtin_amdgcn_mov_dpp(__float_as_int(v), 0x4E, 0xF, 0xF, true));
    v += __int_as_float(__builtin_amdgcn_mov_dpp(__float_as_int(v), 0x141, 0xF, 0xF, true));
    v += __int_as_float(__builtin_amdgcn_mov_dpp(__float_as_int(v), 0x140, 0xF, 0xF, true));
    const int b = __float_as_int(v);
    return (__int_as_float(__builtin_amdgcn_readlane(b, 0)) + __int_as_float(__builtin_amdgcn_readlane(b, 16))) + (__int_as_float(__builtin_amdgcn_readlane(b, 32)) + __int_as_float(__builtin_amdgcn_readlane(b, 48)));
}
__device__ __forceinline__ float wave_max(float v) {
#pragma unroll
    for (int o = 1; o < 64; o <<= 1) v = fmaxf(v, __shfl_xor(v, o));
    return v;
}
__device__ __forceinline__ int wave_sum_i(int v) {
#pragma unroll
    for (int o = 1; o < 64; o <<= 1) v += __shfl_xor(v, o);
    return v;
}
__device__ __forceinline__ int wave_incl_scan_i(int v, int lane) {
#pragma unroll
    for (int o = 1; o < 64; o <<= 1) { const int t = __shfl_up(v, o); if (lane >= o) v += t; }
    return v;
}
__device__ __forceinline__ void ld8bf(const bf16* p, float* f) {
    const v4u w = *(const v4u*)p;
    f[0] = bflo(w.x); f[1] = bfhi(w.x); f[2] = bflo(w.y); f[3] = bfhi(w.y); f[4] = bflo(w.z); f[5] = bfhi(w.z); f[6] = bflo(w.w); f[7] = bfhi(w.w);
}
__device__ __forceinline__ float silu_f(float x) { return x * __builtin_amdgcn_rcpf(1.0f + __builtin_amdgcn_exp2f(-1.4426950408889634f * x)); }

struct Frame {
    LAS unsigned char* lds;
    volatile LAS unsigned* MISC;
    gu32* ctl;
    int tid, lane, wave, G, gw, NGW, bx, wave0;
    unsigned char* ws;
    const __attribute__((address_space(4))) unsigned char* kp;
    __device__ __forceinline__ const float* inp(int i) const { typedef const float* cfp; return *(const __attribute__((address_space(4))) cfp*)(kp + 8 * i); }
    __device__ __forceinline__ float* outp() const { typedef float* fp; return *(const __attribute__((address_space(4))) fp*)(kp + 272); }
};

namespace pg8 {
struct EpiSwiGLU {
    static constexpr bool PERM = true, AFTER_DRAIN = false;
    bf16_t* O; int ldc;
    __device__ __forceinline__ void operator()(const f32x4 (&acc)[2][2][4][2], const Unit& u, int wr, int wc, int fr, int fq) const {
        const int row0 = u.pm * BM + wr * 64 + fr, col0 = u.pn * HALF + wc * 32 + 8 * fq;
#pragma unroll
        for (int ai = 0; ai < 2; ++ai)
#pragma unroll
            for (int m = 0; m < 4; ++m) {
                bf16_t* rowp = O + (size_t)(row0 + ai * HALF + m * 16) * ldc + col0;
                const f32x4 g0 = acc[ai][0][m][0], g1 = acc[ai][0][m][1], u0 = acc[ai][1][m][0], u1 = acc[ai][1][m][1];
                u32x4 w;
                w.x = cvt_pk_bf16(silu_f(g0[0]) * u0[0], silu_f(g0[1]) * u0[1]); w.y = cvt_pk_bf16(silu_f(g0[2]) * u0[2], silu_f(g0[3]) * u0[3]);
                w.z = cvt_pk_bf16(silu_f(g1[0]) * u1[0], silu_f(g1[1]) * u1[1]); w.w = cvt_pk_bf16(silu_f(g1[2]) * u1[2], silu_f(g1[3]) * u1[3]);
                *(u32x4*)rowp = w;
            }
    }
};
struct MoeOrder {
    StaticOrder so; int tb[NEXP + 1]; int nN;
    __device__ __forceinline__ void init(const unsigned* cnt, int nN_, int G, int c) {
        tb[0] = 0;
#pragma unroll
        for (int e = 0; e < NEXP; ++e) tb[e + 1] = tb[e] + (int)((__builtin_amdgcn_readfirstlane(cnt[e]) + 255u) >> 8);
        nN = nN_; so.nM = tb[NEXP]; so.nN = nN_; so.nwg = so.nM * nN_; so.G = G; so.c = c; so.lim = so.nwg;
    }
    __device__ __forceinline__ void cut_tail() { const int tail = so.nwg % so.G; if (tail * 16 <= 2 * so.G) so.lim = so.nwg - tail; }
    __device__ __forceinline__ bool next(int i, Unit& u) const {
        if (!so.next(i, u)) return false;
        int e = 0;
#pragma unroll
        for (int k = 1; k < NEXP; ++k) e += (u.pm >= tb[k]) ? 1 : 0;
        u.pb = e * nN + u.pn; return true;
    }
    __device__ __forceinline__ bool at(long L, Unit& u) const {
        if (!so.at(L, u)) return false;
        int e = 0;
#pragma unroll
        for (int k = 1; k < NEXP; ++k) e += (u.pm >= tb[k]) ? 1 : 0;
        u.pb = e * nN + u.pn; return true;
    }
    __device__ __forceinline__ void a_ready(const Unit&) const {}
    __device__ __forceinline__ void done(const Unit&) const {}
};
struct PanelOrder {
    int nM, c;
    __device__ __forceinline__ void init(int M, int c_) { nM = M / BM; c = c_; }
    __device__ __forceinline__ bool next(int i, Unit& u) const { const int j = c >> 3, pm = i * 64 + (c & 7) * 8 + (j >> 2); if (pm >= nM) return false; u.pm = pm; u.pn = j & 3; u.pb = u.pn; return true; }
    __device__ __forceinline__ void a_ready(const Unit&) const {}
    __device__ __forceinline__ void done(const Unit&) const {}
};
struct EpiLnFused {
    static constexpr bool PERM = true, AFTER_DRAIN = false;
    bf16_t* X; const float* g; const float* b; unsigned long long* xbuf; unsigned* cnt; unsigned* tmo; PG8_LAS unsigned char* tl;
    __device__ __forceinline__ void operator()(f32x4 (&acc)[2][2][4][2], const Unit& u, int wr, int wc, int fr, int fq) const {
        typedef float f32x2v __attribute__((ext_vector_type(2)));
        const int wid = wr * 4 + wc, lane = fq * 16 + fr;
        PG8_LAS f32x2v* P = (PG8_LAS f32x2v*)tl;
        PG8_LAS f32x2v* S = (PG8_LAS f32x2v*)(tl + 8192);
        bf16_t* xb0 = X + (size_t)(u.pm * BM + wr * 64 + fr) * 1024 + u.pn * BM + wc * 32 + 8 * fq;
        {
            u32x4 xw[2][4][2];
#pragma unroll
            for (int ai = 0; ai < 2; ++ai)
#pragma unroll
                for (int m = 0; m < 4; ++m)
#pragma unroll
                    for (int bj = 0; bj < 2; ++bj) xw[ai][m][bj] = *(const u32x4*)(xb0 + (size_t)(ai * HALF + m * 16) * 1024 + bj * HALF);
#pragma unroll
            for (int ai = 0; ai < 2; ++ai)
#pragma unroll
                for (int m = 0; m < 4; ++m)
#pragma unroll
                    for (int bj = 0; bj < 2; ++bj) { const u32x4 w = xw[ai][m][bj];
                        acc[ai][bj][m][0] += (f32x4){bflo(w.x), bfhi(w.x), bflo(w.y), bfhi(w.y)} * ALPHA; acc[ai][bj][m][1] += (f32x4){bflo(w.z), bfhi(w.z), bflo(w.w), bfhi(w.w)} * ALPHA; }
            asm volatile("" ::: "memory");
        }
#pragma unroll
        for (int ai = 0; ai < 2; ++ai)
#pragma unroll
            for (int m = 0; m < 4; ++m) {
                float s = 0.f;
#pragma unroll
                for (int bj = 0; bj < 2; ++bj)
#pragma unroll
                    for (int n = 0; n < 2; ++n) { const f32x4 x = acc[ai][bj][m][n]; s += (x[0] + x[1]) + (x[2] + x[3]); }
                s += __int_as_float(__builtin_amdgcn_ds_bpermute((lane ^ 16) << 2, __float_as_int(s))); s += __int_as_float(__builtin_amdgcn_ds_bpermute((lane ^ 32) << 2, __float_as_int(s)));
                const float mw = s * (1.0f / 64.0f); float q = 0.f;
#pragma unroll
                for (int bj = 0; bj < 2; ++bj)
#pragma unroll
                    for (int n = 0; n < 2; ++n) { const f32x4 d = acc[ai][bj][m][n] - mw; q += (d[0] * d[0] + d[1] * d[1]) + (d[2] * d[2] + d[3] * d[3]); }
                q += __int_as_float(__builtin_amdgcn_ds_bpermute((lane ^ 16) << 2, __float_as_int(q))); q += __int_as_float(__builtin_amdgcn_ds_bpermute((lane ^ 32) << 2, __float_as_int(q)));
                if (fq == 0) P[(ai * HALF + wr * 64 + m * 16 + fr) * 4 + wc] = (f32x2v){mw, q};
            }
        asm volatile("s_waitcnt lgkmcnt(0)" ::: "memory"); __builtin_amdgcn_s_barrier(); asm volatile("" ::: "memory");
        const int row = wid * 32 + (lane & 31);
        if (lane < 32) {
            const f32x2v a = P[row * 4 + 0], b2 = P[row * 4 + 1], c2 = P[row * 4 + 2], d = P[row * 4 + 3];
            const float mt = (a.x + b2.x + c2.x + d.x) * 0.25f;
            const float da = a.x - mt, db = b2.x - mt, dc = c2.x - mt, dd = d.x - mt;
            const float m2 = (a.y + b2.y) + (c2.y + d.y) + 64.0f * ((da * da + db * db) + (dc * dc + dd * dd));
            unsigned long long* slot = xbuf + ((size_t)(u.pm * BM + row) * 4 + u.pn);
            __hip_atomic_store(slot, ((unsigned long long)__float_as_uint(m2) << 32) | __float_as_uint(mt), __ATOMIC_RELAXED, __HIP_MEMORY_SCOPE_AGENT);
        }
        asm volatile("s_waitcnt vmcnt(0)" ::: "memory");
        if (lane == 0) __hip_atomic_fetch_add(cnt + 64 * u.pm, 1u, __ATOMIC_RELAXED, __HIP_MEMORY_SCOPE_AGENT);
        if (wid == 0) {
            unsigned sp = 0u;
            while ((unsigned)__builtin_amdgcn_readfirstlane(__hip_atomic_load(cnt + 64 * u.pm, __ATOMIC_RELAXED, __HIP_MEMORY_SCOPE_AGENT)) < 32u) {
                __builtin_amdgcn_s_sleep(2);
                if (++sp > (1u << 17)) { if (lane == 0) __hip_atomic_store(tmo, 1u, __ATOMIC_RELAXED, __HIP_MEMORY_SCOPE_AGENT); break; }
            }
            __builtin_amdgcn_fence(__ATOMIC_ACQUIRE, "agent");
        }
        asm volatile("s_waitcnt vmcnt(0) lgkmcnt(0)" ::: "memory"); __builtin_amdgcn_s_barrier(); asm volatile("" ::: "memory");
        if (lane < 32) {
            const unsigned long long* slot = xbuf + (size_t)(u.pm * BM + row) * 4; float mt[4], m2[4]; float ms = 0.f;
#pragma unroll
            for (int t = 0; t < 4; ++t) { const unsigned long long w = __hip_atomic_load(slot + t, __ATOMIC_RELAXED, __HIP_MEMORY_SCOPE_AGENT); mt[t] = __uint_as_float((unsigned)w); m2[t] = __uint_as_float((unsigned)(w >> 32)); ms += mt[t]; }
            const float mean = ms * 0.25f; float q = 0.f;
#pragma unroll
            for (int t = 0; t < 4; ++t) { const float dm = mt[t] - mean; q += m2[t] + 256.0f * dm * dm; }
            S[row] = (f32x2v){mean, 1.0f / sqrtf(q * (1.0f / 1024.0f) + LN_EPS)};
        }
        asm volatile("s_waitcnt lgkmcnt(0)" ::: "memory"); __builtin_amdgcn_s_barrier(); asm volatile("" ::: "memory");
        const int colg = u.pn * BM + wc * 32 + 8 * fq;
        f32x4 gv[2][2], bv[2][2];
#pragma unroll
        for (int bj = 0; bj < 2; ++bj)
#pragma unroll
            for (int n = 0; n < 2; ++n) { gv[bj][n] = *(const f32x4*)(g + colg + bj * HALF + 4 * n); bv[bj][n] = *(const f32x4*)(b + colg + bj * HALF + 4 * n); }
#pragma unroll
        for (int ai = 0; ai < 2; ++ai)
#pragma unroll
            for (int m = 0; m < 4; ++m) { const f32x2v sr = S[ai * HALF + wr * 64 + m * 16 + fr];
#pragma unroll
                for (int bj = 0; bj < 2; ++bj) {
                    const f32x4 v0 = (acc[ai][bj][m][0] - sr.x) * sr.y * gv[bj][0] + bv[bj][0], v1 = (acc[ai][bj][m][1] - sr.x) * sr.y * gv[bj][1] + bv[bj][1];
                    u32x4 w; w.x = cvt_pk_bf16(v0[0], v0[1]); w.y = cvt_pk_bf16(v0[2], v0[3]); w.z = cvt_pk_bf16(v1[0], v1[1]); w.w = cvt_pk_bf16(v1[2], v1[3]);
                    *(u32x4*)(xb0 + (size_t)(ai * HALF + m * 16) * 1024 + bj * HALF) = w; } }
    }
};
}

__device__ __forceinline__ void cvt_item(const float* W, int K, int N, bf16* WT, int mode, int rowbase, int item, int nblk, int lane) {
    const int kb = item / nblk, nb = item - kb * nblk, k0 = 32 * kb, n = 64 * nb + lane;
    const bool ok = n < N;
    const float* src = W + (size_t)k0 * N + (ok ? n : 0);
    float v[32];
#pragma unroll
    for (int i = 0; i < 32; ++i) v[i] = __builtin_nontemporal_load(src + (size_t)i * N);
    const int row = (mode == 0) ? n : ((n >> 7) * 256 + (n & 127) + (mode == 2 ? 128 : 0));
    bf16* dst = WT + (size_t)(rowbase + row) * K + k0;
#pragma unroll
    for (int g = 0; g < 4; ++g) { v4u o;
        o.x = ok ? pk2(v[8 * g], v[8 * g + 1]) : 0u; o.y = ok ? pk2(v[8 * g + 2], v[8 * g + 3]) : 0u; o.z = ok ? pk2(v[8 * g + 4], v[8 * g + 5]) : 0u; o.w = ok ? pk2(v[8 * g + 6], v[8 * g + 7]) : 0u;
        *(GAS v4u*)(dst + 8 * g) = o; }
}
__device__ __forceinline__ void cvt_even(Frame& F, int j) {
    bf16* wb = (bf16*)(F.ws + WS_WB);
    const float* w_in = F.inp(1) + (size_t)j * D * EIN; const float* w_out = F.inp(10) + (size_t)j * D * D;
    const float* w_g = F.inp(13) + (size_t)j * D * FF; const float* w_u = F.inp(14) + (size_t)j * D * FF; const float* w_d = F.inp(15) + (size_t)j * FF * D;
    constexpr int I_IN = 32 * 44, I_OUT = 32 * 16, I_G = 32 * 44, I_D = 88 * 16, TOT = I_IN + I_OUT + 2 * I_G + I_D;
    for (int it = F.gw; it < TOT; it += F.NGW) {
        int r = it;
        if (r < I_IN) { cvt_item(w_in, D, EIN, wb + WB_WIN / 2, 0, 0, r, 44, F.lane); continue; } r -= I_IN;
        if (r < I_OUT) { cvt_item(w_out, D, D, wb + WB_WOUT / 2, 0, 0, r, 16, F.lane); continue; } r -= I_OUT;
        if (r < I_G) { cvt_item(w_g, D, FF, wb + WB_WGU / 2, 1, 0, r, 44, F.lane); continue; } r -= I_G;
        if (r < I_G) { cvt_item(w_u, D, FF, wb + WB_WGU / 2, 2, 0, r, 44, F.lane); continue; } r -= I_G;
        cvt_item(w_d, FF, D, wb + WB_WDN / 2, 0, 0, r, 16, F.lane);
    }
}
__device__ __forceinline__ void cvt_odd(Frame& F, int j) {
    bf16* wb = (bf16*)(F.ws + WS_WB);
    const float* w_qkv = F.inp(18) + (size_t)j * D * 3072; const float* w_out = F.inp(24) + (size_t)j * D * D;
    const float* w_g = F.inp(29) + (size_t)j * NEXP * D * FF; const float* w_u = F.inp(30) + (size_t)j * NEXP * D * FF; const float* w_d = F.inp(31) + (size_t)j * NEXP * FF * D;
    constexpr int I_QKV = 32 * 48, I_OUT = 32 * 16, I_E = 1408, TOT = I_QKV + I_OUT + 24 * I_E;
    for (int it = F.gw; it < TOT; it += F.NGW) {
        int r = it;
        if (r < I_QKV) { cvt_item(w_qkv, D, 3072, wb + WB_WQKV / 2, 0, 0, r, 48, F.lane); continue; } r -= I_QKV;
        if (r < I_OUT) { cvt_item(w_out, D, D, wb + WB_WOUT / 2, 0, 0, r, 16, F.lane); continue; } r -= I_OUT;
        const int mat = r / I_E, item = r - mat * I_E, kind = mat >> 3, e = mat & 7;
        if (kind == 0) cvt_item(w_g + (size_t)e * D * FF, D, FF, wb + WB_MGU / 2, 1, e * 5632, item, 44, F.lane);
        else if (kind == 1) cvt_item(w_u + (size_t)e * D * FF, D, FF, wb + WB_MGU / 2, 2, e * 5632, item, 44, F.lane);
        else cvt_item(w_d + (size_t)e * FF * D, FF, D, wb + WB_MDN / 2, 0, e * 1024, item, 16, F.lane);
    }
}
__device__ __forceinline__ void xb_from_x(Frame& F) {
    const float* x = F.inp(0); bf16* xb = (bf16*)(F.ws + WS_XB);
    for (int m = F.gw; m < M; m += F.NGW) {
        const GAS f32x4* xr = (const GAS f32x4*)(x + (size_t)m * D) + F.lane;
        GAS unsigned long long* o8 = (GAS unsigned long long*)(xb + (size_t)m * D) + F.lane;
#pragma unroll
        for (int j = 0; j < 4; ++j) { const f32x4 v = xr[64 * j]; o8[64 * j] = (unsigned long long)pk2(v.x, v.y) | ((unsigned long long)pk2(v.z, v.w) << 32); }
    }
}

template <int MODE, bool XBF>
__device__ __forceinline__ void ln_load(f32x4 (&v)[4], int m, int lane, const float* xin, const bf16* xb, const bf16* Hb, const int* r_p, const float* r_g) {
    f32x4 xv4[4];
    if (XBF) { const GAS unsigned long long* xr8 = (const GAS unsigned long long*)(xb + (size_t)m * D) + lane;
#pragma unroll
        for (int j = 0; j < 4; ++j) { const unsigned long long xw = xr8[64 * j]; const unsigned lo = (unsigned)xw, hi = (unsigned)(xw >> 32); xv4[j] = (f32x4){bflo(lo), bfhi(lo), bflo(hi), bfhi(hi)}; } }
    else { const GAS f32x4* xr = (const GAS f32x4*)(xin + (size_t)m * D) + lane;
#pragma unroll
        for (int j = 0; j < 4; ++j) xv4[j] = xr[64 * j]; }
    if (MODE == 0) {
        const GAS unsigned long long* hr = (const GAS unsigned long long*)(Hb + (size_t)m * D) + lane;
#pragma unroll
        for (int j = 0; j < 4; ++j) { const f32x4 xv = xv4[j]; const unsigned long long hw = hr[64 * j]; const unsigned lo = (unsigned)hw, hi = (unsigned)(hw >> 32);
            v[j].x = ALPHA * xv.x + bflo(lo); v[j].y = ALPHA * xv.y + bfhi(lo); v[j].z = ALPHA * xv.z + bflo(hi); v[j].w = ALPHA * xv.w + bfhi(hi); }
    } else {
        const int p0 = r_p[2 * m], p1 = r_p[2 * m + 1]; const float g0 = r_g[2 * m], g1 = r_g[2 * m + 1];
        const GAS unsigned long long* h0 = (const GAS unsigned long long*)(Hb + (size_t)p0 * D) + lane;
        const GAS unsigned long long* h1 = (const GAS unsigned long long*)(Hb + (size_t)p1 * D) + lane;
#pragma unroll
        for (int j = 0; j < 4; ++j) { const f32x4 xv = xv4[j]; const unsigned long long a = h0[64 * j], c = h1[64 * j];
            const unsigned al = (unsigned)a, ah = (unsigned)(a >> 32), cl = (unsigned)c, ch = (unsigned)(c >> 32);
            v[j].x = ALPHA * xv.x + (g0 * bflo(al) + g1 * bflo(cl)); v[j].y = ALPHA * xv.y + (g0 * bfhi(al) + g1 * bfhi(cl));
            v[j].z = ALPHA * xv.z + (g0 * bflo(ah) + g1 * bflo(ch)); v[j].w = ALPHA * xv.w + (g0 * bfhi(ah) + g1 * bfhi(ch)); }
    }
}
template <int MODE, bool ROUTER, bool XBF  , bool WRITE_F32>
__device__ __forceinline__ void ln_phase(Frame& F, const float* xin, const bf16* Hb, const float* g, const float* b, float* xout, bf16* xb,
                                         const float* rw, const float* rb, int lslot) {
    int* r_e = (int*)(F.ws + WS_ROUTE); float* r_g = (float*)(F.ws + WS_ROUTE + 256 * 1024); int* r_i = (int*)(F.ws + WS_ROUTE + 512 * 1024); int* r_p = (int*)(F.ws + WS_ROUTE + 768 * 1024);
    LAS float* wr = (LAS float*)F.lds;
    LAS int* lcnt = (LAS int*)(F.lds + 32768);
    LAS int* lrk = (LAS int*)(F.lds + 32768 + 64);
    LAS int* lex = (LAS int*)(F.lds + 32768 + 64 + 4096);
    LAS int* wbase = (LAS int*)(F.lds + 32768 + 32);
    const int r0 = (int)((long)F.bx * M / F.G), r1 = (int)((long)(F.bx + 1) * M / F.G);
    if (ROUTER) {
        for (int i = F.tid; i < D * NEXP; i += NTHR) wr[i] = rw[i];
        if (F.tid < 8) lcnt[F.tid] = 0;
        __syncthreads();
    }
    f32x4 gg[4], bb[4];
#pragma unroll
    for (int j = 0; j < 4; ++j) { gg[j] = *((const GAS f32x4*)g + F.lane + 64 * j); bb[j] = *((const GAS f32x4*)b + F.lane + 64 * j); }
    f32x4 v[4], vn[4];
    int m = r0 + F.wave;
    if (m < r1) ln_load<MODE, XBF>(v, m, F.lane, xin, xb, Hb, r_p, r_g);
    for (; m < r1; m += NWAVES) {
        const bool more = m + NWAVES < r1;
        if (more) ln_load<MODE, XBF>(vn, m + NWAVES, F.lane, xin, xb, Hb, r_p, r_g);
        float s = 0.f;
#pragma unroll
        for (int j = 0; j < 4; ++j) s += (v[j].x + v[j].y) + (v[j].z + v[j].w);
        const float mean = wave_sum_fd(s) * (1.f / D); float s2 = 0.f;
#pragma unroll
        for (int j = 0; j < 4; ++j) { v[j] = v[j] - mean; s2 += (v[j].x * v[j].x + v[j].y * v[j].y) + (v[j].z * v[j].z + v[j].w * v[j].w); }
        const float rstd = 1.f / sqrtf(wave_sum_fd(s2) * (1.f / D) + LN_EPS);
        GAS f32x4* xo = (GAS f32x4*)(xout + (size_t)m * D) + F.lane;
        GAS unsigned long long* o8 = (GAS unsigned long long*)(xb + (size_t)m * D) + F.lane;
#pragma unroll
        for (int j = 0; j < 4; ++j) {
            v[j] = v[j] * rstd * gg[j] + bb[j]; if (WRITE_F32) xo[64 * j] = v[j];
            else o8[64 * j] = (unsigned long long)pk2(v[j].x, v[j].y) | ((unsigned long long)pk2(v[j].z, v[j].w) << 32);
        }
        if (ROUTER) {
            float pl[NEXP];
#pragma unroll
            for (int e = 0; e < NEXP; ++e) pl[e] = 0.f;
#pragma unroll
            for (int j = 0; j < 4; ++j)
#pragma unroll
                for (int c = 0; c < 4; ++c) { const float xv = v[j][c]; const LAS f32x4* w4 = (const LAS f32x4*)(wr + (size_t)(4 * F.lane + 256 * j + c) * NEXP); const f32x4 wa = w4[0], wb = w4[1];
                    pl[0] += xv * wa.x; pl[1] += xv * wa.y; pl[2] += xv * wa.z; pl[3] += xv * wa.w; pl[4] += xv * wb.x; pl[5] += xv * wb.y; pl[6] += xv * wb.z; pl[7] += xv * wb.w; }
            float best0 = -INFINITY, best1 = -INFINITY; int e0 = 0, e1 = 0;
#pragma unroll
            for (int e = 0; e < NEXP; ++e) { const float l = wave_sum_fd(pl[e]) + rb[e];
                if (l > best0) { best1 = best0; e1 = e0; best0 = l; e0 = e; } else if (l > best1) { best1 = l; e1 = e; } }
            const float ex = __expf(best1 - best0), g0 = 1.f / (1.f + ex), g1 = ex / (1.f + ex);
            if (F.lane == 0) {
                lex[2 * (m - r0)] = e0; lex[2 * (m - r0) + 1] = e1;
                r_g[2 * m] = g0; r_g[2 * m + 1] = g1;
            }
        }
        if (more) {
#pragma unroll
            for (int j = 0; j < 4; ++j) v[j] = vn[j];
        }
    }
    if (ROUTER) {
        __syncthreads();
        const int nent = 2 * (r1 - r0);
        const int e = (F.tid < nent) ? lex[F.tid] : -1; int inr = 0;
#pragma unroll
        for (int k = 0; k < NEXP; ++k) {
            const unsigned long long mk = __ballot(e == k);
            const int below = (int)__builtin_amdgcn_mbcnt_hi((unsigned)(mk >> 32), __builtin_amdgcn_mbcnt_lo((unsigned)mk, 0u));
            inr = (e == k) ? below : inr;
            if (F.lane == 0) lrk[F.wave * NEXP + k] = (int)__builtin_popcountll(mk);
        }
        __syncthreads();
        if (F.tid < nent) { int base = 0;
#pragma unroll
            for (int w = 0; w < NWAVES; ++w) base += (w < F.wave) ? lrk[w * NEXP + e] : 0;
            r_e[2 * r0 + F.tid] = e; r_i[2 * r0 + F.tid] = base + inr; }
        if (F.tid < NEXP) { int t = 0;
#pragma unroll
            for (int w = 0; w < NWAVES; ++w) t += lrk[w * NEXP + F.tid];
            ((int*)(F.ws + WS_CNTT))[F.bx * NEXP + F.tid] = t; }
        __syncthreads();
    }
    (void)lcnt; (void)wbase; (void)lslot;
}

__device__ __forceinline__ void moe_map(Frame& F, int lslot) {
    const int* r_e = (const int*)(F.ws + WS_ROUTE); const int* r_i = (const int*)(F.ws + WS_ROUTE + 512 * 1024); int* r_p = (int*)(F.ws + WS_ROUTE + 768 * 1024);
    int* inv = (int*)(F.ws + WS_INV);
    LAS int* tab = (LAS int*)F.lds; LAS int* pre = (LAS int*)(F.lds + 8192); LAS int* tot = (LAS int*)(F.lds + 16384);
    { const int* cntt = (const int*)(F.ws + WS_CNTT); for (int i = F.tid; i < F.G * NEXP; i += NTHR) tab[i] = cntt[i]; }
    __syncthreads();
    { const int e = F.wave, l4 = 4 * F.lane;
        const int c0 = tab[(l4 + 0) * NEXP + e], c1 = tab[(l4 + 1) * NEXP + e], c2 = tab[(l4 + 2) * NEXP + e], c3 = tab[(l4 + 3) * NEXP + e];
        const int sm = (c0 + c1) + (c2 + c3), inc = wave_incl_scan_i(sm, F.lane), ex = inc - sm;
        pre[(l4 + 0) * NEXP + e] = ex; pre[(l4 + 1) * NEXP + e] = ex + c0; pre[(l4 + 2) * NEXP + e] = ex + c0 + c1; pre[(l4 + 3) * NEXP + e] = ex + c0 + c1 + c2;
        if (F.lane == 63) tot[e] = inc; }
    __syncthreads();
    int sb[NEXP + 1]; unsigned cn[NEXP]; { int a = 0;
#pragma unroll
        for (int e = 0; e < NEXP; ++e) { cn[e] = (unsigned)tot[e]; sb[e] = a; a += (int)((cn[e] + 255u) & ~255u); } sb[NEXP] = a; }
    if (F.bx == 0 && F.tid < NEXP) F.ctl[CW_CNT + 16 * lslot + F.tid] = (unsigned)tot[F.tid];
    const int gt = F.bx * NTHR + F.tid, NG = F.G * NTHR;
    for (int ent = gt; ent < 2 * M; ent += NG) {
        const int e = r_e[ent], idx = r_i[ent] + pre[(ent >> 8) * NEXP + e]; int base = 0;
#pragma unroll
        for (int k = 0; k < NEXP; ++k) base = (e == k) ? sb[k] : base;
        const int pos = base + idx; r_p[ent] = pos; inv[pos] = ent >> 1;
    }
    for (int p = gt; p < NEXP * 256; p += NG) { const int e = p >> 8, k = p & 255; int b0 = 0, b1 = 0; unsigned c = 0;
#pragma unroll
        for (int q = 0; q < NEXP; ++q) { if (e == q) { b0 = sb[q]; b1 = sb[q + 1]; c = cn[q]; } }
        const int pos = b0 + (int)c + k; if (pos < b1) inv[pos] = 0; }
    __syncthreads();
}

typedef float f32x4_t __attribute__((ext_vector_type(4)));
typedef short bf16x8_t __attribute__((ext_vector_type(8)));
typedef unsigned u32x4_t __attribute__((ext_vector_type(4)));
typedef float f32x16_t __attribute__((ext_vector_type(16)));
typedef unsigned u32x2_t __attribute__((ext_vector_type(2)));
constexpr int GLA_RT = 72;
__device__ __forceinline__ void gla_put_vt(LAS bf16* sVt, int tid, v4u w0, v4u w1) {
    const int t = tid & 63, ec = tid >> 6;
#pragma unroll
    for (int it = 0; it < 2; ++it) { const v4u w = it ? w1 : w0; LAS bf16* d = sVt + 8 * (ec + 8 * it) * GLA_RT + t;
        d[0 * GLA_RT] = (bf16)(w.x & 0xffffu); d[1 * GLA_RT] = (bf16)(w.x >> 16); d[2 * GLA_RT] = (bf16)(w.y & 0xffffu); d[3 * GLA_RT] = (bf16)(w.y >> 16);
        d[4 * GLA_RT] = (bf16)(w.z & 0xffffu); d[5 * GLA_RT] = (bf16)(w.z >> 16); d[6 * GLA_RT] = (bf16)(w.w & 0xffffu); d[7 * GLA_RT] = (bf16)(w.w >> 16); }
}
__device__ __forceinline__ void unpk8(v4u w, float* f) { f[0] = bflo(w.x); f[1] = bfhi(w.x); f[2] = bflo(w.y); f[3] = bfhi(w.y); f[4] = bflo(w.z); f[5] = bfhi(w.z); f[6] = bflo(w.w); f[7] = bfhi(w.w); }
__device__ __forceinline__ void dsa_prep(Frame& F, int j) {
    const bf16* P = (const bf16*)(F.ws + WS_P); bf16* KD = (bf16*)(F.ws + WS_KD); bf16* VD = (bf16*)(F.ws + WS_VD); bf16* KI = (bf16*)(F.ws + WS_KI);
    const float* kvg = F.inp(2) + j * 128; const float* wuk = F.inp(3) + (size_t)j * 128 * 64; const float* wuv = F.inp(4) + (size_t)j * 128 * 64;
    const float* kg = F.inp(5) + j * 64; const float* kb = F.inp(6) + j * 64;
    constexpr int WT_RS = 136;
    LAS bf16* sWt = (LAS bf16*)F.lds;
    for (int i = F.tid; i < 128 * 128; i += NTHR) {
        const int c = i >> 7, f = i & 127; const float w = (f < 64) ? wuk[c * 64 + f] * C2 : wuv[c * 64 + (f - 64)];
        sWt[f * WT_RS + c] = (bf16)f2bf(w * kvg[c]); }
    __syncthreads();
    const int lane = F.lane, t16 = lane & 15, quad = lane >> 4;
    bf16x8_t af[8][4];
#pragma unroll
    for (int ft = 0; ft < 8; ++ft)
#pragma unroll
        for (int ks = 0; ks < 4; ++ks) af[ft][ks] = *(const LAS bf16x8_t*)(sWt + (16 * ft + t16) * WT_RS + 32 * ks + 8 * quad);
    float kgl[16], kbl[16];
#pragma unroll
    for (int k = 0; k < 16; ++k) { kgl[k] = kg[16 * quad + k]; kbl[k] = kb[16 * quad + k]; }
    for (int m0 = F.gw * 16; m0 < M; m0 += F.NGW * 16) {
        const bf16* pr = P + (size_t)(m0 + t16) * EINP;
        bf16x8_t cf[4]; float ss = 0.f;
#pragma unroll
        for (int ks = 0; ks < 4; ++ks) { const v4u w = *(const v4u*)(pr + PC_CKV + 32 * ks + 8 * quad); cf[ks] = __builtin_bit_cast(bf16x8_t, w);
            float f8[8]; unpk8(w, f8);
#pragma unroll
            for (int k = 0; k < 8; ++k) ss += f8[k] * f8[k]; }
        ss += __int_as_float(__builtin_amdgcn_ds_bpermute((lane ^ 16) << 2, __float_as_int(ss))); ss += __int_as_float(__builtin_amdgcn_ds_bpermute((lane ^ 32) << 2, __float_as_int(ss)));
        const float rs = 1.f / sqrtf(ss * (1.f / 128.f) + RMS_EPS);
#pragma unroll
        for (int ft = 0; ft < 8; ++ft) {
            f32x4_t c = {0.f, 0.f, 0.f, 0.f};
#pragma unroll
            for (int ks = 0; ks < 4; ++ks) c = __builtin_amdgcn_mfma_f32_16x16x32_bf16(af[ft][ks], cf[ks], c, 0, 0, 0);
            u32x2_t o; o.x = pk2(c[0] * rs, c[1] * rs); o.y = pk2(c[2] * rs, c[3] * rs);
            bf16* dst = (ft < 4 ? KD : VD) + (size_t)(m0 + t16) * 64 + 16 * (ft & 3) + 4 * quad;
            *(u32x2_t*)dst = o;
        }
        {
            float x[16]; const v4u w0 = *(const v4u*)(pr + PC_KI + 16 * quad), w1 = *(const v4u*)(pr + PC_KI + 16 * quad + 8); unpk8(w0, x); unpk8(w1, x + 8);
            float s = 0.f;
#pragma unroll
            for (int k = 0; k < 16; ++k) s += x[k];
            s += __int_as_float(__builtin_amdgcn_ds_bpermute((lane ^ 16) << 2, __float_as_int(s))); s += __int_as_float(__builtin_amdgcn_ds_bpermute((lane ^ 32) << 2, __float_as_int(s)));
            const float mean = s * (1.f / 64.f); float q = 0.f;
#pragma unroll
            for (int k = 0; k < 16; ++k) { x[k] -= mean; q += x[k] * x[k]; }
            q += __int_as_float(__builtin_amdgcn_ds_bpermute((lane ^ 16) << 2, __float_as_int(q))); q += __int_as_float(__builtin_amdgcn_ds_bpermute((lane ^ 32) << 2, __float_as_int(q)));
            const float rstd = 1.f / sqrtf(q * (1.f / 64.f) + LN_EPS);
            v4u o0, o1;
            o0.x = pk2(x[0] * rstd * kgl[0] + kbl[0], x[1] * rstd * kgl[1] + kbl[1]); o0.y = pk2(x[2] * rstd * kgl[2] + kbl[2], x[3] * rstd * kgl[3] + kbl[3]);
            o0.z = pk2(x[4] * rstd * kgl[4] + kbl[4], x[5] * rstd * kgl[5] + kbl[5]); o0.w = pk2(x[6] * rstd * kgl[6] + kbl[6], x[7] * rstd * kgl[7] + kbl[7]);
            o1.x = pk2(x[8] * rstd * kgl[8] + kbl[8], x[9] * rstd * kgl[9] + kbl[9]); o1.y = pk2(x[10] * rstd * kgl[10] + kbl[10], x[11] * rstd * kgl[11] + kbl[11]);
            o1.z = pk2(x[12] * rstd * kgl[12] + kbl[12], x[13] * rstd * kgl[13] + kbl[13]); o1.w = pk2(x[14] * rstd * kgl[14] + kbl[14], x[15] * rstd * kgl[15] + kbl[15]);
            bf16* kd = KI + (size_t)(m0 + t16) * 64 + 16 * quad; *(v4u*)kd = o0; *(v4u*)(kd + 8) = o1;
        }
    }
    __syncthreads();
}

struct GlaPrepIn { v4u v0, v1, g0, g1, q, k; };
__device__ __forceinline__ GlaPrepIn gla_prep_load(const bf16* P, int unit, int tid) {
    const int h = unit & 3, tok0 = (unit >> 2) * 64; GlaPrepIn r;
    { const int t = tid & 63, ec = tid >> 6; const bf16* p = P + (size_t)(tok0 + t) * EINP + PC_BV + h * 128 + 8 * ec; r.v0 = *(const v4u*)p; r.v1 = *(const v4u*)(p + 64); }
    { const int t = tid >> 3, dg = tid & 7; const bf16* p = P + (size_t)(tok0 + t) * EINP;
      r.g0 = *(const v4u*)(p + PC_BG); r.g1 = *(const v4u*)(p + PC_BG + 8); r.q = *(const v4u*)(p + PC_BQ + h * 64 + 8 * dg); r.k = *(const v4u*)(p + PC_BK + h * 64 + 8 * dg); }
    return r;
}
__device__ __forceinline__ void gla_prep(Frame& F, int j) {
    const bf16* P = (const bf16*)(F.ws + WS_P); bf16* QT = (bf16*)(F.ws + WS_QT); bf16* KT = (bf16*)(F.ws + WS_KT);
    float* EBL = (float*)(F.ws + WS_EBL); float* GST = (float*)(F.ws + WS_GST);
    const float* wg2 = F.inp(7) + (size_t)j * 16 * 256; const float* bgb = F.inp(8) + j * 256;
    LAS float* sG = (LAS float*)F.lds;
    LAS float* sSeg = sG + 4096;
    LAS bf16* sKHt = (LAS bf16*)(F.lds + 18432);
    LAS bf16* sVt = (LAS bf16*)(F.lds + 27648);
    LAS float* sW = (LAS float*)(F.lds + 46080);
    const int tid = F.tid, lane = F.lane, hi = lane >> 5, r32 = lane & 31;
    const int NU = BATCH * 32 * 4;
    int hw = -1;
    GlaPrepIn cur; if (F.bx < NU) cur = gla_prep_load(P, F.bx, tid);
    for (int unit = F.bx; unit < NU; unit += F.G) {
        const int h = unit & 3, bc = unit >> 2, tok0 = bc * 64;
        GlaPrepIn nxt = cur; if (unit + F.G < NU) nxt = gla_prep_load(P, unit + F.G, tid);
        if (h != hw) { for (int i = tid; i < 1024; i += NTHR) sW[i] = wg2[(i >> 6) * 256 + h * 64 + (i & 63)]; if (tid < 64) sW[1024 + tid] = bgb[h * 64 + tid]; hw = h; }
        gla_put_vt(sVt, tid, cur.v0, cur.v1);
        LDS_BAR();
        const int t8 = tid >> 3, dg = tid & 7;
        {
            float bg[16]; unpk8(cur.g0, bg); unpk8(cur.g1, bg + 8);
#pragma unroll
            for (int k = 0; k < 8; ++k) { const int d = 8 * dg + k; float z = sW[1024 + d];
#pragma unroll
                for (int r = 0; r < 16; ++r) z += bg[r] * sW[r * 64 + d];
                sG[t8 * 64 + d] = (fminf(z, 0.f) - __logf(1.f + __expf(-fabsf(z)))) * (1.f / 16.f); }
        }
        LDS_BAR();
        {
            const int d = tid & 63, seg = tid >> 6; float pre[8], run = 0.f;
#pragma unroll
            for (int k = 0; k < 8; ++k) { run += sG[(8 * seg + k) * 64 + d]; pre[k] = run; }
            sSeg[seg * 64 + d] = run;
            LDS_BAR();
            float off = 0.f;
#pragma unroll
            for (int s2 = 0; s2 < 7; ++s2) off += (s2 < seg) ? sSeg[s2 * 64 + d] : 0.f;
#pragma unroll
            for (int k = 0; k < 8; ++k) sG[(8 * seg + k) * 64 + d] = off + pre[k];
        }
        LDS_BAR();
        {
            float q[8], kk[8]; unpk8(cur.q, q); unpk8(cur.k, kk);
            const f32x4 b0 = *(const LAS f32x4*)(sG + t8 * 64 + 8 * dg), b1 = *(const LAS f32x4*)(sG + t8 * 64 + 8 * dg + 4);
            const f32x4 l0 = *(const LAS f32x4*)(sG + 63 * 64 + 8 * dg), l1 = *(const LAS f32x4*)(sG + 63 * 64 + 8 * dg + 4);
            const float bb[8] = {b0.x, b0.y, b0.z, b0.w, b1.x, b1.y, b1.z, b1.w}, bl[8] = {l0.x, l0.y, l0.z, l0.w, l1.x, l1.y, l1.z, l1.w};
            float qo[8], ko[8];
#pragma unroll
            for (int k = 0; k < 8; ++k) { qo[k] = q[k] * 0.125f * __expf(bb[k]); ko[k] = kk[k] * __expf(-bb[k]); sKHt[(8 * dg + k) * GLA_RT + t8] = (bf16)f2bf(kk[k] * __expf(bl[k] - bb[k])); }
            v4u wq, wk; wq.x = pk2(qo[0], qo[1]); wq.y = pk2(qo[2], qo[3]); wq.z = pk2(qo[4], qo[5]); wq.w = pk2(qo[6], qo[7]); wk.x = pk2(ko[0], ko[1]); wk.y = pk2(ko[2], ko[3]); wk.z = pk2(ko[4], ko[5]); wk.w = pk2(ko[6], ko[7]);
            { const size_t fo = (size_t)unit * 4096 + (size_t)((((t8 >> 5) * 4 + (dg >> 1)) * 64 + (t8 & 31) + 32 * (dg & 1)) * 8);
              *(v4u*)(QT + fo) = wq; *(v4u*)(KT + fo) = wk; }
            if (t8 == 63) {
#pragma unroll
                for (int k = 0; k < 8; ++k) EBL[(size_t)bc * 256 + h * 64 + 8 * dg + k] = __expf(bl[k]); }
        }
        LDS_BAR();
        {
            const int db = F.wave >> 2, eb = F.wave & 3; f32x16_t acc = {};
#pragma unroll
            for (int ks = 0; ks < 4; ++ks) {
                const bf16x8_t a = *(const LAS bf16x8_t*)(sKHt + (32 * db + r32) * GLA_RT + 16 * ks + 8 * hi);
                const bf16x8_t bfr = *(const LAS bf16x8_t*)(sVt + (32 * eb + r32) * GLA_RT + 16 * ks + 8 * hi);
                acc = __builtin_amdgcn_mfma_f32_32x32x16_bf16(a, bfr, acc, 0, 0, 0); }
            bf16* g = (bf16*)GST + (size_t)unit * 8192 + 4 * hi;
#pragma unroll
            for (int rg = 0; rg < 4; ++rg) *(GAS unsigned long long*)(g + (((eb * 4 + 2 * db + (rg >> 1)) * 64 + r32 + 32 * (rg & 1)) * 8)) = (unsigned long long)pk2(acc[4 * rg], acc[4 * rg + 1]) | ((unsigned long long)pk2(acc[4 * rg + 2], acc[4 * rg + 3]) << 32);
        }
        LDS_BAR();
        cur = nxt;
    }
}
__device__ __forceinline__ void gla_scan(Frame& F) {
    const float* GST = (const float*)(F.ws + WS_GST); const float* EBL = (const float*)(F.ws + WS_EBL); bf16* GSB = (bf16*)(F.ws + WS_GSB);
    const int gt = F.bx * NTHR + F.tid, NG = F.G * NTHR;
    for (int idx = gt; idx < BATCH * 4 * 2048; idx += NG) {
        const int de = (idx & 2047) * 4, h = (idx >> 11) & 3, b = idx >> 13, d = 16 * ((de >> 9) & 3) + 8 * ((de >> 8) & 1) + (de & 7);
        f32x4 S = {0.f, 0.f, 0.f, 0.f};
#pragma unroll 16
        for (int c = 0; c < 32; ++c) { const size_t off = (size_t)(((b * 32 + c) << 2) + h) * 8192 + de; const unsigned long long aw = *(const GAS unsigned long long*)((const bf16*)GST + off); const f32x4 a = {bflo((unsigned)aw), bfhi((unsigned)aw), bflo((unsigned)(aw >> 32)), bfhi((unsigned)(aw >> 32))};
            *(GAS unsigned long long*)(GSB + off) = (unsigned long long)pk2(S.x, S.y) | ((unsigned long long)pk2(S.z, S.w) << 32);
            const f32x4 e = *(const f32x4*)(EBL + (size_t)(b * 32 + c) * 256 + h * 64 + d); S = e * S + a; }
    }
}
struct GlaOutIn { v4u v0, v1; bf16x8_t qf[4], kf[2][4], sf[4]; unsigned rw[8]; };
__device__ __forceinline__ GlaOutIn gla_out_load(const bf16* P, const bf16* QT, const bf16* KT, const bf16* GSB, int unit, int tid, int wave, int lane) {
    const int h = unit & 3, tok0 = (unit >> 2) * 64, hi = lane >> 5, r32 = lane & 31, ib = wave & 1, eb = wave >> 1; GlaOutIn r;
    { const int t = tid & 63, ec = tid >> 6; const bf16* p = P + (size_t)(tok0 + t) * EINP + PC_BV + h * 128 + 8 * ec; r.v0 = *(const v4u*)p; r.v1 = *(const v4u*)(p + 64); }
#pragma unroll
    for (int ks = 0; ks < 4; ++ks) { r.qf[ks] = *(const bf16x8_t*)(QT + (size_t)unit * 4096 + ((ib * 4 + ks) * 64 + lane) * 8);
        r.kf[0][ks] = *(const bf16x8_t*)(KT + (size_t)unit * 4096 + ((0 * 4 + ks) * 64 + lane) * 8);
        r.kf[1][ks] = *(const bf16x8_t*)(KT + (size_t)unit * 4096 + ((1 * 4 + ks) * 64 + lane) * 8); }
    const bf16* sr = GSB + (size_t)unit * 8192;
#pragma unroll
    for (int ks = 0; ks < 4; ++ks) r.sf[ks] = *(const bf16x8_t*)(sr + ((eb * 4 + ks) * 64 + lane) * 8);
#pragma unroll
    for (int i = 0; i < 8; ++i) r.rw[i] = *(const unsigned*)(P + (size_t)(tok0 + wave + 8 * i) * EINP + PC_BR + h * 128 + 2 * lane);
    return r;
}
__device__ __forceinline__ void gla_out(Frame& F, int j) {
    const bf16* P = (const bf16*)(F.ws + WS_P); const bf16* QT = (const bf16*)(F.ws + WS_QT); const bf16* KT = (const bf16*)(F.ws + WS_KT);
    const bf16* GST = (const bf16*)(F.ws + WS_GSB); bf16* MIX = (bf16*)(F.ws + WS_MIX); const float* ng = F.inp(9) + j * 512;
    LAS bf16* sVt = (LAS bf16*)F.lds;
    LAS float* sO = (LAS float*)(F.lds + 18432);
    const int tid = F.tid, lane = F.lane, hi = lane >> 5, r32 = lane & 31;
    const int ib = F.wave & 1, eb = F.wave >> 1;
    const int NU = BATCH * 32 * 4;
    GlaOutIn cur; if (F.bx < NU) cur = gla_out_load(P, QT, KT, GST, F.bx, tid, F.wave, lane);
    for (int unit = F.bx; unit < NU; unit += F.G) {
        const int h = unit & 3, bc = unit >> 2, tok0 = bc * 64;
        GlaOutIn nxt = cur; if (unit + F.G < NU) nxt = gla_out_load(P, QT, KT, GST, unit + F.G, tid, F.wave, lane);
        gla_put_vt(sVt, tid, cur.v0, cur.v1);
        LDS_BAR();
        f32x16_t acc = {};
#pragma unroll
        for (int jb = 0; jb < 2; ++jb) {
            if (jb <= ib) {
                f32x16_t X = {};
#pragma unroll
                for (int ks = 0; ks < 4; ++ks) X = __builtin_amdgcn_mfma_f32_32x32x16_bf16(cur.kf[jb][ks], cur.qf[ks], X, 0, 0, 0);
                if (jb == ib) {
#pragma unroll
                    for (int r = 0; r < 16; ++r) { const int jr = (r & 3) + 8 * (r >> 2) + 4 * hi; if (jr > r32) X[r] = 0.f; }
                }
#pragma unroll
                for (int s2 = 0; s2 < 2; ++s2) {
                    u32x4_t xw; xw.x = pk2(X[8 * s2], X[8 * s2 + 1]); xw.y = pk2(X[8 * s2 + 2], X[8 * s2 + 3]); xw.z = pk2(X[8 * s2 + 4], X[8 * s2 + 5]); xw.w = pk2(X[8 * s2 + 6], X[8 * s2 + 7]);
                    const LAS bf16* vr = sVt + (32 * eb + r32) * GLA_RT + 32 * jb + 16 * s2 + 4 * hi;
                    const u32x2_t a0 = *(const LAS u32x2_t*)vr, a1 = *(const LAS u32x2_t*)(vr + 8);
                    u32x4_t aw; aw.x = a0.x; aw.y = a0.y; aw.z = a1.x; aw.w = a1.y;
                    acc = __builtin_amdgcn_mfma_f32_32x32x16_bf16(__builtin_bit_cast(bf16x8_t, aw), __builtin_bit_cast(bf16x8_t, xw), acc, 0, 0, 0);
                }
            }
        }
#pragma unroll
        for (int ks = 0; ks < 4; ++ks) acc = __builtin_amdgcn_mfma_f32_32x32x16_bf16(cur.sf[ks], cur.qf[ks], acc, 0, 0, 0);
#pragma unroll
        for (int r = 0; r < 16; ++r) sO[(32 * ib + r32) * 129 + 32 * eb + (r & 3) + 8 * (r >> 2) + 4 * hi] = acc[r];
        LDS_BAR();
        const float n0 = ng[h * 128 + 2 * lane], n1 = ng[h * 128 + 2 * lane + 1];
#pragma unroll
        for (int i8 = 0; i8 < 8; ++i8) { const int i = F.wave + 8 * i8;
            const float o0 = sO[i * 129 + 2 * lane], o1 = sO[i * 129 + 2 * lane + 1];
            const float rs = 1.f / sqrtf(wave_sum(o0 * o0 + o1 * o1) * (1.f / 128.f) + RMS_EPS);
            const unsigned rw = cur.rw[i8];
            *(unsigned*)(MIX + (size_t)(tok0 + i) * D + 512 + h * 128 + 2 * lane) = pk2(o0 * rs * n0 * silu_f(bflo(rw)), o1 * rs * n1 * silu_f(bfhi(rw)));
        }
        LDS_BAR();
        cur = nxt;
    }
}

__device__ __forceinline__ int wave_sum_dpp(int v) {
    v += __builtin_amdgcn_mov_dpp(v, 0xB1, 0xF, 0xF, true);
    v += __builtin_amdgcn_mov_dpp(v, 0x4E, 0xF, 0xF, true);
    v += __builtin_amdgcn_mov_dpp(v, 0x141, 0xF, 0xF, true);
    v += __builtin_amdgcn_mov_dpp(v, 0x140, 0xF, 0xF, true);
    v += __builtin_amdgcn_update_dpp(0, v, 0x142, 0xA, 0xF, false);
    v += __builtin_amdgcn_update_dpp(0, v, 0x143, 0xC, 0xF, false);
    return __builtin_amdgcn_readlane(v, 63);
}
__device__ __forceinline__ unsigned mono_key(float f) { const unsigned u = __float_as_uint(f); return (u & 0x80000000u) ? ~u : (u | 0x80000000u); }
__device__ __forceinline__ float relu1(float x) { const int b = __float_as_int(x); return __int_as_float(b > 0 ? b : 0); }
__device__ __forceinline__ void dsa_index(Frame& F) {
    const bf16* P = (const bf16*)(F.ws + WS_P); const bf16* KI = (const bf16*)(F.ws + WS_KI);
    unsigned* MASK = (unsigned*)(F.ws + WS_MASK);
    LAS unsigned char* scl = F.lds;
    const int nu = 2 * ((BATCH * 64 - F.bx + F.G - 1) / F.G);
#define IDX_UNIT(u, b_, blk_) do { const int v_ = F.bx + ((u) >> 1) * F.G; b_ = (v_ >> 6) & 15; const int s_ = ((v_ & 63) + 16 * (v_ >> 8)) & 63; blk_ = ((u) & 1) ? 127 - s_ : s_; } while (0)
#define IDX_QLOAD(b_, blk_) do { int ln_ = F.lane; asm volatile("" : "+v"(ln_)); const bf16* qr_ = P + (size_t)((b_) * SEQ + (blk_) * 16 + (ln_ & 15)) * EINP; \
        _Pragma("unroll") for (int h = 0; h < 8; ++h) { qfn[h][0] = *(const bf16x8_t*)(qr_ + PC_QI + h * 64 + 8 * (ln_ >> 4)); qfn[h][1] = *(const bf16x8_t*)(qr_ + PC_QI + h * 64 + 32 + 8 * (ln_ >> 4)); } \
        wnq = *(const v4u*)(qr_ + PC_WI); } while (0)
    bf16x8_t qfn[8][2]; v4u wnq = (v4u){0u, 0u, 0u, 0u};
    { int b0_, blk0_; IDX_UNIT(0, b0_, blk0_); if (blk0_ > 15) IDX_QLOAD(b0_, blk0_); }
#pragma unroll 1
    for (int u = 0; u < nu; ++u) {
        {
            int b, blk; IDX_UNIT(u, b, blk);
            const int q0 = blk * 16, ntk = (q0 >> 6) + 1;
            if (blk > 15) {
                int lane = F.lane; asm volatile("" : "+v"(lane)); const int c16 = lane & 15, quad = lane >> 4;
                bf16x8_t qf[8][2]; float w[8];
#pragma unroll
                for (int h = 0; h < 8; ++h) { qf[h][0] = qfn[h][0]; qf[h][1] = qfn[h][1]; }
                { float f[8]; unpk8(wnq, f);
#pragma unroll
                    for (int h = 0; h < 8; ++h) w[h] = f[h]; }
                const bf16* kbase = KI + (size_t)(b * SEQ + c16) * 64 + 8 * quad;
                LAS unsigned char* wrow = scl + c16 * 8192;
                const int nit = 4 * ntk;
                const int cnt = (nit - F.wave + NWAVES - 1) / NWAVES, last = F.wave + NWAVES * (cnt - 1);
                auto do_item = [&](const int it, const bf16x8_t af0, const bf16x8_t af1) {
                    f32x4_t sc = {0.f, 0.f, 0.f, 0.f};
#pragma unroll
                    for (int h = 0; h < 8; ++h) {
                        f32x4_t c = {0.f, 0.f, 0.f, 0.f};
                        c = __builtin_amdgcn_mfma_f32_16x16x32_bf16(af0, qf[h][0], c, 0, 0, 0);
                        c = __builtin_amdgcn_mfma_f32_16x16x32_bf16(af1, qf[h][1], c, 0, 0, 0);
                        sc[0] += w[h] * relu1(c[0]); sc[1] += w[h] * relu1(c[1]); sc[2] += w[h] * relu1(c[2]); sc[3] += w[h] * relu1(c[3]);
                    }
                    const int ch = 4 * it + quad;
                    *(LAS f32x4_t*)(wrow + ((ch & ~15) | ((ch ^ (ch >> 4) ^ c16) & 15)) * 16) = sc;
                };
                bf16x8_t afq[4][2];
#pragma unroll
                for (int j = 0; j < 4; ++j) { const int itj = min(F.wave + NWAVES * j, last);
                    afq[j][0] = *(const bf16x8_t*)(kbase + (size_t)(16 * itj) * 64); afq[j][1] = *(const bf16x8_t*)(kbase + (size_t)(16 * itj) * 64 + 32); }
                int base = F.wave, done = 0;
#pragma unroll 1
                for (; done + 4 <= cnt; done += 4, base += 4 * NWAVES) {
                    bf16x8_t anx[4][2];
#pragma unroll
                    for (int j = 0; j < 4; ++j) { const int itn = min(base + NWAVES * (j + 4), last);
                        anx[j][0] = *(const bf16x8_t*)(kbase + (size_t)(16 * itn) * 64); anx[j][1] = *(const bf16x8_t*)(kbase + (size_t)(16 * itn) * 64 + 32); }
#pragma unroll
                    for (int j = 0; j < 4; ++j) do_item(base + NWAVES * j, afq[j][0], afq[j][1]);
#pragma unroll
                    for (int j = 0; j < 4; ++j) { afq[j][0] = anx[j][0]; afq[j][1] = anx[j][1]; }
                }
#pragma unroll
                for (int j = 0; j < 3; ++j) if (done + j < cnt) do_item(base + NWAVES * j, afq[j][0], afq[j][1]);
            }
            if (u + 1 < nu) { int b2_, blk2_; IDX_UNIT(u + 1, b2_, blk2_); if (blk2_ > 15) IDX_QLOAD(b2_, blk2_); }
            LDS_BAR();
            int lane = F.lane; asm volatile("" : "+v"(lane));
            {
                const int ra = 2 * F.wave, ia = q0 + ra, ib = ia + 1;
                unsigned ma, mb;
                if (ib < TOPK) {
                    const int na = ia - 32 * lane + 1, nb = ib - 32 * lane + 1;
                    ma = na <= 0 ? 0u : (na >= 32 ? 0xffffffffu : ((1u << na) - 1u)); mb = nb <= 0 ? 0u : (nb >= 32 ? 0xffffffffu : ((1u << nb) - 1u));
                } else {
                    unsigned ua[32], ub[32];
#pragma unroll
                    for (int k = 0; k < 8; ++k) { const int ch = 8 * lane + k;
                        const f32x4_t xa = *(const LAS f32x4_t*)(scl + ra * 8192 + ((ch & ~15) | ((ch ^ (ch >> 4) ^ ra) & 15)) * 16);
                        const f32x4_t xb = *(const LAS f32x4_t*)(scl + (ra + 1) * 8192 + ((ch & ~15) | ((ch ^ (ch >> 4) ^ (ra + 1)) & 15)) * 16);
#pragma unroll
                        for (int e = 0; e < 4; ++e) { ua[4 * k + e] = __float_as_uint(xa[e]); ub[4 * k + e] = __float_as_uint(xb[e]); } }
#pragma unroll
                    for (int st = 0; st < 5; ++st) { const int j = 16 >> st; const unsigned m = (st == 0) ? 0x0000FFFFu : (st == 1) ? 0x00FF00FFu : (st == 2) ? 0x0F0F0F0Fu : (st == 3) ? 0x33333333u : 0x55555555u;
#pragma unroll
                        for (int k = 0; k < 32; ++k) if ((k & j) == 0) {
                            { const unsigned hi = ua[k], lo = ua[k + j]; ua[k + j] = (lo & ~m) | ((hi >> j) & m); ua[k] = (hi & ~(m << j)) | ((lo << j) & (m << j)); }
                            { const unsigned hi = ub[k], lo = ub[k + j]; ub[k + j] = (lo & ~m) | ((hi >> j) & m); ub[k] = (hi & ~(m << j)) | ((lo << j) & (m << j)); } }
                        __builtin_amdgcn_sched_barrier(0); }
                    const int nva = ia - 32 * lane + 1, nvb = ib - 32 * lane + 1;
                    unsigned Ga = 0u, Ea = nva <= 0 ? 0u : (nva >= 32 ? 0xffffffffu : ((1u << nva) - 1u)), Gb = 0u, Eb = nvb <= 0 ? 0u : (nvb >= 32 ? 0xffffffffu : ((1u << nvb) - 1u));
                    const unsigned sa = ua[31], sb = ub[31];
#pragma unroll
                    for (int bit = 17; bit >= 0; --bit) {
                        const unsigned pa_ = (bit == 17) ? ~sa : (ua[14 + bit] ^ sa), pb_ = (bit == 17) ? ~sb : (ub[14 + bit] ^ sb);
                        const unsigned ca = Ea & pa_, cb = Eb & pb_;
                        const int tot = wave_sum_dpp(__builtin_popcount(Ga | ca) + (__builtin_popcount(Gb | cb) << 16));
                        if ((tot & 0xffff) >= TOPK) Ea = ca; else { Ga |= ca; Ea ^= ca; }
                        if ((tot >> 16) >= TOPK) Eb = cb; else { Gb |= cb; Eb ^= cb; }
                    }
                    const int ea = __builtin_popcount(Ea), eb = __builtin_popcount(Eb);
                    const int totg = wave_sum_dpp(__builtin_popcount(Ga) + (__builtin_popcount(Gb) << 16));
                    const int tiet = wave_sum_dpp(ea + (eb << 16));
                    const int needa = TOPK - (totg & 0xffff), needb = TOPK - (totg >> 16);
                    if (needa == (tiet & 0xffff) && needb == (tiet >> 16)) { ma = Ga | Ea; mb = Gb | Eb; }
                    else {
                        int pa = wave_incl_scan_i(ea, lane) - ea, pb2 = wave_incl_scan_i(eb, lane) - eb; ma = Ga; mb = Gb;
#pragma unroll
                        for (int r = 0; r < 32; ++r) {
                            const unsigned ba = (Ea >> r) & 1u, bb = (Eb >> r) & 1u;
                            ma |= (ba & (pa < needa ? 1u : 0u)) << r; pa += (int)ba;
                            mb |= (bb & (pb2 < needb ? 1u : 0u)) << r; pb2 += (int)bb;
                        }
                    }
                }
                MASK[(size_t)(b * SEQ + ia) * 64 + lane] = ma; MASK[(size_t)(b * SEQ + ib) * 64 + lane] = mb;
            }
            LDS_BAR();
        }
    }
#undef IDX_UNIT
#undef IDX_QLOAD
}

typedef float f32x16_d __attribute__((ext_vector_type(16)));
typedef short v4i16_d __attribute__((ext_vector_type(4)));
constexpr int DT_RSK = 72, DT_RSV = 160;
constexpr int DT_BUF = 64 * DT_RSK * 2 + 64 * DT_RSV * 2;
__device__ __forceinline__ void frame_refresh(Frame& F);
__device__ __forceinline__ void diff_attn_t(Frame& F, unsigned char* ldsg, int j, const float lam_init) {
    const bf16* QKV = (const bf16*)(F.ws + WS_QKV); bf16* MIXO = (bf16*)(F.ws + WS_MIXO);
    LAS unsigned char* lds = F.lds;
    LAS unsigned* sO0 = (LAS unsigned*)(lds + 2 * DT_BUF) + F.wave * 2048;
    LAS float* sG = (LAS float*)(lds + 2 * DT_BUF + 65536);
    const int wave = F.wave;
    float lam;
    { const int tid = F.tid, lane = F.lane;
    if (tid < 128) sG[tid] = F.inp(23)[j * 128 + tid] * (1.f - lam_init);
    { const float a = wave_sum_l(F.inp(19)[j * 64 + lane] * F.inp(20)[j * 64 + lane], lane), c = wave_sum_l(F.inp(21)[j * 64 + lane] * F.inp(22)[j * 64 + lane], lane); lam = __expf(a) - __expf(c) + lam_init; } }
    __syncthreads();
    const int vcu = (F.G % 8 == 0) ? (F.bx % 8) * (F.G / 8) + F.bx / 8 : F.bx;
    for (int v = vcu; v < BATCH * 8 * 2; v += F.G) {
        const int bh = v >> 1, p = v & 1, b = bh >> 3, h = bh & 7;
#pragma unroll 1
        for (int qi = 0; qi < 4; ++qi) {
            const int qb = (qi == 0) ? p : (qi == 1) ? 7 - p : (qi == 2) ? 2 + p : 5 - p;
            const int lane = hw_lane(), tid = wave * 64 + lane, r32 = lane & 31, hi = lane >> 5;
            const int krow = tid >> 3, kch = tid & 7, vrow = tid >> 4, vch = tid & 15;
            const int vtr = (4 * hi + ((lane & 15) >> 2)) * (DT_RSV * 2) + ((lane >> 4) & 1) * 32 + (lane & 3) * 8;
            const int nt = 4 * (qb + 1), qpos = 256 * qb + 32 * wave + r32, wmin = 256 * qb + 32 * wave;
            const size_t tokq = (size_t)b * SEQ + qpos;
#pragma unroll 1
            for (int m = 0; m < 2; ++m) {
                bf16x8_t qf[4];
#pragma unroll
                for (int ks = 0; ks < 4; ++ks) qf[ks] = *(const bf16x8_t*)(QKV + tokq * 3072 + h * 128 + m * 64 + 16 * ks + 8 * hi);
                f32x16_d O[4];
#pragma unroll
                for (int db = 0; db < 4; ++db) O[db] = f32x16_d{};
                float mrun = 0.f, lsum = 0.f; f32x16_d negm = f32x16_d{};
                const bf16* kg = QKV + ((size_t)b * SEQ + krow) * 3072 + 1024 + h * 128 + m * 64 + kch * 8;
                const bf16* vg = QKV + ((size_t)b * SEQ + vrow) * 3072 + 2048 + h * 128 + vch * 8;
                v4u sk[2], sv0[2], sv1[2];
                sk[0] = *(const v4u*)kg; sv0[0] = *(const v4u*)vg; sv1[0] = *(const v4u*)(vg + (size_t)32 * 3072);
                { const size_t ko = (size_t)64 * 3072; sk[1] = *(const v4u*)(kg + ko); sv0[1] = *(const v4u*)(vg + ko); sv1[1] = *(const v4u*)(vg + ko + (size_t)32 * 3072); }
                *(LAS v4u*)(lds + krow * (DT_RSK * 2) + kch * 16) = sk[0];
                *(LAS v4u*)(lds + 64 * DT_RSK * 2 + vrow * (DT_RSV * 2) + vch * 16) = sv0[0]; *(LAS v4u*)(lds + 64 * DT_RSK * 2 + (vrow + 32) * (DT_RSV * 2) + vch * 16) = sv1[0];
                __syncthreads();
#pragma unroll 1
                for (int t2 = 0; t2 < nt; t2 += 2) {
#pragma unroll
                  for (int tp = 0; tp < 2; ++tp) {
                    const int t = t2 + tp;
                    const int buf = tp * DT_BUF;
                    if (t + 2 < nt) { const size_t ko = (size_t)(t + 2) * 64 * 3072; sk[tp] = *(const v4u*)(kg + ko); sv0[tp] = *(const v4u*)(vg + ko); sv1[tp] = *(const v4u*)(vg + ko + (size_t)32 * 3072); }
                    if (64 * t <= wmin + 31) {
                        LAS unsigned char* kb_ = lds + buf; LAS unsigned char* vb_ = lds + buf + 64 * DT_RSK * 2;
                        f32x16_d S[2];
#pragma unroll
                        for (int kb = 0; kb < 2; ++kb) {
#pragma unroll
                            for (int ks = 0; ks < 4; ++ks) { const bf16x8_t kf = *(const LAS bf16x8_t*)(kb_ + (32 * kb + r32) * (DT_RSK * 2) + (16 * ks + 8 * hi) * 2);
                                S[kb] = __builtin_amdgcn_mfma_f32_32x32x16_bf16(kf, qf[ks], ks == 0 ? negm : S[kb], 0, 0, 0); } }
                        if (64 * t + 63 > wmin) {
#pragma unroll
                            for (int kb = 0; kb < 2; ++kb)
#pragma unroll
                                for (int r = 0; r < 16; ++r) { const int key = 64 * t + 32 * kb + (r & 3) + 8 * (r >> 2) + 4 * hi; if (key > qpos) S[kb][r] = -INFINITY; }
                        }
                        float mx = S[0][0];
#pragma unroll
                        for (int r = 1; r < 16; ++r) mx = fmaxf(mx, S[0][r]);
#pragma unroll
                        for (int r = 0; r < 16; ++r) mx = fmaxf(mx, S[1][r]);
                        { auto rr = __builtin_amdgcn_permlane32_swap(__float_as_uint(mx), __float_as_uint(mx), false, false); mx = fmaxf(__uint_as_float(rr[0]), __uint_as_float(rr[1])); }
                        if (__builtin_expect(__any(mx > 8.f), 0)) {
                            const float dl = fmaxf(mx, 0.f), alpha = __builtin_amdgcn_exp2f(-dl); mrun += dl; lsum *= alpha;
#pragma unroll
                            for (int kb = 0; kb < 2; ++kb)
#pragma unroll
                                for (int r = 0; r < 16; ++r) S[kb][r] -= dl;
#pragma unroll
                            for (int r = 0; r < 16; ++r) negm[r] = -mrun;
#pragma unroll
                            for (int db = 0; db < 4; ++db)
#pragma unroll
                                for (int r = 0; r < 16; ++r) O[db][r] *= alpha;
                        }
                        float ps = 0.f;
#pragma unroll
                        for (int kb = 0; kb < 2; ++kb)
#pragma unroll
                            for (int r = 0; r < 16; ++r) { const float pv = __builtin_amdgcn_exp2f(S[kb][r]); S[kb][r] = pv; ps += pv; }
                        lsum += ps;
#pragma unroll
                        for (int kb = 0; kb < 2; ++kb)
#pragma unroll
                            for (int s2 = 0; s2 < 2; ++s2) {
                                u32x4_t pw; pw.x = pk2(S[kb][8 * s2], S[kb][8 * s2 + 1]); pw.y = pk2(S[kb][8 * s2 + 2], S[kb][8 * s2 + 3]); pw.z = pk2(S[kb][8 * s2 + 4], S[kb][8 * s2 + 5]); pw.w = pk2(S[kb][8 * s2 + 6], S[kb][8 * s2 + 7]);
                                const bf16x8_t pf = __builtin_bit_cast(bf16x8_t, pw);
#pragma unroll
                                for (int db = 0; db < 4; ++db) {
                                    LAS unsigned char* va = vb_ + vtr + (32 * kb + 16 * s2) * (DT_RSV * 2) + db * 64;
                                    const v4i16_d lo = __builtin_amdgcn_ds_read_tr16_b64_v4i16((LAS v4i16_d*)va), hi4 = __builtin_amdgcn_ds_read_tr16_b64_v4i16((LAS v4i16_d*)(va + 8 * (DT_RSV * 2)));
                                    const bf16x8_t vf = (bf16x8_t){lo[0], lo[1], lo[2], lo[3], hi4[0], hi4[1], hi4[2], hi4[3]};
                                    O[db] = __builtin_amdgcn_mfma_f32_32x32x16_bf16(vf, pf, O[db], 0, 0, 0);
                                }
                            }
                    }
                    if (t + 1 < nt) { const int nb = (tp ^ 1) * DT_BUF;
                        *(LAS v4u*)(lds + nb + krow * (DT_RSK * 2) + kch * 16) = sk[tp ^ 1];
                        *(LAS v4u*)(lds + nb + 64 * DT_RSK * 2 + vrow * (DT_RSV * 2) + vch * 16) = sv0[tp ^ 1]; *(LAS v4u*)(lds + nb + 64 * DT_RSK * 2 + (vrow + 32) * (DT_RSV * 2) + vch * 16) = sv1[tp ^ 1]; }
                    LDS_BAR();
                  }
                }
                lsum += __int_as_float(__builtin_amdgcn_ds_bpermute((lane ^ 32) << 2, __float_as_int(lsum)));
                const float linv = 1.f / lsum;
                if (m == 0) {
#pragma unroll
                    for (int db = 0; db < 4; ++db)
#pragma unroll
                        for (int r = 0; r < 16; r += 2) sO0[(db * 8 + (r >> 1)) * 64 + lane] = pk2(O[db][r] * linv, O[db][r + 1] * linv);
                } else {
                    float ss = 0.f;
#pragma unroll
                    for (int db = 0; db < 4; ++db)
#pragma unroll
                        for (int r = 0; r < 16; r += 2) { const unsigned w0 = sO0[(db * 8 + (r >> 1)) * 64 + lane];
                            const float o0 = bflo(w0) - lam * (O[db][r] * linv), o1 = bfhi(w0) - lam * (O[db][r + 1] * linv); O[db][r] = o0; O[db][r + 1] = o1; ss += o0 * o0 + o1 * o1; }
                    ss += __int_as_float(__builtin_amdgcn_ds_bpermute((lane ^ 32) << 2, __float_as_int(ss)));
                    const float rs = 1.f / sqrtf(ss * (1.f / 128.f) + RMS_EPS);
                    bf16* orow = MIXO + tokq * D + h * 128 + 4 * hi;
#pragma unroll
                    for (int db = 0; db < 4; ++db)
#pragma unroll
                        for (int rg = 0; rg < 4; ++rg) { const int d0 = 32 * db + 8 * rg + 4 * hi; const f32x4 g4 = *(const LAS f32x4*)(sG + d0);
                            u32x2_t w; w.x = pk2(O[db][4 * rg] * rs * g4.x, O[db][4 * rg + 1] * rs * g4.y); w.y = pk2(O[db][4 * rg + 2] * rs * g4.z, O[db][4 * rg + 3] * rs * g4.w);
                            *(u32x2_t*)(orow + 32 * db + 8 * rg) = w; }
                }
            }
        }
    }
    __syncthreads();
}

__device__ __forceinline__ void moe_tail_down(Frame& F, int lslot) {
    pg8::MoeOrder S; S.init((const unsigned*)(F.ctl + CW_CNT + 16 * lslot), 4, F.G, F.bx); S.cut_tail();
    const int ntail = S.so.nwg - S.so.lim;
    if (ntail <= 0) return;
    const bf16* A = (const bf16*)(F.ws + WS_HIDP); const bf16* Bt = (const bf16*)(F.ws + WS_WB + WB_MDN); bf16* O = (bf16*)(F.ws + WS_XPERM);
    int lane = F.lane; asm volatile("" : "+v"(lane)); const int fr = lane & 15, fq = lane >> 4;
    LAS unsigned char* red = F.lds;
    for (int rr = 0; rr * 16 < ntail; ++rr) {
        const int j = F.bx >> 3, t = (F.bx & 7) + 8 * ((j >> 4) + 2 * rr), p = j & 15;
        if (t >= ntail) continue;
        pg8::Unit u; S.at((long)S.so.lim + t, u);
        const int sr = (p >> 2) & 3, sc = p & 3;
        const bf16* ap = A + (size_t)(u.pm * 256 + 64 * sr + fr) * FF + 352 * F.wave + 8 * fq;
        const bf16* bp = Bt + (size_t)(u.pb * 256 + 64 * sc + fr) * FF + 352 * F.wave + 8 * fq;
        f32x4_t acc[4][4];
#pragma unroll
        for (int m = 0; m < 4; ++m)
#pragma unroll
            for (int n = 0; n < 4; ++n) acc[m][n] = (f32x4_t){0.f, 0.f, 0.f, 0.f};
        bf16x8_t fa[3][4], fb[3][4];
#define TL_LOAD(st, s) do { _Pragma("unroll") for (int g = 0; g < 4; ++g) { fa[st][g] = *(const bf16x8_t*)(ap + (size_t)(16 * g) * FF + 32 * (s)); fb[st][g] = *(const bf16x8_t*)(bp + (size_t)(16 * g) * FF + 32 * (s)); } } while (0)
        TL_LOAD(0, 0); TL_LOAD(1, 1);
#pragma unroll
        for (int s = 0; s < 11; ++s) {
            if (s + 2 < 11) TL_LOAD((s + 2) % 3, s + 2);
            __builtin_amdgcn_sched_barrier(0);
#pragma unroll
            for (int m = 0; m < 4; ++m)
#pragma unroll
                for (int n = 0; n < 4; ++n) acc[m][n] = __builtin_amdgcn_mfma_f32_16x16x32_bf16(fb[s % 3][n], fa[s % 3][m], acc[m][n], 0, 0, 0);
            __builtin_amdgcn_sched_barrier(0);
        }
#undef TL_LOAD
#pragma unroll
        for (int m = 0; m < 4; ++m)
#pragma unroll
            for (int n = 0; n < 4; ++n) *(LAS f32x4_t*)(red + ((size_t)((F.wave * 16 + m * 4 + n) * 64 + lane)) * 16) = acc[m][n];
        __syncthreads();
#pragma unroll
        for (int q2 = 0; q2 < 2; ++q2) {
            const int q = 2 * F.wave + q2, m = q >> 2, n = q & 3;
            f32x4_t t = *(const LAS f32x4_t*)(red + ((size_t)(q * 64 + lane)) * 16);
#pragma unroll
            for (int v = 1; v < 8; ++v) t += *(const LAS f32x4_t*)(red + ((size_t)((v * 16 + q) * 64 + lane)) * 16);
            bf16* op = O + (size_t)(u.pm * 256 + 64 * sr + 16 * m + fr) * D + u.pn * 256 + 64 * sc + 16 * n + 4 * fq;
            *(GAS unsigned long long*)op = (unsigned long long)pk2(t[0], t[1]) | ((unsigned long long)pk2(t[2], t[3]) << 32);
        }
        __syncthreads();
    }
}

struct Args { const float* in[34]; float* out; unsigned char* ws; int lo, hi; };
constexpr int PH_PER_PAIR = 17, NPHASE = 1 + 2 * PH_PER_PAIR;
#ifndef PHMASK
#define PHMASK 0x3FFFFu
#endif
#define PHON(k) (((PHMASK) >> (k)) & 1u)

__device__ __forceinline__ void frame_refresh(Frame& F) {
    int wv = F.wave0; asm volatile("" : "+s"(wv));
    int ln; asm volatile("v_mbcnt_lo_u32_b32 %0, -1, 0\n\tv_mbcnt_hi_u32_b32 %0, -1, %0" : "=v"(ln));
    ln &= 63; wv &= 7; const int t = wv * 64 + ln;
    int bx = blockIdx.x; asm volatile("" : "+s"(bx));
    const __attribute__((address_space(4))) unsigned char* kp = (const __attribute__((address_space(4))) unsigned char*)__builtin_amdgcn_kernarg_segment_ptr(); asm volatile("" : "+s"(kp));
    typedef unsigned char* ucp; unsigned char* w = *(const __attribute__((address_space(4))) ucp*)(kp + 280);
    F.kp = kp; F.tid = t; F.lane = t & 63; F.wave = wv;
    F.bx = bx; F.gw = bx * NWAVES + F.wave; F.ws = w; F.ctl = (gu32*)(w + WS_CTL);
}

#define IN(k) (lo <= (k) && (k) < hi)
#define SEAM(k) do { if (IN((k) + 1)) xcd_barrier(bar, F.tid); } while (0)
#define WSB(off) ((bf16*)(F.ws + (off)))
template <int lp> __device__ __forceinline__ void layer_pair(Frame& F, const int lo, const int hi, const XcdBarrier& bar, unsigned char* lds) {
        const int pb = 1 + PH_PER_PAIR * lp;
        if (PHON(1) && IN(pb + 0)) {
            frame_refresh(F);
            pg8::Gemm g{WSB(WS_XB), WSB(WS_WB + WB_WIN), M, EINP, D}; pg8::StaticOrder S; S.init(M, EINP, F.G, F.bx);
            pg8::EpiBf16<0> E{WSB(WS_P), EINP, nullptr, 0, 0, 1.f};
            pg8::gemm_phase<pg8::EpiBf16<0>, pg8::StaticOrder, true, true>(F.lds, g, S, E, F.tid);
            SEAM(pb + 0);
        }
        if (PHON(2) && IN(pb + 1)) { frame_refresh(F); dsa_prep(F, lp); gla_prep(F, lp); SEAM(pb + 1); }
        if (PHON(3) && IN(pb + 2)) { frame_refresh(F); dsa_index(F); frame_refresh(F); gla_scan(F); SEAM(pb + 2); }
        if (PHON(4) && IN(pb + 3)) { frame_refresh(F);
            dsa_body::dsa_attn_phase<8>((char*)lds, (const dsa_body::bf16*)(F.ws + WS_P) + PC_AQ, (const dsa_body::bf16*)(F.ws + WS_KD), (const dsa_body::bf16*)(F.ws + WS_VD), (dsa_body::bf16*)(F.ws + WS_MIX), (const unsigned*)(F.ws + WS_MASK), F.bx, F.G, F.tid);
            __syncthreads(); gla_out(F, lp); SEAM(pb + 3); }
        if (PHON(5) && IN(pb + 4)) {
            frame_refresh(F);
            pg8::Gemm g{WSB(WS_MIX), WSB(WS_WB + WB_WOUT), M, D, D}; pg8::PanelOrder S; S.init(M, F.bx);
            pg8::EpiLnFused E{WSB(WS_XB), F.inp(11) + lp * D, F.inp(12) + lp * D, (unsigned long long*)(F.ws + WS_XSTAT), (unsigned*)(F.ctl + CW_PANEL + 8192 * (2 * lp)), (unsigned*)(F.ctl + CW_TMO), F.lds + XTRA_OFF};
            pg8::gemm_phase<pg8::EpiLnFused, pg8::PanelOrder, true, true>(F.lds, g, S, E, F.tid);
            SEAM(pb + 4);
        }
        if (PHON(7) && IN(pb + 6)) {
            frame_refresh(F);
            pg8::Gemm g{WSB(WS_XB), WSB(WS_WB + WB_WGU), M, 2 * FF, D}; pg8::StaticOrder S; S.init(M, 2 * FF, F.G, F.bx);
            pg8::EpiSwiGLU E{WSB(WS_HID), FF};
            pg8::gemm_phase<pg8::EpiSwiGLU, pg8::StaticOrder, true, true>(F.lds, g, S, E, F.tid);
            SEAM(pb + 6);
        }
        if (PHON(8) && IN(pb + 7)) {
            frame_refresh(F);
            pg8::Gemm g{WSB(WS_HID), WSB(WS_WB + WB_WDN), M, D, FF}; pg8::PanelOrder S; S.init(M, F.bx);
            pg8::EpiLnFused E{WSB(WS_XB), F.inp(16) + lp * D, F.inp(17) + lp * D, (unsigned long long*)(F.ws + WS_XSTAT), (unsigned*)(F.ctl + CW_PANEL + 8192 * (2 * lp + 1)), (unsigned*)(F.ctl + CW_TMO), F.lds + XTRA_OFF};
            pg8::gemm_phase<pg8::EpiLnFused, pg8::PanelOrder, true, true>(F.lds, g, S, E, F.tid);
            SEAM(pb + 7);
        }
        if (PHON(9) && IN(pb + 8)) { frame_refresh(F); cvt_odd(F, lp); SEAM(pb + 8); }
        if (PHON(10) && IN(pb + 9)) {
            frame_refresh(F);
            pg8::Gemm g{WSB(WS_XB), WSB(WS_WB + WB_WQKV), M, 3072, D}; pg8::StaticOrder S; S.init(M, 3072, F.G, F.bx);
            pg8::EpiBf16<0> E{WSB(WS_QKV), 3072, nullptr, 1024, 1024, C2};
            pg8::gemm_phase<pg8::EpiBf16<0>, pg8::StaticOrder, true, true>(F.lds, g, S, E, F.tid);
            SEAM(pb + 9);
        }
        if (PHON(11) && IN(pb + 10)) {
            frame_refresh(F);
            constexpr float lam_init = (lp == 0) ? 0.355509068f : 0.556058204f;
            diff_attn_t(F, lds, lp, lam_init);
            SEAM(pb + 10);
        }
        if (PHON(12) && IN(pb + 11)) {
            frame_refresh(F);
            pg8::Gemm g{WSB(WS_MIXO), WSB(WS_WB + WB_WOUT), M, D, D}; pg8::StaticOrder S; S.init(M, D, F.G, F.bx);
            pg8::EpiBf16<0> E{WSB(WS_H_ODD), D, nullptr, 0, 0, 1.f};
            pg8::gemm_phase<pg8::EpiBf16<0>, pg8::StaticOrder, true, true>(F.lds, g, S, E, F.tid);
            SEAM(pb + 11);
        }
        if (PHON(13) && IN(pb + 12)) { frame_refresh(F);
            ln_phase<0, true, true, false>(F, (const float*)F.outp(), WSB(WS_H_ODD), F.inp(25) + lp * D, F.inp(26) + lp * D, F.outp(), WSB(WS_XB), F.inp(27) + (size_t)lp * D * NEXP, F.inp(28) + lp * NEXP, lp); SEAM(pb + 12); }
        if (PHON(14) && IN(pb + 13)) { frame_refresh(F); moe_map(F, lp); SEAM(pb + 13); }
        if (PHON(15) && IN(pb + 14)) {
            frame_refresh(F);
            pg8::MoeOrder S; S.init((const unsigned*)(F.ctl + CW_CNT + 16 * lp), 22, F.G, F.bx);
            pg8::Gemm g{WSB(WS_XB), WSB(WS_WB + WB_MGU), S.so.nM * 256, 2 * FF, D, (const int*)(F.ws + WS_INV)};
            pg8::EpiSwiGLU E{WSB(WS_HIDP), FF};
            pg8::gemm_phase<pg8::EpiSwiGLU, pg8::MoeOrder, true, true, true>(F.lds, g, S, E, F.tid);
            SEAM(pb + 14);
        }
        if (PHON(16) && IN(pb + 15)) {
            frame_refresh(F);
            pg8::MoeOrder S; S.init((const unsigned*)(F.ctl + CW_CNT + 16 * lp), 4, F.G, F.bx); S.cut_tail();
            pg8::Gemm g{WSB(WS_HIDP), WSB(WS_WB + WB_MDN), S.so.nM * 256, D, FF};
            pg8::EpiBf16<0> E{WSB(WS_XPERM), D, nullptr, 0, 0, 1.f};
            pg8::gemm_phase<pg8::EpiBf16<0>, pg8::MoeOrder, true, true>(F.lds, g, S, E, F.tid);
            frame_refresh(F); moe_tail_down(F, lp);
            SEAM(pb + 15);
        }
        if (PHON(17) && IN(pb + 16)) {
            frame_refresh(F);
            ln_phase<1, false, true, lp == 1>(F, (const float*)F.outp(), WSB(WS_XPERM), F.inp(32) + lp * D, F.inp(33) + lp * D, F.outp(), WSB(WS_XB), nullptr, nullptr, 0);
            if (lp == 0) { __syncthreads(); cvt_even(F, 1); SEAM(pb + 16); }
        }
    }

__global__ void __launch_bounds__(NTHR, 2) mega_fwd(Args args) {
    extern __shared__ __attribute__((aligned(16))) unsigned char lds[];
    Frame F;
    F.lds = (LAS unsigned char*)lds; F.MISC = (volatile LAS unsigned*)(F.lds + MISC_OFF);
    F.G = gridDim.x; F.NGW = F.G * NWAVES; F.wave0 = __builtin_amdgcn_readfirstlane((int)threadIdx.x >> 6);
    frame_refresh(F);
    for (int u = F.tid; u < (LDS_BYTES - LDSCTL_OFF) / 4; u += NTHR) ((LAS unsigned*)(F.lds + LDSCTL_OFF))[u] = 0u;
    __syncthreads();
    const int lo = args.lo, hi = args.hi;
    const bool use_bar = (hi - lo) > 1;
    XcdBarrier bar; bar.bar = (unsigned*)(F.ctl + CW_BAR); bar.x = 0; bar.st = nullptr;
    if (use_bar) bar = xcd_barrier_post((unsigned*)(F.ctl + CW_BAR), F.MISC + 8, F.tid);

    if (PHON(0) && IN(0)) { frame_refresh(F); cvt_even(F, 0); xb_from_x(F); SEAM(0); }

    layer_pair<0>(F, lo, hi, bar, lds);
    layer_pair<1>(F, lo, hi, bar, lds);
#undef IN
#undef SEAM
}

#ifndef MK_SINGLE
#define MK_SINGLE 1
#endif
extern "C" void kernel_launch(void* const* d_in, const int* in_sizes, int n_in, void* d_out, int out_size, void* d_ws, size_t ws_size, hipStream_t stream) {
    static int grid = 0;
    if (grid == 0) {
        if (n_in != 34 || in_sizes[0] != M * D || out_size != M * D || ws_size < WS_END) { fprintf(stderr, "kernel_launch: unexpected shapes or workspace (n_in %d, ws %zu)\n", n_in, ws_size); grid = -1; return; }
        int dev = 0, cus = 0, per_cu = 0;
        if (hipGetDevice(&dev) != hipSuccess || hipDeviceGetAttribute(&cus, hipDeviceAttributeMultiprocessorCount, dev) != hipSuccess) { grid = -1; return; }
        if (hipFuncSetAttribute((const void*)mega_fwd, hipFuncAttributeMaxDynamicSharedMemorySize, LDS_BYTES) != hipSuccess) { grid = -1; return; }
        if (hipOccupancyMaxActiveBlocksPerMultiprocessor(&per_cu, (const void*)mega_fwd, NTHR, LDS_BYTES) != hipSuccess || per_cu < 1) fprintf(stderr, "kernel_launch: occupancy query says %d\n", per_cu);
        (void)hipGetLastError();
        if (cus != 256) { fprintf(stderr, "kernel_launch: this kernel is laid out for 256 CUs (got %d)\n", cus); grid = -1; return; }
        grid = cus;
    }
    if (grid < 0) return;
    (void)hipMemsetAsync((char*)d_ws + WS_CTL, 0, CTL_ZERO_BYTES, stream);
    Args a{};
    for (int i = 0; i < 34; ++i) a.in[i] = (const float*)d_in[i];
    a.out = (float*)d_out; a.ws = (unsigned char*)d_ws;
    a.lo = 0; a.hi = NPHASE;
    hipLaunchKernelGGL(mega_fwd, dim3(grid), dim3(NTHR), LDS_BYTES, stream, a);
}
```
